# Optimizing an MI355X kernel written in HIP

```python
import math
import jax
import jax.numpy as jnp
from jax import lax
import numpy as np

D_MODEL = 4096
BATCH = 2
SEQ = 8192
DEPTH = 2

CHUNK = 64
Q_BLOCK = 128
EPS = 1e-6
NEG = -1e30
F_FLOOR = 1e-20
W_MIX = D_MODEL
GROUP = W_MIX // 4
HEAD_DIM = 128
A_HEADS = GROUP // HEAD_DIM
A_DK = HEAD_DIM
A_DV = GROUP // A_HEADS
B_HEADS = GROUP // HEAD_DIM
B_DQK = HEAD_DIM // 2
B_DV = GROUP // B_HEADS
CONV_W = 4
C_HEADS = GROUP // (2 * HEAD_DIM)
C_DQK = HEAD_DIM
C_DV = 2 * HEAD_DIM
D_HEADS = GROUP // HEAD_DIM
D_DH = HEAD_DIM
IDX_HEADS = 16
IDX_DIM = 64
TOPK_MAX = 256
D_FF = 4 * D_MODEL

SPLIT_SIZES = (
    GROUP, GROUP, GROUP, GROUP,
    2 * B_HEADS * B_DQK, GROUP, GROUP, 2 * B_HEADS,
    2 * C_HEADS * C_DQK, 2 * C_HEADS * C_DQK, C_HEADS * C_DV,
    D_HEADS * D_DH, D_HEADS * D_DH, D_HEADS * D_DH,
    IDX_HEADS * IDX_DIM, IDX_DIM, IDX_HEADS,
)
N_IN = sum(SPLIT_SIZES)

kernel_name = 'hybrid_hgrn2_mlstm_diffattn_dsa_block'


def _split_points():
    pts, acc = [], 0
    for size in SPLIT_SIZES[:-1]:
        acc += size
        pts.append(acc)
    return pts


def rmsnorm(x, g):
    xf = x.astype(jnp.float32)
    y = xf * lax.rsqrt(jnp.mean(jnp.square(xf), axis=-1, keepdims=True) + EPS)
    return (y * g.astype(jnp.float32)).astype(x.dtype)


def _heads(t, n_heads):
    b, s, _ = t.shape
    return t.astype(jnp.float32).reshape(b, s, n_heads, -1).transpose(0, 2, 1, 3)


def _to_chunks(t):
    b, h, s = t.shape[:3]
    t = t.reshape((b, h, s // CHUNK, CHUNK) + t.shape[3:])
    return jnp.moveaxis(t, 2, 0)


def _from_chunks(y):
    nc, b, h, c, d = y.shape
    return jnp.moveaxis(y, 0, 2).reshape(b, h, nc * c, d).transpose(0, 2, 1, 3)


def causal_conv(x, w):
    c = x.shape[-1]
    return lax.conv_general_dilated(
        x, w[:, None, :].astype(x.dtype), window_strides=(1,), padding=[(CONV_W - 1, 0)],
        dimension_numbers=('NWC', 'WIO', 'NWC'), feature_group_count=c)


def hgrn2_mixer(q_raw, f_raw, i_raw, g_raw, lb, g_norm):
    bsz, s, _ = q_raw.shape
    z = f_raw.astype(jnp.float32)
    lb = lb.astype(jnp.float32)
    f = lb + (1.0 - lb) * jax.nn.sigmoid(z)
    log_f = jnp.log(jnp.maximum(f, F_FLOOR))
    k_in = 1.0 - f
    q = _heads(jax.nn.silu(q_raw.astype(jnp.float32)), A_HEADS) * A_DK ** -0.5
    k = _heads(k_in, A_HEADS)
    v = _heads(i_raw, A_HEADS)
    g = _heads(log_f, A_HEADS)
    causal = jnp.tril(jnp.ones((CHUNK, CHUNK), dtype=bool))

    def step(state, inp):
        qc, kc, vc, gc = inp
        b = jnp.cumsum(gc, axis=2)
        rel = b[:, :, :, None, :] - b[:, :, None, :, :]
        decay = jnp.where(causal[:, :, None], jnp.exp(jnp.minimum(rel, 0.0)), 0.0)
        scores = jnp.einsum('bhtk,bhtsk,bhsk->bhts', qc, decay, kc)
        o = (jnp.einsum('bhts,bhsv->bhtv', scores, vc)
             + jnp.einsum('bhtk,bhkv->bhtv', qc * jnp.exp(b), state))
        b_last = b[:, :, -1:, :]
        state = (jnp.exp(b_last[:, :, 0, :, None]) * state
                 + jnp.einsum('bhsk,bhsv->bhkv', kc * jnp.exp(b_last - b), vc))
        return state, o

    s0 = jnp.zeros((bsz, A_HEADS, A_DK, A_DV), jnp.float32)
    _, o = lax.scan(step, s0, (_to_chunks(q), _to_chunks(k), _to_chunks(v), _to_chunks(g)))
    o = _from_chunks(o)
    gate = jax.nn.silu(g_raw.astype(jnp.float32)).reshape(bsz, s, A_HEADS, A_DV)
    o = rmsnorm(o, g_norm) * gate
    return o.reshape(bsz, s, GROUP).astype(q_raw.dtype)


def mlstm_mixer(qk_raw, v_raw, o_raw, if_raw, conv_w, gate_bias, h_norm):
    bsz, s, _ = qk_raw.shape
    qk = jax.nn.silu(causal_conv(qk_raw, conv_w))
    q_half, k_half = jnp.split(qk, 2, axis=-1)
    q = _heads(q_half, B_HEADS)
    k = _heads(k_half, B_HEADS) * B_DQK ** -0.5
    v = _heads(v_raw, B_HEADS)
    gates = (if_raw.astype(jnp.float32) + gate_bias.astype(jnp.float32)).transpose(0, 2, 1)
    ig, fg = jnp.split(gates, 2, axis=1)
    log_f = jax.nn.log_sigmoid(fg)
    causal = jnp.tril(jnp.ones((CHUNK, CHUNK), dtype=bool))

    def step(carry, inp):
        c_mat, n_vec, m_prev = carry
        qc, kc, vc, igc, lfc = inp
        b = jnp.cumsum(lfc, axis=-1)
        log_d = jnp.where(causal, b[..., :, None] - b[..., None, :] + igc[..., None, :], NEG)
        log_inter = b + m_prev[..., None]
        m_t = jnp.maximum(jnp.max(log_d, axis=-1), log_inter)
        qk_w = jnp.einsum('bhtd,bhsd->bhts', qc, kc) * jnp.exp(log_d - m_t[..., None])
        w_inter = jnp.exp(log_inter - m_t)
        num = (jnp.einsum('bhts,bhsv->bhtv', qk_w, vc)
               + w_inter[..., None] * jnp.einsum('bhtd,bhdv->bhtv', qc, c_mat))
        den = jnp.sum(qk_w, axis=-1) + w_inter * jnp.einsum('bhtd,bhd->bht', qc, n_vec)
        h = num / jnp.maximum(jnp.abs(den), jnp.exp(-m_t))[..., None]
        m_new = m_t[..., -1]
        w_state = jnp.exp(b[..., -1:] - b + igc - m_new[..., None])
        decay = jnp.exp(b[..., -1] + m_prev - m_new)
        c_mat = decay[..., None, None] * c_mat + jnp.einsum('bhs,bhsd,bhsv->bhdv', w_state, kc, vc)
        n_vec = decay[..., None] * n_vec + jnp.einsum('bhs,bhsd->bhd', w_state, kc)
        return (c_mat, n_vec, m_new), h

    carry0 = (jnp.zeros((bsz, B_HEADS, B_DQK, B_DV), jnp.float32),
              jnp.zeros((bsz, B_HEADS, B_DQK), jnp.float32),
              jnp.zeros((bsz, B_HEADS), jnp.float32))
    _, h = lax.scan(step, carry0, (_to_chunks(q), _to_chunks(k), _to_chunks(v),
                                   _to_chunks(ig), _to_chunks(log_f)))
    h = _from_chunks(h)
    o_gate = jax.nn.sigmoid(o_raw.astype(jnp.float32)).reshape(bsz, s, B_HEADS, B_DV)
    return (rmsnorm(h, h_norm) * o_gate).reshape(bsz, s, GROUP).astype(qk_raw.dtype)


def diff_attention(q_raw, k_raw, v_raw, qk_norm, lam, sub_norm, lambda_init):
    bsz, s, _ = q_raw.shape
    q = rmsnorm(q_raw.reshape(bsz, s, C_HEADS, 2, C_DQK), qk_norm[0]) * C_DQK ** -0.5
    k = rmsnorm(k_raw.reshape(bsz, s, C_HEADS, 2, C_DQK), qk_norm[1])
    v = v_raw.reshape(bsz, s, C_HEADS, C_DV)
    lam_f = lam.astype(jnp.float32)
    lam_full = (jnp.exp(jnp.sum(lam_f[0] * lam_f[1])) - jnp.exp(jnp.sum(lam_f[2] * lam_f[3]))
                + lambda_init)
    k_chunk = jnp.arange(s) // CHUNK

    def block(i):
        start = i * Q_BLOCK
        qb = lax.dynamic_slice_in_dim(q, start, Q_BLOCK, axis=1)
        scores = jnp.einsum('bthmd,bshmd->bhmts', qb, k).astype(jnp.float32)
        q_chunk = (start + jnp.arange(Q_BLOCK)) // CHUNK
        mask = k_chunk[None, :] <= q_chunk[:, None]
        p = jax.nn.softmax(jnp.where(mask, scores, NEG), axis=-1)
        a = p[:, :, 0] - lam_full * p[:, :, 1]
        return jnp.einsum('bhts,bshv->bthv', a.astype(v.dtype), v)

    o = lax.map(block, jnp.arange(s // Q_BLOCK))
    o = jnp.moveaxis(o, 0, 1).reshape(bsz, s, C_HEADS, C_DV)
    o = rmsnorm(o, sub_norm) * (1.0 - lambda_init)
    return o.reshape(bsz, s, GROUP)


def dsa_attention(q_raw, k_raw, v_raw, qi_raw, ki_raw, wi_raw, qk_norm, ki_norm):
    bsz, s, _ = q_raw.shape
    q = rmsnorm(q_raw.reshape(bsz, s, D_HEADS, D_DH), qk_norm[0]) * D_DH ** -0.5
    k = rmsnorm(k_raw.reshape(bsz, s, D_HEADS, D_DH), qk_norm[1])
    v = v_raw.reshape(bsz, s, D_HEADS, D_DH)
    qi = qi_raw.reshape(bsz, s, IDX_HEADS, IDX_DIM)
    ki = rmsnorm(ki_raw, ki_norm)
    wi = wi_raw * IDX_HEADS ** -0.5
    topk = min(TOPK_MAX, s // 4)
    k_chunk = jnp.arange(s) // CHUNK
    gather = jax.vmap(lambda table, idx: table[idx])

    def block(i):
        start = i * Q_BLOCK
        qb = lax.dynamic_slice_in_dim(q, start, Q_BLOCK, axis=1)
        qib = lax.dynamic_slice_in_dim(qi, start, Q_BLOCK, axis=1)
        wib = lax.dynamic_slice_in_dim(wi, start, Q_BLOCK, axis=1)
        q_chunk = (start + jnp.arange(Q_BLOCK)) // CHUNK
        logits = jnp.einsum('bthd,bsd->bths', qib, ki).astype(jnp.float32) * IDX_DIM ** -0.5
        index_score = jnp.einsum('bths,bth->bts', jax.nn.relu(logits), wib.astype(jnp.float32))
        admissible = k_chunk[None, :] <= q_chunk[:, None]
        index_score = jnp.where(admissible[None], index_score, NEG)
        _, sel = lax.top_k(index_score, topk)
        valid = (sel // CHUNK) <= q_chunk[None, :, None]
        k_sel = gather(k, sel)
        v_sel = gather(v, sel)
        scores = jnp.einsum('bthd,btkhd->bhtk', qb, k_sel).astype(jnp.float32)
        p = jax.nn.softmax(jnp.where(valid[:, None], scores, NEG), axis=-1)
        return jnp.einsum('bhtk,btkhd->bthd', p.astype(v.dtype), v_sel)

    o = lax.map(block, jnp.arange(s // Q_BLOCK))
    return jnp.moveaxis(o, 0, 1).reshape(bsz, s, GROUP)


def setup_inputs(seed: int = 0) -> dict:
    key = jax.random.key(seed)
    ks = jax.random.split(key, 20)
    f32 = jnp.float32

    def nrm(k, shape, scale):
        return scale * jax.random.normal(k, shape, f32)

    fg_bias = jnp.linspace(3.0, 6.0, B_HEADS, dtype=f32)
    return {
        'x': nrm(ks[0], (BATCH, SEQ, D_MODEL), 1.0),
        'norm_mix': 1.0 + nrm(ks[1], (DEPTH, D_MODEL), 0.02),
        'w_in': nrm(ks[2], (DEPTH, D_MODEL, N_IN), D_MODEL ** -0.5),
        'hgrn_lb_logits': nrm(ks[3], (DEPTH, GROUP), 1.0),
        'hgrn_gnorm': 1.0 + nrm(ks[4], (DEPTH, A_DV), 0.02),
        'mlstm_conv': nrm(ks[5], (DEPTH, CONV_W, 2 * B_HEADS * B_DQK), CONV_W ** -0.5),
        'mlstm_gate_bias': jnp.concatenate(
            [nrm(ks[6], (DEPTH, B_HEADS), 0.1), fg_bias[None] + nrm(ks[7], (DEPTH, B_HEADS), 0.1)], axis=-1),
        'mlstm_hnorm': 1.0 + nrm(ks[8], (DEPTH, B_DV), 0.02),
        'diff_qk_norm': 1.0 + nrm(ks[9], (DEPTH, 2, C_DQK), 0.02),
        'diff_lambda': nrm(ks[10], (DEPTH, 4, C_DQK), 0.1),
        'diff_subln': 1.0 + nrm(ks[11], (DEPTH, C_DV), 0.02),
        'dsa_qk_norm': 1.0 + nrm(ks[12], (DEPTH, 2, D_DH), 0.02),
        'dsa_idx_knorm': 1.0 + nrm(ks[13], (DEPTH, IDX_DIM), 0.02),
        'w_out': nrm(ks[14], (DEPTH, W_MIX, D_MODEL), W_MIX ** -0.5),
        'norm_mlp': 1.0 + nrm(ks[15], (DEPTH, D_MODEL), 0.02),
        'w1': nrm(ks[16], (DEPTH, D_MODEL, D_FF), D_MODEL ** -0.5),
        'w2': nrm(ks[17], (DEPTH, D_FF, D_MODEL), D_FF ** -0.5),
    }


def reference(x, norm_mix, w_in, hgrn_lb_logits, hgrn_gnorm, mlstm_conv, mlstm_gate_bias,
              mlstm_hnorm, diff_qk_norm, diff_lambda, diff_subln, dsa_qk_norm, dsa_idx_knorm,
              w_out, norm_mlp, w1, w2):
    p_lb = jax.nn.softmax(hgrn_lb_logits.astype(jnp.float32), axis=0)
    lower_bounds = jnp.cumsum(p_lb, axis=0) - p_lb[0:1]
    points = _split_points()
    for l in range(DEPTH):
        lambda_init = 0.8 - 0.6 * math.exp(-0.3 * l)
        h = rmsnorm(x, norm_mix[l])
        proj = jnp.einsum('bsd,dn->bsn', h, w_in[l])
        (a_q, a_f, a_i, a_g, b_qk, b_v, b_o, b_if, c_q, c_k, c_v,
         d_q, d_k, d_v, d_qi, d_ki, d_w) = jnp.split(proj, points, axis=-1)
        y_a = hgrn2_mixer(a_q, a_f, a_i, a_g, lower_bounds[l], hgrn_gnorm[l])
        y_b = mlstm_mixer(b_qk, b_v, b_o, b_if, mlstm_conv[l], mlstm_gate_bias[l], mlstm_hnorm[l])
        y_c = diff_attention(c_q, c_k, c_v, diff_qk_norm[l], diff_lambda[l], diff_subln[l], lambda_init)
        y_d = dsa_attention(d_q, d_k, d_v, d_qi, d_ki, d_w, dsa_qk_norm[l], dsa_idx_knorm[l])
        y = jnp.concatenate([y_a, y_b, y_c, y_d], axis=-1)
        x = x + jnp.einsum('bsw,wd->bsd', y, w_out[l])
        h = rmsnorm(x, norm_mlp[l])
        hidden = jnp.square(jax.nn.relu(jnp.einsum('bsd,df->bsf', h, w1[l])))
        x = x + jnp.einsum('bsf,fd->bsd', hidden, w2[l])
    return x
```

```cpp
#include <hip/hip_runtime.h>
#include <cstdio>
#include <cstdint>

#ifndef ONE_LAUNCH
#define ONE_LAUNCH 1
#endif

#define LAS __attribute__((address_space(3)))
typedef unsigned short bf16_t;
typedef short bf16x8 __attribute__((ext_vector_type(8)));
typedef short s16x4 __attribute__((ext_vector_type(4)));
typedef float f32x2 __attribute__((ext_vector_type(2)));
typedef float f32x4 __attribute__((ext_vector_type(4)));
typedef float f32x16 __attribute__((ext_vector_type(16)));
typedef unsigned u32x2 __attribute__((ext_vector_type(2)));
typedef unsigned u32x4 __attribute__((ext_vector_type(4)));

constexpr int T = 8192, NB = 2, M = NB * T, DM = 4096, FF = 16384, DEPTH = 2;
constexpr int NIN = 14432, NINP = 14592;
constexpr int LDP = 14336;
constexpr int C_AQ = 0, C_AF = 1024, C_AI = 2048, C_AG = 3072, C_BQK = 4096, C_BV = 5120, C_BO = 6144;
constexpr int C_CQ = 7168, C_CK = 8192, C_CV = 9216, C_DQ = 10240, C_DK = 11264, C_DV = 12288, C_DQI = 13312;
constexpr int LDO = 128;
constexpr float EPS = 1e-6f;

constexpr size_t MiB = 1u << 20;
constexpr size_t WS_CTL = 0, CTL_BYTES = 2 * MiB;
constexpr size_t SZ_WIN = (size_t)NINP * DM * 2, SZ_WOUT = (size_t)DM * DM * 2, SZ_W1 = (size_t)FF * DM * 2, SZ_W2 = (size_t)DM * FF * 2;
constexpr size_t WS_WIN = WS_CTL + CTL_BYTES;
constexpr size_t WS_WOUT = WS_WIN + 2 * SZ_WIN;
constexpr size_t WS_W1 = WS_WOUT + 2 * SZ_WOUT;
constexpr size_t WS_W2 = WS_W1 + 2 * SZ_W1;
constexpr size_t WS_XB = WS_W2 + 2 * SZ_W2;
constexpr size_t WS_PROJ = WS_XB + (size_t)M * DM * 2;
constexpr size_t WS_GLOG = WS_PROJ + (size_t)M * LDP * 2;
constexpr size_t WS_ODD = WS_GLOG + (size_t)M * 1024 * 4;
constexpr size_t WS_Y = WS_ODD + (size_t)M * LDO * 4;
constexpr size_t WS_MASK = WS_Y + (size_t)M * DM * 2;
constexpr size_t WS_BQK = WS_MASK + (size_t)NB * 256 * T * 4;
constexpr size_t WS_KI = WS_BQK + (size_t)M * 1024 * 2;
constexpr size_t WS_LB = WS_KI + (size_t)M * 64 * 2;
constexpr size_t WS_SCB = WS_LB + 65536;
constexpr size_t WS_CATT = WS_SCB + (size_t)256 * 8 * 4 * T * 4;
constexpr size_t WS_SSQP = WS_CATT + (size_t)M * 2048 * 4;
constexpr size_t WS_RS = WS_SSQP + (size_t)64 * M * 4;
constexpr size_t WS_END = WS_RS + (size_t)M * 4;
static_assert((size_t)M * LDP * 2 + (size_t)M * 1024 * 4 == (size_t)M * FF * 2, "HID overlay");

constexpr int CW_BAR = 1024;
constexpr int CW_BGQ = 12288;
constexpr int CW_Q = 8192;

constexpr int LDS_BYTES = 147456;
constexpr int LDS_MISC = LDS_BYTES - 512;
constexpr int LDS_WTAB = LDS_BYTES - 256;
constexpr int NPHASE = 1 + 9 * DEPTH;

__host__ __device__ __forceinline__ size_t tiled_off(size_t row, int col, int K) { return ((((row >> 8) * (size_t)(K >> 6)) + (size_t)(col >> 6)) * 256 + (row & 255)) * 64 + (col & 63); }
__device__ __forceinline__ unsigned cvt_pk_bf16(float lo, float hi) { unsigned r; asm volatile("v_cvt_pk_bf16_f32 %0, %1, %2" : "=v"(r) : "v"(lo), "v"(hi)); return r; }
__device__ __forceinline__ float bf_lo(unsigned u) { return __uint_as_float(u << 16); }
__device__ __forceinline__ float bf_hi(unsigned u) { return __uint_as_float(u & 0xffff0000u); }
__device__ __forceinline__ float bf2f(bf16_t b) { return __uint_as_float(((unsigned)b) << 16); }
__device__ __forceinline__ float fast_sigmoid(float v) { return __builtin_amdgcn_rcpf(1.f + __expf(-v)); }
__device__ __forceinline__ float fast_silu(float v) { return v * fast_sigmoid(v); }
__device__ __forceinline__ int my_tid() {
    unsigned lane; asm volatile("v_mbcnt_lo_u32_b32 %0, -1, 0\n\tv_mbcnt_hi_u32_b32 %0, -1, %0" : "=v"(lane));
    const unsigned slot = (unsigned)__builtin_amdgcn_s_getreg((5 << 11) | 4) & 63u;
    const unsigned wv = *(volatile LAS unsigned*)(uintptr_t)(LDS_WTAB + slot * 4);
    return __builtin_amdgcn_readfirstlane((int)wv) * 64 + (int)lane;
}
__device__ __forceinline__ float sx(float v, int o, int lane) { return __int_as_float(__builtin_amdgcn_ds_bpermute((lane ^ o) << 2, __float_as_int(v))); }
#define DPPF(v, ctrl) __int_as_float(__builtin_amdgcn_update_dpp(0, __float_as_int(v), (ctrl), 0xf, 0xf, true))
__device__ __forceinline__ float xrow16_sum(float x) {
    auto s = __builtin_amdgcn_permlane16_swap(__float_as_uint(x), __float_as_uint(x), false, false);
    x = __uint_as_float(s[0]) + __uint_as_float(s[1]);
    auto t = __builtin_amdgcn_permlane32_swap(__float_as_uint(x), __float_as_uint(x), false, false);
    return __uint_as_float(t[0]) + __uint_as_float(t[1]);
}
__device__ __forceinline__ float sum8(float v) { v += DPPF(v, 0xB1); v += DPPF(v, 0x4E); v += DPPF(v, 0x141); return v; }
__device__ __forceinline__ float sum16(float v) { v = sum8(v); v += DPPF(v, 0x140); return v; }
__device__ __forceinline__ float sidx(float v, int src) { return __int_as_float(__builtin_amdgcn_ds_bpermute(src << 2, __float_as_int(v))); }
__device__ __forceinline__ unsigned sidxu(unsigned v, int src) { return (unsigned)__builtin_amdgcn_ds_bpermute(src << 2, (int)v); }
__device__ __forceinline__ u32x4 zero4() { unsigned z = 0u; asm volatile("" : "+v"(z)); return (u32x4){z, z, z, z}; }

namespace pg8 {
constexpr int BM = 256, BK = 64, HALF = 128, HTB = HALF * BK * 2, STAGE_BYTES = 8 * HTB, NXCD = 8, WGM = 8;
__host__ __device__ __forceinline__ int lds_byte(int r, int c) { const int st = (r >> 4) * 2 + (c >> 5), rr = r & 15, cc = c & 31, ob = rr * 64 + cc * 2; return st * 1024 + (ob ^ (((ob >> 9) & 1) << 5)); }
__host__ __device__ __forceinline__ void stage_rc(int b, int& R, int& C) { const int st = b / 1024, sb = b % 1024, swz = sb ^ (((sb >> 9) & 1) << 5); R = (st >> 1) * 16 + swz / 64; C = (st & 1) * 32 + (swz % 64) / 2; }
__host__ __device__ __forceinline__ int perm32(int rho) { const int n = rho >> 4, i = rho & 15; return 8 * (i >> 2) + 4 * n + (i & 3); }
struct Unit { int pm, pn; };
struct Gemm { const bf16_t* A; const bf16_t* Bt; int M, N, K, Kld; };
struct StaticOrder {
    int nM, nN, nwg, G, c;
    __host__ __device__ void init(int M_, int N_, int G_, int c_) { nM = M_ / BM; nN = N_ / BM; nwg = nM * nN; G = G_; c = c_; }
    __host__ __device__ bool next(int i, Unit& u) const {
        const long L = (long)i * G + c; if (L >= nwg) return false;
        int wgid = (int)L; { const int q = nwg / NXCD, r = nwg % NXCD, xcd = wgid % NXCD, off = wgid / NXCD; wgid = (xcd < r ? xcd * (q + 1) : r * (q + 1) + (xcd - r) * q) + off; }
        const int nig = WGM * nN, gid = wgid / nig, fm = gid * WGM, gsz = (nM - fm) < WGM ? (nM - fm) : WGM;
        u.pm = fm + ((wgid % nig) % gsz); u.pn = (wgid % nig) / gsz; return true;
    }
    __device__ __forceinline__ void a_ready(const Unit&) const {}
    __device__ __forceinline__ void done(const Unit&) const {}
    __device__ __forceinline__ size_t aoff(const Unit& u, size_t tstep, size_t) const { return (size_t)u.pm * tstep; }
    __device__ __forceinline__ size_t boff(const Unit& u, size_t tstep, size_t) const { return (size_t)u.pn * tstep; }
};
struct SplitKOrder {
    int G, c, nunits, nsplit;
    __device__ void init(int M_, int nsplit_, int G_, int c_) { nsplit = nsplit_; nunits = (M_ / BM) * nsplit_; G = G_; c = c_; }
    __device__ bool next(int i, Unit& u) const { const int L = i * G + c; if (L >= nunits) return false; u.pm = L / nsplit; u.pn = L % nsplit; return true; }
    __device__ __forceinline__ void a_ready(const Unit&) const {}
    __device__ __forceinline__ size_t aoff(const Unit& u, size_t tstep, size_t kspan) const { return (size_t)u.pm * tstep + (size_t)u.pn * kspan; }
    __device__ __forceinline__ size_t boff(const Unit& u, size_t, size_t kspan) const { return (size_t)u.pn * kspan; }
};

template <class Epi, class Sched>
__device__ __forceinline__ void gemm_phase(LAS unsigned char* lds, const Gemm g, const Sched& S, const Epi& E) {
    const int tid_ = my_tid();
    const int tid = tid_, wid = __builtin_amdgcn_readfirstlane(tid >> 6), lane = tid & 63, wr = wid >> 2, wc = wid & 3, fr = lane & 15, fq = lane >> 4;
    const int K = g.K, nt = K / BK;
    unsigned voffA[2], voffB[2];
#pragma unroll
    for (int i = 0; i < 2; ++i) { int R, C; stage_rc(tid * 16 + i * 8192, R, C); const int Rb = Epi::PERM ? ((R & ~31) + perm32(R & 31)) : R;
        voffA[i] = (unsigned)(R * 64 + C) * 2u; voffB[i] = (unsigned)(Rb * 64 + C) * 2u; }
    const size_t kstep = (size_t)(BM * BK * 2);
    const size_t hstep = (size_t)HALF * BK * 2;
    const size_t tstep = (size_t)BM * g.Kld * 2, kspan = (size_t)nt * kstep;
    const unsigned ldsw = (unsigned)wid * 1024u;
    const int aoff = lds_byte(wr * 64 + fr, fq * 8), boff = lds_byte(wc * 32 + fr, fq * 8);
#define PG8_SA(b, h) (((b) * 2 + (h)) * HTB)
#define PG8_SB(b, h) ((4 + (b) * 2 + (h)) * HTB)
#define PG8_STAGE(bufoff, gbase, voff) do { _Pragma("unroll") for (int _i = 0; _i < 2; ++_i) \
        __builtin_amdgcn_global_load_lds((const unsigned*)((const char*)(gbase) + (voff)[_i]), (LAS unsigned*)(lds + (bufoff) + ldsw + _i * 8192), 16, 0, 0); } while (0)
#define PG8_LDA(dst, b, h) do { _Pragma("unroll") for (int m = 0; m < 4; ++m) _Pragma("unroll") for (int k = 0; k < 2; ++k) dst[m][k] = *(const LAS bf16x8*)(lds + PG8_SA(b, h) + aoff + m * 2048 + k * 1024); } while (0)
#define PG8_LDB(dst, b, h) do { _Pragma("unroll") for (int n = 0; n < 2; ++n) _Pragma("unroll") for (int k = 0; k < 2; ++k) dst[n][k] = *(const LAS bf16x8*)(lds + PG8_SB(b, h) + boff + n * 2048 + k * 1024); } while (0)
#define PG8_MMA(ai, bj, At, Bt) do { __builtin_amdgcn_s_setprio(1); _Pragma("unroll") for (int m = 0; m < 4; ++m) _Pragma("unroll") for (int n = 0; n < 2; ++n) _Pragma("unroll") for (int k = 0; k < 2; ++k) \
        acc[ai][bj][m][n] = __builtin_amdgcn_mfma_f32_16x16x32_bf16(Bt[n][k], At[m][k], acc[ai][bj][m][n], 0, 0, 0); __builtin_amdgcn_s_setprio(0); } while (0)
#define PG8_WAIT_V(n) asm volatile("s_waitcnt vmcnt(" #n ")" ::: "memory")
#define PG8_WAIT_L(n) asm volatile("s_waitcnt lgkmcnt(" #n ")" ::: "memory")
#define PG8_BAR __builtin_amdgcn_s_barrier()
#define PG8_SCHED __builtin_amdgcn_sched_barrier(0)
    Unit cur, nxt; int ui = 0;
    if (!S.next(0, cur)) return;
    f32x4 acc[2][2][4][2];
#pragma unroll
    for (int a = 0; a < 2; ++a)
#pragma unroll
        for (int b = 0; b < 2; ++b)
#pragma unroll
            for (int m = 0; m < 4; ++m)
#pragma unroll
                for (int n = 0; n < 2; ++n) acc[a][b][m][n] = (f32x4){0.f, 0.f, 0.f, 0.f};
    bf16x8 At[4][2], B0[2][2], B1[2][2];
    const char* cA = (const char*)g.A + S.aoff(cur, tstep, kspan); const char* cB = (const char*)g.Bt + S.boff(cur, tstep, kspan);
    S.a_ready(cur);
    PG8_STAGE(PG8_SB(0, 0), cB, voffB); PG8_STAGE(PG8_SB(0, 1), cB + hstep, voffB); PG8_STAGE(PG8_SA(0, 0), cA, voffA); PG8_STAGE(PG8_SA(0, 1), cA + hstep, voffA);
    if (wr == 1) PG8_BAR;
    PG8_WAIT_V(2); PG8_BAR;
    PG8_STAGE(PG8_SB(1, 0), cB + kstep, voffB); PG8_STAGE(PG8_SA(1, 0), cA + kstep, voffA); PG8_STAGE(PG8_SB(1, 1), cB + hstep + kstep, voffB);
    PG8_WAIT_V(6); PG8_BAR;
    for (;;) {
        const bool has_next = S.next(ui + 1, nxt);
        const char* nA = has_next ? (const char*)g.A + S.aoff(nxt, tstep, kspan) : cA; const char* nB = has_next ? (const char*)g.Bt + S.boff(nxt, tstep, kspan) : cB;
        for (int t = 0; t < nt; t += 2) {
            const bool last = (t == nt - 2);
            const char* a1 = cA + (size_t)(t + 1) * kstep;
            const char* a2 = last ? nA : cA + (size_t)(t + 2) * kstep; const char* b2 = last ? nB : cB + (size_t)(t + 2) * kstep;
            const char* a3 = a2 + kstep; const char* b3 = b2 + kstep;
            if (last && has_next) S.a_ready(nxt);
            PG8_LDB(B0, 0, 0); PG8_LDB(B1, 0, 1); PG8_SCHED; PG8_LDA(At, 0, 0); PG8_STAGE(PG8_SA(1, 1), a1 + hstep, voffA);
            PG8_WAIT_V(8); PG8_WAIT_L(0); PG8_BAR; PG8_MMA(0, 0, At, B0); if constexpr (!Epi::HALF_ALL) PG8_MMA(0, 1, At, B1); PG8_BAR; PG8_SCHED;
            PG8_LDA(At, 0, 1); PG8_STAGE(PG8_SB(0, 0), b2, voffB); PG8_STAGE(PG8_SB(0, 1), b2 + hstep, voffB); PG8_STAGE(PG8_SA(0, 0), a2, voffA);
            PG8_WAIT_V(8); PG8_WAIT_L(0); PG8_BAR; PG8_MMA(1, 0, At, B0); if constexpr (!Epi::HALF_ALL) PG8_MMA(1, 1, At, B1); PG8_BAR; PG8_SCHED;
            PG8_LDB(B0, 1, 0); PG8_LDB(B1, 1, 1); PG8_SCHED; PG8_LDA(At, 1, 0); PG8_STAGE(PG8_SA(0, 1), a2 + hstep, voffA);
            PG8_WAIT_V(8); PG8_WAIT_L(0); PG8_BAR; PG8_MMA(0, 0, At, B0); if constexpr (!Epi::HALF_ALL) PG8_MMA(0, 1, At, B1); PG8_BAR; PG8_SCHED;
            PG8_LDA(At, 1, 1); PG8_STAGE(PG8_SB(1, 0), b3, voffB); PG8_STAGE(PG8_SB(1, 1), b3 + hstep, voffB); PG8_STAGE(PG8_SA(1, 0), a3, voffA);
            PG8_WAIT_V(8); PG8_WAIT_L(0); PG8_BAR; PG8_MMA(1, 0, At, B0); if constexpr (!Epi::HALF_ALL) PG8_MMA(1, 1, At, B1); PG8_BAR; PG8_SCHED;
        }
        if (wr == 0) PG8_BAR;
        E(acc, cur, wr, wc, fr, fq);
        if (!has_next) break;
#pragma unroll
        for (int a = 0; a < 2; ++a)
#pragma unroll
            for (int b = 0; b < 2; ++b)
#pragma unroll
                for (int m = 0; m < 4; ++m)
#pragma unroll
                    for (int n = 0; n < 2; ++n) acc[a][b][m][n] = (f32x4){0.f, 0.f, 0.f, 0.f};
        cur = nxt; cA = nA; cB = nB; ++ui;
        if (wr == 1) PG8_BAR;
    }
    PG8_WAIT_V(0);
    PG8_BAR;
#undef PG8_SA
#undef PG8_SB
#undef PG8_STAGE
#undef PG8_LDA
#undef PG8_LDB
#undef PG8_MMA
#undef PG8_WAIT_V
#undef PG8_WAIT_L
#undef PG8_BAR
#undef PG8_SCHED
}
}

__device__ __forceinline__ void rs_panel(const float* SSQP, int pm, LAS float* rsl, volatile LAS int* tag, int tid, float* rsg = nullptr) {
    if (*tag == pm) return;
    const int row = tid >> 1, h = tid & 1; const float* p = SSQP + (size_t)(h * 32) * M + pm * 256 + row; float s = 0.f;
#pragma unroll 8
    for (int j = 0; j < 32; ++j) s += p[(size_t)j * M];
    s += DPPF(s, 0xB1);
    __syncthreads();
    if (h == 0) { const float rv = 1.f / sqrtf(s * (1.f / DM) + EPS); rsl[row] = rv; if (rsg) rsg[pm * 256 + row] = rv; }
    if (tid == 0) *tag = pm;
    __syncthreads();
}
struct EpiResidBf {
    static constexpr bool PERM = true; static constexpr bool HALF_ALL = false;
    bf16_t* XR; float* SSQP;
    __device__ __forceinline__ void operator()(const f32x4 (&acc)[2][2][4][2], const pg8::Unit& u, int wr, int wc, int fr, int fq) const {
        const int row0 = u.pm * 256 + wr * 64 + fr, col0 = u.pn * 256 + wc * 32 + 8 * fq;
#pragma unroll
        for (int ai = 0; ai < 2; ++ai) {
            u32x4 xr[4][2]; float ssv[4];
#pragma unroll
            for (int m = 0; m < 4; ++m)
#pragma unroll
                for (int bj = 0; bj < 2; ++bj) xr[m][bj] = *(const u32x4*)(XR + tiled_off((size_t)(row0 + ai * 128 + m * 16), col0, DM) + (size_t)bj * 2 * 256 * 64);
#pragma unroll
            for (int m = 0; m < 4; ++m) { bf16_t* rowp = XR + tiled_off((size_t)(row0 + ai * 128 + m * 16), col0, DM); float ss = 0.f;
#pragma unroll
                for (int bj = 0; bj < 2; ++bj) { const u32x4 x = xr[m][bj];
                    const f32x4 a0 = acc[ai][bj][m][0], a1 = acc[ai][bj][m][1];
                    u32x4 o; o.x = cvt_pk_bf16(bf_lo(x.x) + a0[0], bf_hi(x.x) + a0[1]); o.y = cvt_pk_bf16(bf_lo(x.y) + a0[2], bf_hi(x.y) + a0[3]);
                    o.z = cvt_pk_bf16(bf_lo(x.z) + a1[0], bf_hi(x.z) + a1[1]); o.w = cvt_pk_bf16(bf_lo(x.w) + a1[2], bf_hi(x.w) + a1[3]);
                    *(u32x4*)(rowp + (size_t)bj * 2 * 256 * 64) = o;
                    ss += bf_lo(o.x) * bf_lo(o.x) + bf_hi(o.x) * bf_hi(o.x) + bf_lo(o.y) * bf_lo(o.y) + bf_hi(o.y) * bf_hi(o.y)
                        + bf_lo(o.z) * bf_lo(o.z) + bf_hi(o.z) * bf_hi(o.z) + bf_lo(o.w) * bf_lo(o.w) + bf_hi(o.w) * bf_hi(o.w); }
                ssv[m] = xrow16_sum(ss); }
            if (fq == 0) {
#pragma unroll
                for (int m = 0; m < 4; ++m) SSQP[(size_t)(u.pn * 4 + wc) * M + row0 + ai * 128 + m * 16] = ssv[m]; }
        }
    }
};
struct EpiFinal {
    static constexpr bool PERM = true; static constexpr bool HALF_ALL = false;
    const bf16_t* XR; float* out;
    __device__ __forceinline__ void operator()(const f32x4 (&acc)[2][2][4][2], const pg8::Unit& u, int wr, int wc, int fr, int fq) const {
        const int row0 = u.pm * 256 + wr * 64 + fr, col0 = u.pn * 256 + wc * 32 + 8 * fq;
#pragma unroll
        for (int ai = 0; ai < 2; ++ai) {
          u32x4 xr[4][2];
#pragma unroll
          for (int m = 0; m < 4; ++m)
#pragma unroll
              for (int bj = 0; bj < 2; ++bj) xr[m][bj] = *(const u32x4*)(XR + tiled_off((size_t)(row0 + ai * 128 + m * 16), col0, DM) + (size_t)bj * 2 * 256 * 64);
#pragma unroll
            for (int m = 0; m < 4; ++m) { const int row = row0 + ai * 128 + m * 16; float* op = out + (size_t)row * DM + col0;
#pragma unroll
                for (int bj = 0; bj < 2; ++bj) { const u32x4 x = xr[m][bj];
                    const f32x4 a0 = acc[ai][bj][m][0], a1 = acc[ai][bj][m][1];
                    *(f32x4*)(op + bj * 128) = (f32x4){bf_lo(x.x) + a0[0], bf_hi(x.x) + a0[1], bf_lo(x.y) + a0[2], bf_hi(x.y) + a0[3]};
                    *(f32x4*)(op + bj * 128 + 4) = (f32x4){bf_lo(x.z) + a1[0], bf_hi(x.z) + a1[1], bf_lo(x.w) + a1[2], bf_hi(x.w) + a1[3]}; } }
        }
    }
};
struct EpiRelu2 {
    static constexpr bool PERM = true; static constexpr bool HALF_ALL = false;
    bf16_t* O; const float* SSQP; LAS float* rsl; volatile LAS int* tag;
    __device__ __forceinline__ void operator()(const f32x4 (&acc)[2][2][4][2], const pg8::Unit& u, int wr, int wc, int fr, int fq) const {
        const int row0 = u.pm * 256 + wr * 64 + fr, col0 = u.pn * 256 + wc * 32 + 8 * fq;
        rs_panel(SSQP, u.pm, rsl, tag, (wr * 4 + wc) * 64 + fq * 16 + fr);
        float rsv[8];
#pragma unroll
        for (int q = 0; q < 8; ++q) rsv[q] = rsl[wr * 64 + fr + (q >> 2) * 128 + (q & 3) * 16];
#pragma unroll
        for (int ai = 0; ai < 2; ++ai)
#pragma unroll
            for (int m = 0; m < 4; ++m) { bf16_t* rowp = O + tiled_off((size_t)(row0 + ai * 128 + m * 16), col0, FF);
#pragma unroll
                for (int bj = 0; bj < 2; ++bj) { const float rs = rsv[ai * 4 + m]; f32x4 v0 = acc[ai][bj][m][0] * rs, v1 = acc[ai][bj][m][1] * rs;
#pragma unroll
                    for (int j = 0; j < 4; ++j) { const float a = fmaxf(v0[j], 0.f), b = fmaxf(v1[j], 0.f); v0[j] = a * a; v1[j] = b * b; }
                    u32x4 o; o.x = cvt_pk_bf16(v0[0], v0[1]); o.y = cvt_pk_bf16(v0[2], v0[3]); o.z = cvt_pk_bf16(v1[0], v1[1]); o.w = cvt_pk_bf16(v1[2], v1[3]);
                    *(u32x4*)(rowp + (size_t)bj * 2 * 256 * 64) = o; } }
    }
};
struct EpiOddPart {
    static constexpr bool PERM = true; static constexpr bool HALF_ALL = true;
    float* ODDP;
    __device__ __forceinline__ void operator()(const f32x4 (&acc)[2][2][4][2], const pg8::Unit& u, int wr, int wc, int fr, int fq) const {
        const int row0 = u.pm * 256 + wr * 64 + fr, c0 = wc * 32 + 8 * fq;
        if (c0 >= 96) return;
#pragma unroll
        for (int ai = 0; ai < 2; ++ai)
#pragma unroll
            for (int m = 0; m < 4; ++m) { float* p = ODDP + ((size_t)u.pn * M + row0 + ai * 128 + m * 16) * 128 + c0; *(f32x4*)p = acc[ai][0][m][0]; *(f32x4*)(p + 4) = acc[ai][0][m][1]; }
    }
};
struct EpiInProj {
    static constexpr bool PERM = true; static constexpr bool HALF_ALL = false;
    bf16_t* PROJ; float* GLOG; float* ODD; const float* lb; const float* gbias; const float* SSQP;
    const float* gcqk; const float* gdqk; LAS float* xch; LAS float* rsl; volatile LAS int* tag; float* RSG;
    __device__ __forceinline__ void operator()(const f32x4 (&acc)[2][2][4][2], const pg8::Unit& u, int wr, int wc, int fr, int fq) const {
        const int row0 = u.pm * 256 + wr * 64 + fr; const int pn = u.pn;
        const int seg = pn >> 2;
        rs_panel(SSQP, u.pm, rsl, tag, (wr * 4 + wc) * 64 + fq * 16 + fr, RSG);
        float rsv[8];
#pragma unroll
        for (int q = 0; q < 8; ++q) rsv[q] = rsl[wr * 64 + fr + (q >> 2) * 128 + (q & 3) * 16];
        int kind = 0;
        if (pn >= 56) kind = 6; else if (seg == 0) kind = 1; else if (seg == 1) kind = 5; else if (seg == 3) kind = 2; else if (seg == 6) kind = 3; else if (seg == 13) kind = 4; else if (seg == 7 || seg == 8 || seg == 10 || seg == 11) kind = 7;
        if (kind == 6) {
            const int c0 = wc * 32 + 8 * fq;
            if (c0 >= 96) return;
#pragma unroll
            for (int ai = 0; ai < 2; ++ai)
#pragma unroll
                for (int m = 0; m < 4; ++m) { float* rowp = ODD + (size_t)(row0 + ai * 128 + m * 16) * LDO + c0;
                    const float rs = rsv[ai * 4 + m]; f32x4 v0 = acc[ai][0][m][0] * rs, v1 = acc[ai][0][m][1] * rs;
                    if (c0 >= 64 && c0 < 80) { v0 = v0 * 0.25f; v1 = v1 * 0.25f; }
                    else if (c0 == 80) {
#pragma unroll
                        for (int j = 0; j < 4; ++j) { v0[j] += gbias[j]; v1[j] += gbias[4 + j]; } }
                    else if (c0 == 88) {
#pragma unroll
                        for (int j = 0; j < 4; ++j) { const float a = v0[j] + gbias[8 + j], b = v1[j] + gbias[12 + j];
                            v0[j] = fminf(a, 0.f) - __logf(1.f + __expf(-fabsf(a))); v1[j] = fminf(b, 0.f) - __logf(1.f + __expf(-fabsf(b))); } }
                    *(f32x4*)rowp = v0; *(f32x4*)(rowp + 4) = v1; }
            return;
        }
        const int col0 = pn * 256 + wc * 32 + 8 * fq;
        if (kind == 7) {
            const float* gp = ((seg < 9) ? gcqk : gdqk) + ((seg == 8 || seg == 11) ? 128 : 0) + wc * 32 + 8 * fq;
            const f32x4 g0 = *(const f32x4*)gp, g1 = *(const f32x4*)(gp + 4);
            float ssv[16];
#pragma unroll
            for (int ai = 0; ai < 2; ++ai)
#pragma unroll
                for (int m = 0; m < 4; ++m)
#pragma unroll
                    for (int bj = 0; bj < 2; ++bj) { const f32x4 a0 = acc[ai][bj][m][0], a1 = acc[ai][bj][m][1];
                        const float ss = (a0[0] * a0[0] + a0[1] * a0[1]) + (a0[2] * a0[2] + a0[3] * a0[3]) + (a1[0] * a1[0] + a1[1] * a1[1]) + (a1[2] * a1[2] + a1[3] * a1[3]);
                        ssv[(ai * 4 + m) * 2 + bj] = xrow16_sum(ss); }
            if (fq == 0) {
#pragma unroll
                for (int q = 0; q < 16; ++q) xch[((((q >> 3) * 128 + wr * 64 + ((q >> 1) & 3) * 16 + fr) * 2 + (q & 1)) * 4) + wc] = ssv[q];
            }
            __syncthreads();
#pragma unroll
            for (int ai = 0; ai < 2; ++ai)
#pragma unroll
                for (int m = 0; m < 4; ++m) { bf16_t* rowp = PROJ + (size_t)(row0 + ai * 128 + m * 16) * LDP + col0; const float rs = rsv[ai * 4 + m];
#pragma unroll
                    for (int bj = 0; bj < 2; ++bj) { const f32x4 pq = *(const LAS f32x4*)(xch + ((ai * 128 + wr * 64 + m * 16 + fr) * 2 + bj) * 4);
                        const float rn = rs * __builtin_amdgcn_rsqf(rs * rs * ((pq[0] + pq[1]) + (pq[2] + pq[3])) * (1.f / 128.f) + EPS);
                        const f32x4 v0 = acc[ai][bj][m][0] * rn * g0, v1 = acc[ai][bj][m][1] * rn * g1;
                        u32x4 o; o.x = cvt_pk_bf16(v0[0], v0[1]); o.y = cvt_pk_bf16(v0[2], v0[3]); o.z = cvt_pk_bf16(v1[0], v1[1]); o.w = cvt_pk_bf16(v1[2], v1[3]);
                        *(u32x4*)(rowp + bj * 128) = o; } }
            return;
        }
        if (kind == 5) {
            const int lc = col0 - C_AF;
            f32x4 l0[2], l1[2];
#pragma unroll
            for (int bj = 0; bj < 2; ++bj) { l0[bj] = *(const f32x4*)(lb + lc + bj * 128); l1[bj] = *(const f32x4*)(lb + lc + bj * 128 + 4); }
#pragma unroll
            for (int ai = 0; ai < 2; ++ai)
#pragma unroll
                for (int m = 0; m < 4; ++m) { float* rowp = GLOG + (size_t)(row0 + ai * 128 + m * 16) * 1024 + lc;
#pragma unroll
                    for (int bj = 0; bj < 2; ++bj) { const float rs = rsv[ai * 4 + m]; f32x4 v0 = acc[ai][bj][m][0] * rs, v1 = acc[ai][bj][m][1] * rs;
#pragma unroll
                        for (int j = 0; j < 4; ++j) { const float fa = l0[bj][j] + (1.f - l0[bj][j]) * fast_sigmoid(v0[j]), fb = l1[bj][j] + (1.f - l1[bj][j]) * fast_sigmoid(v1[j]);
                            v0[j] = __logf(fmaxf(fa, 1e-20f)); v1[j] = __logf(fmaxf(fb, 1e-20f)); }
                        *(f32x4*)(rowp + bj * 128) = v0; *(f32x4*)(rowp + bj * 128 + 4) = v1; } }
            return;
        }
#pragma unroll
        for (int ai = 0; ai < 2; ++ai)
#pragma unroll
            for (int m = 0; m < 4; ++m) { bf16_t* rowp = PROJ + (size_t)(row0 + ai * 128 + m * 16) * LDP + col0;
#pragma unroll
                for (int bj = 0; bj < 2; ++bj) { const float rs = rsv[ai * 4 + m]; f32x4 v0 = acc[ai][bj][m][0] * rs, v1 = acc[ai][bj][m][1] * rs;
                    if (kind == 1) {
#pragma unroll
                        for (int j = 0; j < 4; ++j) { v0[j] = fast_silu(v0[j]) * 0.08838834764831845f; v1[j] = fast_silu(v1[j]) * 0.08838834764831845f; } }
                    else if (kind == 2) {
#pragma unroll
                        for (int j = 0; j < 4; ++j) { v0[j] = fast_silu(v0[j]); v1[j] = fast_silu(v1[j]); } }
                    else if (kind == 3) {
#pragma unroll
                        for (int j = 0; j < 4; ++j) { v0[j] = fast_sigmoid(v0[j]); v1[j] = fast_sigmoid(v1[j]); } }
                    else if (kind == 4) { v0 = v0 * 0.015625f; v1 = v1 * 0.015625f; }
                    u32x4 o; o.x = cvt_pk_bf16(v0[0], v0[1]); o.y = cvt_pk_bf16(v0[2], v0[3]); o.z = cvt_pk_bf16(v1[0], v1[1]); o.w = cvt_pk_bf16(v1[2], v1[3]);
                    *(u32x4*)(rowp + bj * 128) = o; } }
    }
};


namespace att {
constexpr int D = 128, NW = 8, QBLK = 32, KVBLK = 64, QB = NW * QBLK;
constexpr int SHM_V = KVBLK * D * 2, SHM_K = KVBLK * D * 2;
constexpr int ATT_LDS = 2 * SHM_V + 2 * SHM_K + NW * 64 * 4;
constexpr float SCALE = 0.08838834764831845f, THR = 8.f;
#define KSWZ(row, colB) ((row) * 256 + ((colB) ^ (((row) & 7) << 4)))
#define SBAR() __builtin_amdgcn_sched_barrier(0)
__device__ __forceinline__ int v_st(int k, int c) { const int kk = (k & ~0xC) | ((k & 4) << 1) | ((k & 8) >> 1); return ((kk >> 3) * 4 + (c >> 5)) * 512 + ((kk & 7) * 32 + (c & 31)) * 2; }
__device__ __forceinline__ int v_rd_base(int lane) { return ((lane & 3) << 3) | (((lane >> 2) & 3) << 6) | (((lane >> 4) & 1) << 5) | (((lane >> 5) & 1) << 8); }
constexpr int v_rd_off(int d0, int ks, int half) { return d0 * 512 + ks * 4096 + half * 2048; }
__device__ __forceinline__ int crow(int r, int hi) { return (r & 3) + 8 * (r >> 2) + 4 * hi; }
__device__ __forceinline__ bf16x8 ld8(const bf16_t* p) { return *reinterpret_cast<const bf16x8*>(p); }
__device__ __forceinline__ void partialSM(f32x16& p0, f32x16& p1, float& m_reg, float& mn, float& alpha) {
    float pmax = p0[0];
#pragma unroll
    for (int r = 1; r < 16; ++r) pmax = fmaxf(pmax, p0[r]);
#pragma unroll
    for (int r = 0; r < 16; ++r) pmax = fmaxf(pmax, p1[r]);
    { auto rr = __builtin_amdgcn_permlane32_swap(__float_as_uint(pmax), __float_as_uint(pmax), false, false);
      pmax = fmaxf(__uint_as_float(rr[0]), __uint_as_float(rr[1])); }
    constexpr float C2 = 1.4426950408889634f * SCALE;
    if (__builtin_expect(__all((pmax - m_reg) * SCALE <= THR), 1)) { mn = m_reg; alpha = 1.f; }
    else { mn = fmaxf(m_reg, pmax); alpha = __builtin_amdgcn_exp2f((m_reg - mn) * C2); m_reg = mn; }
    const float mnL = -mn * C2;
#pragma unroll
    for (int r = 0; r < 16; ++r) p0[r] = fmaf(p0[r], C2, mnL);
#pragma unroll
    for (int r = 0; r < 16; ++r) p1[r] = fmaf(p1[r], C2, mnL);
#pragma unroll
    for (int r = 0; r < 16; ++r) p0[r] = __builtin_amdgcn_exp2f(p0[r]);
}
__device__ __forceinline__ void finishSM(f32x16& p0, f32x16& p1, float alpha, float& l_reg, bf16x8& pa0, bf16x8& pa1, bf16x8& pa2, bf16x8& pa3) {
#pragma unroll
    for (int r = 0; r < 16; ++r) p1[r] = __builtin_amdgcn_exp2f(p1[r]);
    float ps = 0;
#pragma unroll
    for (int r = 0; r < 16; ++r) ps += p0[r];
#pragma unroll
    for (int r = 0; r < 16; ++r) ps += p1[r];
    { auto rr = __builtin_amdgcn_permlane32_swap(__float_as_uint(ps), __float_as_uint(ps), false, false);
      ps = __uint_as_float(rr[0]) + __uint_as_float(rr[1]); }
    l_reg = l_reg * alpha + ps;
#define PK4(P, B_, OUT) do { unsigned a0 = cvt_pk_bf16(P[B_+0], P[B_+1]), a1 = cvt_pk_bf16(P[B_+2], P[B_+3]);                          \
        unsigned b0 = cvt_pk_bf16(P[B_+4], P[B_+5]), b1 = cvt_pk_bf16(P[B_+6], P[B_+7]);                                             \
        auto r0 = __builtin_amdgcn_permlane32_swap(a0, b0, false, false); auto r1 = __builtin_amdgcn_permlane32_swap(a1, b1, false, false); \
        u32x4 w = {r0[0], r1[0], r0[1], r1[1]}; OUT = *reinterpret_cast<bf16x8*>(&w); } while (0)
    PK4(p0, 0, pa0); PK4(p0, 8, pa1); PK4(p1, 0, pa2); PK4(p1, 8, pa3);
#undef PK4
}
template <int KB>
__device__ __forceinline__ void qkt(f32x16& p0, f32x16& p1, const char* K_lds, int r32, int hi, const bf16x8* qr) {
    p0 = f32x16{}; p1 = f32x16{};
    const char* kb[4];
#pragma unroll
    for (int dd = 0; dd < 4; ++dd) kb[dd] = K_lds + KB * SHM_K + KSWZ(r32, (dd * 16 + hi * 8) * 2);
#pragma unroll
    for (int d0 = 0; d0 < 8; ++d0) { const char* a = kb[d0 & 3] + (d0 >> 2) * 128;
        bf16x8 b0 = *reinterpret_cast<const bf16x8*>(a);
        bf16x8 b1 = *reinterpret_cast<const bf16x8*>(a + 32 * 256);
        p0 = __builtin_amdgcn_mfma_f32_32x32x16_bf16(b0, qr[d0], p0, 0, 0, 0);
        p1 = __builtin_amdgcn_mfma_f32_32x32x16_bf16(b1, qr[d0], p1, 0, 0, 0); }
}
template <int VB>
__device__ __forceinline__ void pv_tile(f32x16* o, int vb0, bf16x8 pa0, bf16x8 pa1, bf16x8 pa2, bf16x8 pa3) {
#define TRRD(dst, off) asm volatile("ds_read_b64_tr_b16 %0, %1 offset:%2" : "=&v"(dst) : "v"(vb0), "i"(off) : "memory")
#define PV_D0(d0) do { s16x4 l0, l1, l2, l3, h0, h1, h2, h3; constexpr int b_ = VB * SHM_V + v_rd_off(d0, 0, 0); \
        TRRD(l0, b_); TRRD(h0, b_ + 2048); TRRD(l1, b_ + 4096); TRRD(h1, b_ + 6144); TRRD(l2, b_ + 8192); TRRD(h2, b_ + 10240); TRRD(l3, b_ + 12288); TRRD(h3, b_ + 14336); \
        asm volatile("s_waitcnt lgkmcnt(0)" ::: "memory"); SBAR();   \
        o[d0] = __builtin_amdgcn_mfma_f32_32x32x16_bf16(pa0, (bf16x8){l0[0], l0[1], l0[2], l0[3], h0[0], h0[1], h0[2], h0[3]}, o[d0], 0, 0, 0);   \
        o[d0] = __builtin_amdgcn_mfma_f32_32x32x16_bf16(pa1, (bf16x8){l1[0], l1[1], l1[2], l1[3], h1[0], h1[1], h1[2], h1[3]}, o[d0], 0, 0, 0);   \
        o[d0] = __builtin_amdgcn_mfma_f32_32x32x16_bf16(pa2, (bf16x8){l2[0], l2[1], l2[2], l2[3], h2[0], h2[1], h2[2], h2[3]}, o[d0], 0, 0, 0);   \
        o[d0] = __builtin_amdgcn_mfma_f32_32x32x16_bf16(pa3, (bf16x8){l3[0], l3[1], l3[2], l3[3], h3[0], h3[1], h3[2], h3[3]}, o[d0], 0, 0, 0); } while (0)
    PV_D0(0); PV_D0(1); PV_D0(2); PV_D0(3);
#undef PV_D0
#undef TRRD
}
template <class TOut> struct BlockRef { const bf16_t* Q; const bf16_t* K; const bf16_t* V; TOut* O; const unsigned* MK; int P0; int orow, ocol; };
struct Seam { bf16x8 qr[8]; bf16x8 st_v0, st_v1, st_k0, st_k1; };
#define ROW(p, k0, rr) ((p) + (size_t)((k0) + (rr)) * LDP + sc)
#define VMW() asm volatile("s_waitcnt vmcnt(0)" ::: "memory")
#define VMWN(n) asm volatile("s_waitcnt vmcnt(%0)" :: "i"(n) : "memory")
#define SLOAD_H(Kp, Vp, k0) do { S.st_v0 = ld8(ROW(Vp, k0, sr)); S.st_v1 = ld8(ROW(Vp, k0, 32 + sr)); S.st_k0 = ld8(ROW(Kp, k0, sr)); S.st_k1 = ld8(ROW(Kp, k0, 32 + sr)); } while (0)
#define SWRITE_HK(bf) do { *(bf16x8*)(K_lds + (bf) * SHM_K + kws) = S.st_k0; *(bf16x8*)(K_lds + (bf) * SHM_K + kws + 32 * 256) = S.st_k1; } while (0)
#define SWRITE_HV(bf) do { *(bf16x8*)(V_lds + (bf) * SHM_V + vst0) = S.st_v0; *(bf16x8*)(V_lds + (bf) * SHM_V + vst1) = S.st_v1; } while (0)
#define SWRITE_H(bf) do { SWRITE_HV(bf); SWRITE_HK(bf); } while (0)
template <class TOut>
__device__ __forceinline__ void attn_prime(const BlockRef<TOut>& cur, char* lds, Seam& S) {
    const int tid_ = my_tid();
    const int tid = tid_, wid = __builtin_amdgcn_readfirstlane(tid >> 6), lane = tid & 63, r32 = lane & 31, hi = lane >> 5;
    const int sr = tid >> 4, sc = (tid & 15) * 8, kws = KSWZ(sr, sc * 2); char* K_lds = lds + 2 * SHM_V;
#pragma unroll
    for (int d0 = 0; d0 < 8; ++d0) S.qr[d0] = ld8(cur.Q + (size_t)(wid * QBLK + r32) * LDP + d0 * 16 + hi * 8);
    SLOAD_H(cur.K, cur.V, 0); VMW(); SWRITE_HK(0);
    __syncthreads();
}
template <class TOut, bool BM, int OS>
__device__ __forceinline__ void attn_block(const BlockRef<TOut>& cur, const BlockRef<TOut>& nxt, char* lds, Seam& S) {
    const int tid_ = my_tid();
    const int tid = tid_, wid = __builtin_amdgcn_readfirstlane(tid >> 6), lane = tid & 63, r32 = lane & 31, hi = lane >> 5;
    const int NT = (cur.P0 + QB - 1) / KVBLK + 1;
    const int qlo = cur.P0 + wid * QBLK;
    const int klim = (qlo & ~63) + 64;
    char* V_lds = lds; char* K_lds = lds + 2 * SHM_V;
    float* wsl = (float*)(lds + 2 * SHM_V + 2 * SHM_K) + wid * 64; float* li_l = wsl, * al_l = wsl + 32;
    float m_reg = -1e30f, l_reg = 0; f32x16 o[4] = {};
    const int sr = tid >> 4, sc = (tid & 15) * 8, vst0 = v_st(sr, sc), vst1 = v_st(32 + sr, sc), kws = KSWZ(sr, sc * 2);
    const int vb0 = (int)(uintptr_t)V_lds + v_rd_base(lane);
    const bf16_t* Kh = cur.K; const bf16_t* Vh = cur.V;
    const unsigned moff = (unsigned)(qlo + r32) * 4u;
    unsigned mw0 = 0, mw1 = 0;
#define RESC(a) do { if (__any((a) < 1.f)) { if (hi == 0) al_l[r32] = (a); asm volatile("s_waitcnt lgkmcnt(0)" ::: "memory");              \
                     _Pragma("unroll") for (int d_ = 0; d_ < 4; ++d_) _Pragma("unroll") for (int r = 0; r < 16; ++r) o[d_][r] *= al_l[crow(r, hi)]; } } while (0)
#define KBASE(t) ((t) * KVBLK)
#define MLOAD(t) do { if (BM) { const char* mb_ = (const char*)cur.MK + (size_t)(2 * (t)) * (T * 4); mw0 = *(const unsigned*)(mb_ + (size_t)moff); mw1 = *(const unsigned*)(mb_ + (size_t)(T * 4) + (size_t)moff); } } while (0)
#define MASKT(P0_, P1_, t) do { const float NEGI = -__builtin_inff(); \
        if (KBASE(t) >= klim) { _Pragma("unroll") for (int r = 0; r < 16; ++r) { P0_[r] = NEGI; P1_[r] = NEGI; } } \
        else if (BM) { const unsigned a_ = mw0 >> (4 * hi), b_ = mw1 >> (4 * hi); \
            _Pragma("unroll") for (int r = 0; r < 16; ++r) { const int cb = (r & 3) + 8 * (r >> 2); \
                const unsigned ma_ = (unsigned)__builtin_amdgcn_sbfe((int)a_, cb, 1), mb_ = (unsigned)__builtin_amdgcn_sbfe((int)b_, cb, 1);     \
                P0_[r] = __uint_as_float((__float_as_uint(P0_[r]) & ma_) | (0xFF800000u & ~ma_)); P1_[r] = __uint_as_float((__float_as_uint(P1_[r]) & mb_) | (0xFF800000u & ~mb_)); } } } while (0)
#define SEAM_K0() do { VMWN(8); SWRITE_HK(0); SBAR(); } while (0)
    f32x16 pA0, pA1, pB0, pB1; float mnA, mnB, alA, alB; bf16x8 pa0, pa1, pa2, pa3;
    SWRITE_HV(0); SBAR();
    MLOAD(0);
    if (NT > 1) { SLOAD_H(Kh, Vh, KBASE(1)); }
    SBAR(); qkt<0>(pA0, pA1, K_lds, r32, hi, S.qr);
    if (BM) VMW();
    MASKT(pA0, pA1, 0); partialSM(pA0, pA1, m_reg, mnA, alA);
    if (NT > 1) { VMW(); SWRITE_H(1); }
    __syncthreads();
#define HALF_STEP(PX0, PX1, mnX, alX, PY0, PY1, alY, t, KB, VB, SB) do {                                                      \
        MLOAD(t);                                                                                                             \
        SBAR(); qkt<KB>(PX0, PX1, K_lds, r32, hi, S.qr);                                                                      \
        finishSM(PY0, PY1, alY, l_reg, pa0, pa1, pa2, pa3); SBAR();                                                           \
        if ((t) + 1 < NT) { SLOAD_H(Kh, Vh, KBASE((t) + 1)); SBAR(); }                                                        \
        pv_tile<VB>(o, vb0, pa0, pa1, pa2, pa3);                                                                              \
        if (BM) { if ((t) + 1 < NT) VMWN(4); else VMW(); }                                                                    \
        MASKT(PX0, PX1, (t)); partialSM(PX0, PX1, m_reg, mnX, alX);                                                           \
        __syncthreads();                                                                                                      \
        if ((t) + 1 < NT) { VMW(); SWRITE_H(SB); }                                                                            \
        RESC(alX); __syncthreads(); } while (0)
    for (int t = 1; t + 1 < NT; t += 2) {
        HALF_STEP(pB0, pB1, mnB, alB, pA0, pA1, alA, t, 1, 0, 0);
        HALF_STEP(pA0, pA1, mnA, alA, pB0, pB1, alB, t + 1, 0, 1, 1);
    }
    const bool even = (NT & 1) == 0;
    if (even) { MLOAD(NT - 1); SBAR(); qkt<1>(pB0, pB1, K_lds, r32, hi, S.qr); SBAR(); }
    SLOAD_H(nxt.K, nxt.V, 0); SBAR();
#pragma unroll
    for (int d0 = 0; d0 < 8; ++d0) S.qr[d0] = ld8(nxt.Q + (size_t)(wid * QBLK + r32) * LDP + d0 * 16 + hi * 8);
    SBAR();
    finishSM(pA0, pA1, alA, l_reg, pa0, pa1, pa2, pa3); SBAR();
    pv_tile<0>(o, vb0, pa0, pa1, pa2, pa3);
    if (even) { if (BM) VMWN(12); MASKT(pB0, pB1, NT - 1); partialSM(pB0, pB1, m_reg, mnB, alB); __syncthreads(); RESC(alB);
        finishSM(pB0, pB1, alB, l_reg, pa0, pa1, pa2, pa3); SBAR(); pv_tile<1>(o, vb0, pa0, pa1, pa2, pa3); }
    SBAR(); SEAM_K0();
    if (hi == 0) li_l[r32] = l_reg; asm volatile("s_waitcnt lgkmcnt(0)" ::: "memory");
    float rli[16];
#pragma unroll
    for (int r = 0; r < 16; ++r) rli[r] = __builtin_amdgcn_rcpf(li_l[crow(r, hi)]);
    TOut* obase_ = cur.O; asm volatile("" : "+s"(obase_));
    TOut* Ow = obase_ + (size_t)(wid * QBLK) * OS;
#pragma unroll
    for (int r = 0; r < 16; ++r) { const int orow = crow(r, hi);
#pragma unroll
        for (int d0 = 0; d0 < 4; ++d0) { const float v = o[d0][r] * rli[r];
            if constexpr (sizeof(TOut) == 4) { Ow[(size_t)orow * OS + d0 * 32 + r32] = v; }
            else { const float vn = sx(v, 1, lane);
                   if ((r32 & 1) == 0) *(unsigned*)(obase_ + tiled_off((size_t)(cur.orow + wid * QBLK + orow), cur.ocol + d0 * 32 + r32, OS)) = cvt_pk_bf16(v, vn); } } }
    __syncthreads();
#undef RESC
#undef KBASE
#undef MLOAD
#undef MASKT
#undef SEAM_K0
#undef HALF_STEP
}
#undef ROW
#undef VMW
#undef VMWN
#undef SLOAD_H
#undef SWRITE_HK
#undef SWRITE_HV
#undef SWRITE_H
}

#define XB_TMO      128
#define XB_XCNT(j)  (256  + 64 * (j))
#define XB_XSUB(j)  (1280 + 64 * (j))
#define XB_XGEN(j)  (2304 + 64 * (j))
#define XB_TOP      3328
#define XB_TOPGEN   3392
#define XCD_BAR_WORDS 3456
#define XB_SPIN_CAP (1u << 22)
__device__ __forceinline__ unsigned xb_ld(unsigned* p)              { return __hip_atomic_load(p, __ATOMIC_RELAXED, __HIP_MEMORY_SCOPE_AGENT); }
__device__ __forceinline__ unsigned xb_add(unsigned* p, unsigned v) { return __hip_atomic_fetch_add(p, v, __ATOMIC_RELAXED, __HIP_MEMORY_SCOPE_AGENT); }
__device__ __forceinline__ unsigned xb_xcc_id() { return (unsigned)__builtin_amdgcn_s_getreg((3 << 11) | 20) & 0xFu; }
#define XB_SPIN(cond, bar) do { unsigned _sp = 0; while (cond) { __builtin_amdgcn_s_sleep(1); \
    if ((++_sp & 255u) == 0u) { if (xb_ld(&(bar)[XB_TMO])) break; if (_sp > XB_SPIN_CAP) { atomicAdd(&(bar)[XB_TMO], 1u); break; } } } } while (0)
struct XcdBarrier { unsigned* bar; unsigned x; volatile LAS unsigned* st; };
__device__ __forceinline__ XcdBarrier xcd_barrier_post(unsigned* bar, volatile LAS unsigned* st) {
    XcdBarrier b; b.bar = bar; b.x = xb_xcc_id(); b.st = st;
    if (my_tid() == 0) (void)xb_add(&bar[XB_XCNT(b.x)], 1u);
    return b;
}
__device__ __forceinline__ void xcd_barrier_complete(unsigned* bar, unsigned x, unsigned& nloc, unsigned& nx) {
    const unsigned G = gridDim.x * gridDim.y * gridDim.z;
    unsigned sum, cnt, mine, sp = 0u;
    for (;;) {
        sum = 0u; cnt = 0u; mine = 0u;
#pragma unroll
        for (unsigned j = 0; j < 16; ++j) { const unsigned c = xb_ld(&bar[XB_XCNT(j)]); sum += c; cnt += (c > 0u) ? 1u : 0u; mine = (j == x) ? c : mine; }
        if (sum == G) break;
        __builtin_amdgcn_s_sleep(1);
        if ((++sp & 255u) == 0u) { if (xb_ld(&bar[XB_TMO])) break; if (sp > XB_SPIN_CAP) { atomicAdd(&bar[XB_TMO], 1u); break; } }
    }
    nloc = mine > 0u ? mine : 1u; nx = cnt > 0u ? cnt : 1u;
}
__device__ __forceinline__ void xcd_barrier(const XcdBarrier& b) {
    asm volatile("s_waitcnt vmcnt(0)" ::: "memory");
    __syncthreads();
    if (my_tid() == 0) {
        unsigned* bar = b.bar;
        __builtin_amdgcn_s_waitcnt(0);
        unsigned nloc = b.st[0], nx = b.st[1];
        if (nloc == 0u) { xcd_barrier_complete(bar, b.x, nloc, nx); b.st[0] = nloc; b.st[1] = nx; }
        const unsigned old = xb_add(&bar[XB_XSUB(b.x)], 1u);
        const unsigned gen = old / nloc;
        if (old + 1u == (gen + 1u) * nloc) {
            __builtin_amdgcn_fence(__ATOMIC_RELEASE, "agent");
            asm volatile("s_waitcnt vmcnt(0)" ::: "memory");
            const unsigned og = xb_add(&bar[XB_TOP], 1u);
            const unsigned tg = og / nx;
            if (og + 1u == (tg + 1u) * nx) xb_add(&bar[XB_TOPGEN], 1u);
            else XB_SPIN(xb_ld(&bar[XB_TOPGEN]) == tg, bar);
            __builtin_amdgcn_fence(__ATOMIC_ACQUIRE, "agent");
            xb_add(&bar[XB_XGEN(b.x)], 1u);
            asm volatile("s_waitcnt vmcnt(0)" ::: "memory");
        } else {
            XB_SPIN(xb_ld(&bar[XB_XGEN(b.x)]) == gen, bar);
            __builtin_amdgcn_fence(__ATOMIC_ACQUIRE, "agent");
            asm volatile("s_waitcnt vmcnt(0)" ::: "memory");
        }
    }
    __syncthreads();
}

struct Args {
    const float* in[17]; float* out; unsigned char* ws; int ph_lo, ph_hi;
};
typedef const __attribute__((address_space(4))) Args KA;
#define PH_ARGS() ({ KA* p_ = (KA*)__builtin_amdgcn_kernarg_segment_ptr(); asm volatile("" : "+s"(p_)); p_; })
struct Frame {
    LAS unsigned char* lds; int tid, lane, wave, G, vcu;
};
__device__ __forceinline__ Frame make_frame(LAS unsigned char* lds) {
    Frame F; F.lds = lds; const int t = my_tid();
    F.tid = t; F.lane = t & 63; F.wave = __builtin_amdgcn_readfirstlane(t >> 6);
    F.G = gridDim.x; { const int bx = blockIdx.x; F.vcu = (F.G % 8 == 0) ? (bx % 8) * (F.G / 8) + bx / 8 : bx; }
    return F;
}
__device__ __forceinline__ float wave_sum(float v, int lane) {
    v = sum16(v); v += sx(v, 16, lane); v += sx(v, 32, lane);
    return v;
}
#define LDS_WAIT() asm volatile("s_waitcnt lgkmcnt(0)" ::: "memory")

__device__ __forceinline__ void p0_transpose_item(const float* W, int K, int N, bf16_t* WT, const float* gain, bool remap, LAS float* scr, int item, int lane) {
    const int nblk = N / 32, kb = item / nblk, nb = item % nblk, k0 = 128 * kb, n0 = 32 * nb;
    const int r = lane >> 3, c = lane & 7;
    f32x4 v[16];
#pragma unroll
    for (int i = 0; i < 16; ++i) v[i] = *(const f32x4*)(W + (size_t)(k0 + 8 * i + r) * N + n0 + 4 * c);
    if (gain) {
#pragma unroll
        for (int i = 0; i < 16; ++i) v[i] = v[i] * gain[k0 + 8 * i + r]; }
#pragma unroll
    for (int i = 0; i < 16; ++i) { const int k = 8 * i + r;
        scr[(4 * c + 0) * 132 + k] = v[i].x; scr[(4 * c + 1) * 132 + k] = v[i].y; scr[(4 * c + 2) * 132 + k] = v[i].z; scr[(4 * c + 3) * 132 + k] = v[i].w; }
    LDS_WAIT(); asm volatile("" ::: "memory");
    const int nl = lane >> 4, ck = lane & 15;
#pragma unroll
    for (int j = 0; j < 8; ++j) { const int n = 4 * j + nl; const f32x4 a = *(const LAS f32x4*)(scr + n * 132 + 8 * ck), b = *(const LAS f32x4*)(scr + n * 132 + 8 * ck + 4);
        u32x4 o; o.x = cvt_pk_bf16(a.x, a.y); o.y = cvt_pk_bf16(a.z, a.w); o.z = cvt_pk_bf16(b.x, b.y); o.w = cvt_pk_bf16(b.z, b.w);
        int nd = n0 + n;
        if (remap) { if (nd >= 7168) nd = (nd < 7184) ? nd + 7248 : nd - 16; }
        *(u32x4*)(WT + tiled_off((size_t)nd, k0 + 8 * ck, K)) = o; }
    LDS_WAIT(); asm volatile("" ::: "memory");
}
__device__ __forceinline__ void rownorm_row(const float* xrow, bf16_t* xb, float* SSQP, int m, int lane) {
    const f32x4* xr = (const f32x4*)xrow + lane;
    f32x4 v[16]; float s = 0.f;
#pragma unroll
    for (int j = 0; j < 16; ++j) { v[j] = xr[64 * j]; s += (v[j].x * v[j].x + v[j].y * v[j].y) + (v[j].z * v[j].z + v[j].w * v[j].w); }
    const float st = wave_sum(s, lane);
    SSQP[(size_t)lane * M + m] = lane == 0 ? st : 0.f;
#pragma unroll
    for (int j = 0; j < 16; ++j) { u32x2 o; o.x = cvt_pk_bf16(v[j].x, v[j].y); o.y = cvt_pk_bf16(v[j].z, v[j].w); *(u32x2*)(xb + tiled_off((size_t)m, 256 * j + 4 * lane, DM)) = o; }
}
__device__ __forceinline__ void rownorm_phase(const Frame& F, const float* x, bf16_t* xb, float* SSQP) {
    const int gw = F.vcu * 8 + F.wave, NGW = F.G * 8;
    for (int m = gw; m < M; m += NGW) rownorm_row(x + (size_t)m * DM, xb, SSQP, m, F.lane);
}
__device__ __forceinline__ void rs_reduce_phase(const Frame& F, const float* SSQP, float* RS) {
    const int gt = (F.vcu * 8 + F.wave) * 64 + F.lane, NGT = F.G * 512;
    for (int m = gt; m < M; m += NGT) { float s = 0.f;
#pragma unroll 8
        for (int j = 0; j < 64; ++j) s += SSQP[(size_t)j * M + m];
        RS[m] = 1.f / sqrtf(s * (1.f / DM) + EPS); }
}

constexpr int CONV_I_IN = (DM / 128) * (NIN / 32), CONV_I_O = (DM / 128) * (DM / 32), CONV_I_1 = (DM / 128) * (FF / 32), CONV_I_2 = (FF / 128) * (DM / 32);
constexpr int CONV_PER_L = CONV_I_IN + CONV_I_O + CONV_I_1 + CONV_I_2;
__device__ __forceinline__ void conv_item(KA* ap, int l, int r, LAS float* scr, int lane) {
    unsigned char* ws = ap->ws;
    if (r < CONV_I_IN) { p0_transpose_item(ap->in[2] + (size_t)l * DM * NIN, DM, NIN, (bf16_t*)(ws + WS_WIN + l * SZ_WIN), ap->in[1] + l * DM, true, scr, r, lane); return; } r -= CONV_I_IN;
    if (r < CONV_I_O) { p0_transpose_item(ap->in[13] + (size_t)l * DM * DM, DM, DM, (bf16_t*)(ws + WS_WOUT + l * SZ_WOUT), nullptr, false, scr, r, lane); return; } r -= CONV_I_O;
    if (r < CONV_I_1) { p0_transpose_item(ap->in[15] + (size_t)l * DM * FF, DM, FF, (bf16_t*)(ws + WS_W1 + l * SZ_W1), ap->in[14] + l * DM, false, scr, r, lane); return; } r -= CONV_I_1;
    p0_transpose_item(ap->in[16] + (size_t)l * FF * DM, FF, DM, (bf16_t*)(ws + WS_W2 + l * SZ_W2), nullptr, false, scr, r, lane);
}
__device__ __forceinline__ void bg_convert(const Frame& F, KA* ap, unsigned* arrive, bool drain) {
    unsigned* ctl = (unsigned*)(ap->ws + WS_CTL); unsigned* head = ctl + CW_BGQ;
    volatile LAS unsigned* slot = (volatile LAS unsigned*)(F.lds + LDS_MISC) + 24;
    LAS float* scr = (LAS float*)(F.lds + F.wave * 16896);
    if (!drain && F.tid == 0) (void)__hip_atomic_fetch_add(arrive, 1u, __ATOMIC_RELAXED, __HIP_MEMORY_SCOPE_AGENT);
    for (;;) {
        __syncthreads();
        if (F.tid == 0) { unsigned done = 0u; if (!drain) done = (__hip_atomic_load(arrive, __ATOMIC_RELAXED, __HIP_MEMORY_SCOPE_AGENT) >= (unsigned)F.G) ? 1u : 0u;
            unsigned ch = 0xFFFFFFFFu; if (!done) ch = __hip_atomic_fetch_add(head, 1u, __ATOMIC_RELAXED, __HIP_MEMORY_SCOPE_AGENT);
            slot[0] = ch; }
        __syncthreads();
        const unsigned ch = (unsigned)__builtin_amdgcn_readfirstlane((int)slot[0]);
        if (ch == 0xFFFFFFFFu || ch * 8u >= (unsigned)CONV_PER_L) break;
        const int it = (int)ch * 8 + F.wave;
        if (it < CONV_PER_L) conv_item(ap, 1, it, scr, F.lane);
    }
    __syncthreads();
}
constexpr int NCVW = 32;
__device__ __forceinline__ void conv_side(const Frame& F, KA* ap) {
    LAS float* scr = (LAS float*)(F.lds + F.wave * 16896);
    const int ncv = F.G < NCVW ? F.G : NCVW;
    for (int it = CONV_I_IN + (int)blockIdx.x * 8 + F.wave; it < CONV_PER_L; it += ncv * 8) conv_item(ap, 0, it, scr, F.lane);
    __syncthreads();
}
__device__ __forceinline__ void p0_prologue(const Frame& F, KA* ap) {
    unsigned char* ws = ap->ws;
    LAS float* scr = (LAS float*)(F.lds + F.wave * 16896);
    const int gw = F.vcu * 8 + F.wave, NGW = F.G * 8;
    for (int it = gw; it < CONV_I_IN; it += NGW) conv_item(ap, 0, it, scr, F.lane);
    { const int gt = (F.vcu * 8 + F.wave) * 64 + F.lane, NGT = F.G * 512; constexpr int PADV = (NINP - NIN) * DM / 8;
      for (int i = gt; i < DEPTH * PADV; i += NGT) { const int l = i / PADV, r = i % PADV; const int n = NIN + r / (DM / 8), k = (r % (DM / 8)) * 8;
          *(u32x4*)((bf16_t*)(ws + WS_WIN + l * SZ_WIN) + tiled_off((size_t)n, k, DM)) = zero4(); } }
    { const int gt = (F.vcu * 8 + F.wave) * 64 + F.lane; float* lb = (float*)(ws + WS_LB);
      if (gt < 1024) { const float g0 = ap->in[3][gt], g1 = ap->in[3][1024 + gt]; lb[gt] = 0.f; lb[1024 + gt] = 1.f / (1.f + expf(g0 - g1)); } }
    rownorm_phase(F, ap->in[0], (bf16_t*)(ws + WS_XB), (float*)(ws + WS_SSQP));
}


__device__ __forceinline__ int q_next(unsigned* ctr, volatile LAS unsigned* slot) {
    __syncthreads();
    if (my_tid() == 0) *slot = atomicAdd(ctr, 1u);
    __syncthreads();
    return __builtin_amdgcn_readfirstlane((int)*slot);
}

template <bool DRY>
__device__ __forceinline__ void norm128_inplace(bf16_t* p, const float (&g)[16], int lane) {
    u32x4 a = *(const u32x4*)(p + lane * 16), b = *(const u32x4*)(p + lane * 16 + 8);
    float v[16];
    v[0] = bf_lo(a.x); v[1] = bf_hi(a.x); v[2] = bf_lo(a.y); v[3] = bf_hi(a.y); v[4] = bf_lo(a.z); v[5] = bf_hi(a.z); v[6] = bf_lo(a.w); v[7] = bf_hi(a.w);
    v[8] = bf_lo(b.x); v[9] = bf_hi(b.x); v[10] = bf_lo(b.y); v[11] = bf_hi(b.y); v[12] = bf_lo(b.z); v[13] = bf_hi(b.z); v[14] = bf_lo(b.w); v[15] = bf_hi(b.w);
    float ss = 0.f;
#pragma unroll
    for (int i = 0; i < 16; ++i) ss += v[i] * v[i];
    ss = sum8(ss);
    const float rs = 1.f / sqrtf(ss * (1.f / 128.f) + EPS);
#pragma unroll
    for (int i = 0; i < 16; ++i) v[i] = v[i] * rs * g[i];
    a.x = cvt_pk_bf16(v[0], v[1]); a.y = cvt_pk_bf16(v[2], v[3]); a.z = cvt_pk_bf16(v[4], v[5]); a.w = cvt_pk_bf16(v[6], v[7]);
    b.x = cvt_pk_bf16(v[8], v[9]); b.y = cvt_pk_bf16(v[10], v[11]); b.z = cvt_pk_bf16(v[12], v[13]); b.w = cvt_pk_bf16(v[14], v[15]);
    if (!DRY || rs == 1234.5f) { *(u32x4*)(p + lane * 16) = a; *(u32x4*)(p + lane * 16 + 8) = b; }
}
template <bool DRY>
__device__ __forceinline__ void fixup_phase(const Frame& F, KA* ap, int l) {
    unsigned char* ws = ap->ws;
    bf16_t* PROJ = (bf16_t*)(ws + WS_PROJ); float* ODDW = (float*)(ws + WS_ODD); const float* ODDP = (const float*)(ws + WS_Y); const float* RS = (const float*)(ws + WS_RS); const float* gbias = ap->in[6] + l * 16;
    bf16_t* BQK = (bf16_t*)(ws + WS_BQK); bf16_t* KI = (bf16_t*)(ws + WS_KI);
    const float* kin = ap->in[12] + l * 64; const float* cw = ap->in[5] + l * 4096;
    const int gw = F.vcu * 8 + F.wave, NGW = F.G * 8, lane = F.lane;
    float wcv[4][16];
#pragma unroll
    for (int j = 0; j < 4; ++j)
#pragma unroll
        for (int i = 0; i < 16; ++i) wcv[j][i] = cw[j * 1024 + lane * 16 + i];
    for (int m = gw; m < M; m += NGW) {
        {
          const float* op = ODDP + (size_t)m * 128; const float rs = RS[m];
          const float x = rs * ((op[lane] + op[(size_t)M * 128 + lane]) + (op[(size_t)2 * M * 128 + lane] + op[(size_t)3 * M * 128 + lane]));
          if (lane < 32) { const int c2 = 64 + lane; float v = rs * ((op[c2] + op[(size_t)M * 128 + c2]) + (op[(size_t)2 * M * 128 + c2] + op[(size_t)3 * M * 128 + c2]));
              if (c2 < 80) v *= 2.0f;   else { v += gbias[c2 - 80]; if (c2 >= 88) v = fminf(v, 0.f) - __logf(1.f + __expf(-fabsf(v))); }
              if (!DRY || v == 1234.5f) ODDW[(size_t)m * LDO + c2] = v; }
          const float ss = wave_sum(x * x, lane); const float y = x * (1.f / sqrtf(ss * (1.f / 64.f) + EPS)) * kin[lane];
          if (!DRY || y == 1234.5f) KI[(((size_t)(m >> 5) * 4 + (lane >> 4)) * 64 + ((lane >> 3) & 1) * 32 + (m & 31)) * 8 + (lane & 7)] = (bf16_t)(cvt_pk_bf16(y, y) & 0xffffu); }
        { const int tt = m & (T - 1); float acc[16];
#pragma unroll
          for (int i = 0; i < 16; ++i) acc[i] = 0.f;
#pragma unroll
          for (int j = 0; j < 4; ++j) { if (tt - 3 + j >= 0) { const bf16_t* rp = PROJ + (size_t)(m - 3 + j) * LDP + C_BQK + lane * 16;
                const u32x4 x0 = *(const u32x4*)rp, x1 = *(const u32x4*)(rp + 8); const float (&wj)[16] = wcv[j];
                acc[0] += bf_lo(x0.x) * wj[0]; acc[1] += bf_hi(x0.x) * wj[1]; acc[2] += bf_lo(x0.y) * wj[2]; acc[3] += bf_hi(x0.y) * wj[3];
                acc[4] += bf_lo(x0.z) * wj[4]; acc[5] += bf_hi(x0.z) * wj[5]; acc[6] += bf_lo(x0.w) * wj[6]; acc[7] += bf_hi(x0.w) * wj[7];
                acc[8] += bf_lo(x1.x) * wj[8]; acc[9] += bf_hi(x1.x) * wj[9]; acc[10] += bf_lo(x1.y) * wj[10]; acc[11] += bf_hi(x1.y) * wj[11];
                acc[12] += bf_lo(x1.z) * wj[12]; acc[13] += bf_hi(x1.z) * wj[13]; acc[14] += bf_lo(x1.w) * wj[14]; acc[15] += bf_hi(x1.w) * wj[15]; } }
          const float sc = (lane >= 32) ? 0.125f : 1.f;
#pragma unroll
          for (int i = 0; i < 16; ++i) acc[i] = fast_silu(acc[i]) * sc;
          u32x4 o0, o1; o0.x = cvt_pk_bf16(acc[0], acc[1]); o0.y = cvt_pk_bf16(acc[2], acc[3]); o0.z = cvt_pk_bf16(acc[4], acc[5]); o0.w = cvt_pk_bf16(acc[6], acc[7]);
          o1.x = cvt_pk_bf16(acc[8], acc[9]); o1.y = cvt_pk_bf16(acc[10], acc[11]); o1.z = cvt_pk_bf16(acc[12], acc[13]); o1.w = cvt_pk_bf16(acc[14], acc[15]);
          if (!DRY || acc[0] == 1234.5f) { *(u32x4*)(BQK + (size_t)m * 1024 + lane * 16) = o0; *(u32x4*)(BQK + (size_t)m * 1024 + lane * 16 + 8) = o1; } }
    }
}
__device__ __forceinline__ void ccombine_phase(const Frame& F, KA* ap, int l) {
    unsigned char* ws = ap->ws; const float* CATT = (const float*)(ws + WS_CATT); bf16_t* Y = (bf16_t*)(ws + WS_Y);
    const float* lam = ap->in[9] + l * 512; const float* sub = ap->in[10] + l * 256; const int lane = F.lane;
    const float linit = (l == 0) ? 0.2f : 0.35550906759f;
    const float s1 = wave_sum(lam[lane] * lam[128 + lane] + lam[64 + lane] * lam[192 + lane], lane);
    const float s2 = wave_sum(lam[256 + lane] * lam[384 + lane] + lam[320 + lane] * lam[448 + lane], lane);
    const float lamf = expf(s1) - expf(s2) + linit;
    const int gw = F.vcu * 8 + F.wave, NGW = F.G * 8;
    float g[16];
#pragma unroll
    for (int i = 0; i < 16; ++i) g[i] = sub[(lane & 15) * 16 + i] * (1.f - linit);
    for (int m = gw; m < M; m += NGW) {
        const float* r1 = CATT + (size_t)m * 2048 + lane * 16; const float* r2 = r1 + 1024;
        float v[16]; float ss = 0.f;
#pragma unroll
        for (int q = 0; q < 4; ++q) { const f32x4 x = *(const f32x4*)(r1 + 4 * q), y = *(const f32x4*)(r2 + 4 * q);
#pragma unroll
            for (int j = 0; j < 4; ++j) { const float d = x[j] - lamf * y[j]; v[4 * q + j] = d; ss += d * d; } }
        ss = sum16(ss);
        const float rs = 1.f / sqrtf(ss * (1.f / 256.f) + EPS);
        u32x4 o0, o1;
        o0.x = cvt_pk_bf16(v[0] * rs * g[0], v[1] * rs * g[1]); o0.y = cvt_pk_bf16(v[2] * rs * g[2], v[3] * rs * g[3]); o0.z = cvt_pk_bf16(v[4] * rs * g[4], v[5] * rs * g[5]); o0.w = cvt_pk_bf16(v[6] * rs * g[6], v[7] * rs * g[7]);
        o1.x = cvt_pk_bf16(v[8] * rs * g[8], v[9] * rs * g[9]); o1.y = cvt_pk_bf16(v[10] * rs * g[10], v[11] * rs * g[11]); o1.z = cvt_pk_bf16(v[12] * rs * g[12], v[13] * rs * g[13]); o1.w = cvt_pk_bf16(v[14] * rs * g[14], v[15] * rs * g[15]);
        bf16_t* yo = Y + tiled_off((size_t)m, 2048 + lane * 16, DM);
        *(u32x4*)yo = o0; *(u32x4*)(yo + 8) = o1;
    }
}

template <int KS>
__device__ __forceinline__ void mma_nt(f32x16& acc, const LAS unsigned char* A, int sa, const LAS unsigned char* B, int sb, int lane) {
    const LAS unsigned char* ap = A + (lane & 31) * sa + (lane >> 5) * 16;
    const LAS unsigned char* bp = B + (lane & 31) * sb + (lane >> 5) * 16;
#pragma unroll
    for (int ks = 0; ks < KS; ++ks) { const bf16x8 x = *(const LAS bf16x8*)(ap + ks * 32), y = *(const LAS bf16x8*)(bp + ks * 32);
        acc = __builtin_amdgcn_mfma_f32_32x32x16_bf16(x, y, acc, 0, 0, 0); }
}
__device__ __forceinline__ unsigned short bf1(float v) { return (unsigned short)(cvt_pk_bf16(v, v) & 0xffffu); }

__device__ __forceinline__ void hgrn_scan(const Frame& F, KA* ap, int l, int bh) {
    const int tid_ = my_tid();
    const int tid = tid_, lane = tid & 63, w = __builtin_amdgcn_readfirstlane(tid >> 6), hi = lane >> 5, c32 = lane & 31;
    unsigned char* ws = ap->ws; LAS unsigned char* lds = F.lds;
    const int b = bh >> 3, h = bh & 7; const size_t m0 = (size_t)b * T;
    const bf16_t* PROJ = (const bf16_t*)(ws + WS_PROJ); const float* GL = (const float*)(ws + WS_GLOG) + h * 128;
    bf16_t* Y = (bf16_t*)(ws + WS_Y); const float* gn = ap->in[4] + l * 128;
    constexpr int QT = 0, KT = 17408, QH = 34816, KHT = 52224, VT = 70656, ST = 89088, PP = 123904, TOT = 133120, DEC = 137216, OO = 0;
    constexpr int SQ = 272, SK = 144;
    { const u32x4 z4 = zero4(); for (int i = tid; i < 34816 / 16; i += 512) *(LAS u32x4*)(lds + ST + i * 16) = z4; }
    f32x16 sacc[2] = {};
    f32x2 gv[8]; unsigned qv[8], vv[8];
    const int k0 = 2 * lane;
#define HG_LOAD(c) do { _Pragma("unroll") for (int i = 0; i < 8; ++i) { const size_t row = m0 + (size_t)(c) * 64 + 8 * w + i; \
        gv[i] = *(const f32x2*)(GL + row * 1024 + k0); qv[i] = *(const unsigned*)(PROJ + row * LDP + C_AQ + h * 128 + k0); vv[i] = *(const unsigned*)(PROJ + row * LDP + C_AI + h * 128 + k0); } } while (0)
    float ggv[16];
#pragma unroll
    for (int i = 0; i < 16; ++i) ggv[i] = gn[(tid & 7) * 16 + i];
    HG_LOAD(0);
    for (int c = 0; c < T / 64; ++c) {
        const bf16_t* gp_ = PROJ + (m0 + (size_t)c * 64 + (tid >> 3)) * LDP + C_AG + h * 128 + (tid & 7) * 16; const u32x4 g0 = *(const u32x4*)gp_, g1 = *(const u32x4*)(gp_ + 8);
        f32x2 cs[8]; { f32x2 run = {0.f, 0.f};
#pragma unroll
            for (int i = 0; i < 8; ++i) { run += gv[i]; cs[i] = run; }
            *(LAS f32x2*)(lds + TOT + (w * 128 + k0) * 4) = run; }
        __syncthreads();
        { f32x2 off = {0.f, 0.f}, b31 = {0.f, 0.f}, b63 = {0.f, 0.f};
#pragma unroll
          for (int j = 0; j < 8; ++j) { const f32x2 tj = *(const LAS f32x2*)(lds + TOT + (j * 128 + k0) * 4); if (j < w) off += tj; if (j < 4) b31 += tj; b63 += tj; }
          float kh0[8], kh1[8];
#pragma unroll
          for (int i = 0; i < 8; ++i) { const int t = 8 * w + i; const f32x2 bt = off + cs[i];
              const float q0 = bf_lo(qv[i]), q1 = bf_hi(qv[i]);
              const float ki0 = 1.f - __expf(gv[i].x), ki1 = 1.f - __expf(gv[i].y);
              *(LAS unsigned*)(lds + QT + t * SQ + k0 * 2) = cvt_pk_bf16(q0 * __expf(fminf(bt.x - b31.x, 80.f)), q1 * __expf(fminf(bt.y - b31.y, 80.f)));
              *(LAS unsigned*)(lds + KT + t * SQ + k0 * 2) = cvt_pk_bf16(ki0 * __expf(fminf(b31.x - bt.x, 80.f)), ki1 * __expf(fminf(b31.y - bt.y, 80.f)));
              *(LAS unsigned*)(lds + QH + t * SQ + k0 * 2) = cvt_pk_bf16(q0 * __expf(bt.x), q1 * __expf(bt.y));
              kh0[i] = ki0 * __expf(b63.x - bt.x); kh1[i] = ki1 * __expf(b63.y - bt.y); }
          u32x4 o; o.x = cvt_pk_bf16(kh0[0], kh0[1]); o.y = cvt_pk_bf16(kh0[2], kh0[3]); o.z = cvt_pk_bf16(kh0[4], kh0[5]); o.w = cvt_pk_bf16(kh0[6], kh0[7]);
          *(LAS u32x4*)(lds + KHT + k0 * SK + w * 16) = o;
          o.x = cvt_pk_bf16(kh1[0], kh1[1]); o.y = cvt_pk_bf16(kh1[2], kh1[3]); o.z = cvt_pk_bf16(kh1[4], kh1[5]); o.w = cvt_pk_bf16(kh1[6], kh1[7]);
          *(LAS u32x4*)(lds + KHT + (k0 + 1) * SK + w * 16) = o;
          o.x = (vv[0] & 0xffffu) | (vv[1] << 16); o.y = (vv[2] & 0xffffu) | (vv[3] << 16); o.z = (vv[4] & 0xffffu) | (vv[5] << 16); o.w = (vv[6] & 0xffffu) | (vv[7] << 16);
          *(LAS u32x4*)(lds + VT + k0 * SK + w * 16) = o;
          o.x = (vv[0] >> 16) | (vv[1] & 0xffff0000u); o.y = (vv[2] >> 16) | (vv[3] & 0xffff0000u); o.z = (vv[4] >> 16) | (vv[5] & 0xffff0000u); o.w = (vv[6] >> 16) | (vv[7] & 0xffff0000u);
          *(LAS u32x4*)(lds + VT + (k0 + 1) * SK + w * 16) = o;
          if (w == 7) { f32x2 d; d.x = __expf(b63.x); d.y = __expf(b63.y); *(LAS f32x2*)(lds + DEC + k0 * 4) = d; } }
        if (c + 1 < T / 64) HG_LOAD(c + 1);
        __syncthreads();
        f32x16 pacc = {}, oacc = {};
        const int ti = w >> 1, sj = w & 1;
        if (w < 4 && !(ti == 0 && sj == 1)) mma_nt<8>(pacc, lds + QT + ti * 32 * SQ, SQ, lds + KT + sj * 32 * SQ, SQ, lane);
        mma_nt<8>(oacc, lds + QH + (w & 1) * 32 * SQ, SQ, lds + ST + (w >> 1) * 32 * SQ, SQ, lane);
#pragma unroll
        for (int j = 0; j < 2; ++j) { const int kj = 2 * (w & 1) + j; const float dec = *(const LAS float*)(lds + DEC + (32 * kj + c32) * 4);
#pragma unroll
            for (int r = 0; r < 16; ++r) sacc[j][r] *= dec;
            mma_nt<4>(sacc[j], lds + VT + (w >> 1) * 32 * SK, SK, lds + KHT + kj * 32 * SK, SK, lane); }
        __syncthreads();
        if (w < 4) {
#pragma unroll
            for (int r = 0; r < 16; ++r) { const int t = 32 * ti + att::crow(r, hi), s_ = 32 * sj + c32; const float v = (s_ <= t) ? pacc[r] : 0.f;
                *(LAS unsigned short*)(lds + PP + t * SK + s_ * 2) = bf1(v); } }
#pragma unroll
        for (int j = 0; j < 2; ++j) { const int kj = 2 * (w & 1) + j;
#pragma unroll
            for (int r = 0; r < 16; ++r) { const int v_ = 32 * (w >> 1) + att::crow(r, hi), k_ = 32 * kj + c32;
                *(LAS unsigned short*)(lds + ST + v_ * SQ + k_ * 2) = bf1(sacc[j][r]); } }
        __syncthreads();
        mma_nt<4>(oacc, lds + PP + (w & 1) * 32 * SK, SK, lds + VT + (w >> 1) * 32 * SK, SK, lane);
#pragma unroll
        for (int r = 0; r < 16; ++r) { const int t = 32 * (w & 1) + att::crow(r, hi), v_ = 32 * (w >> 1) + c32; *(LAS float*)(lds + OO + (t * 132 + v_) * 4) = oacc[r]; }
        __syncthreads();
        { const int t = tid >> 3, sg = tid & 7; const size_t row = m0 + (size_t)c * 64 + t;
          float v[16]; float ss = 0.f;
#pragma unroll
          for (int q = 0; q < 4; ++q) { const f32x4 x = *(const LAS f32x4*)(lds + OO + (t * 132 + sg * 16 + 4 * q) * 4);
#pragma unroll
              for (int j = 0; j < 4; ++j) { v[4 * q + j] = x[j]; ss += x[j] * x[j]; } }
          ss = sum8(ss);
          const float rs = 1.f / sqrtf(ss * (1.f / 128.f) + EPS);
          const float (&gg)[16] = ggv;
          u32x4 o0, o1;
          o0.x = cvt_pk_bf16(v[0] * rs * gg[0] * bf_lo(g0.x), v[1] * rs * gg[1] * bf_hi(g0.x)); o0.y = cvt_pk_bf16(v[2] * rs * gg[2] * bf_lo(g0.y), v[3] * rs * gg[3] * bf_hi(g0.y));
          o0.z = cvt_pk_bf16(v[4] * rs * gg[4] * bf_lo(g0.z), v[5] * rs * gg[5] * bf_hi(g0.z)); o0.w = cvt_pk_bf16(v[6] * rs * gg[6] * bf_lo(g0.w), v[7] * rs * gg[7] * bf_hi(g0.w));
          o1.x = cvt_pk_bf16(v[8] * rs * gg[8] * bf_lo(g1.x), v[9] * rs * gg[9] * bf_hi(g1.x)); o1.y = cvt_pk_bf16(v[10] * rs * gg[10] * bf_lo(g1.y), v[11] * rs * gg[11] * bf_hi(g1.y));
          o1.z = cvt_pk_bf16(v[12] * rs * gg[12] * bf_lo(g1.z), v[13] * rs * gg[13] * bf_hi(g1.z)); o1.w = cvt_pk_bf16(v[14] * rs * gg[14] * bf_lo(g1.w), v[15] * rs * gg[15] * bf_hi(g1.w));
          bf16_t* yo = Y + tiled_off(row, h * 128 + sg * 16, DM); *(u32x4*)yo = o0; *(u32x4*)(yo + 8) = o1; }
    }
#undef HG_LOAD
    __syncthreads();
}

__device__ __forceinline__ void mlstm_scan(const Frame& F, KA* ap, int l, int bh) {
    const int tid_ = my_tid();
    const int tid = tid_, lane = tid & 63, w = __builtin_amdgcn_readfirstlane(tid >> 6), hi = lane >> 5, c32 = lane & 31;
    unsigned char* ws = ap->ws; LAS unsigned char* lds = F.lds;
    const int b = bh >> 3, h = bh & 7; const size_t m0 = (size_t)b * T;
    const bf16_t* PROJ = (const bf16_t*)(ws + WS_PROJ); const bf16_t* BQK = (const bf16_t*)(ws + WS_BQK); const float* ODD = (const float*)(ws + WS_ODD);
    bf16_t* Y = (bf16_t*)(ws + WS_Y); const float* hn = ap->in[7] + l * 128;
    constexpr int QA = 0, QI = 9216, KB = 18432, KHT = 27648, VT = 36864, CT = 59904, PP = 82944, SCAL = 92160, NUM = 94208;
    constexpr int SK = 144, SN = 164;
    { const u32x4 z4 = zero4(); for (int i = tid; i < 23040 / 16; i += 512) *(LAS u32x4*)(lds + CT + i * 16) = z4; }
    for (int i = tid; i < 32 * SK / 16; i += 512) { const int off = i * 16; const unsigned vone = (off < SK) ? 0x3F803F80u : 0u;
        *(LAS u32x4*)(lds + VT + 128 * SK + off) = (u32x4){vone, vone, vone, vone}; }
    f32x16 cacc[2] = {};
    float m_prev = 0.f;
    const int te = tid >> 3, d0 = (tid & 7) * 8, k0 = 2 * lane;
    bf16x8 qreg, kreg; unsigned vv[8]; float igr = 0.f, lfr = 0.f;
#define ML_LOAD(c) do { const size_t rb = m0 + (size_t)(c) * 64; \
        qreg = *(const bf16x8*)(BQK + (rb + te) * 1024 + h * 64 + d0); kreg = *(const bf16x8*)(BQK + (rb + te) * 1024 + 512 + h * 64 + d0); \
        _Pragma("unroll") for (int i = 0; i < 8; ++i) vv[i] = *(const unsigned*)(PROJ + (rb + 8 * w + i) * LDP + C_BV + h * 128 + k0); \
        if (w == 0) { igr = ODD[(rb + lane) * LDO + 80 + h]; lfr = ODD[(rb + lane) * LDO + 88 + h]; } } while (0)
    float ggv[16];
#pragma unroll
    for (int i = 0; i < 16; ++i) ggv[i] = hn[(tid & 7) * 16 + i];
    ML_LOAD(0);
    for (int c = 0; c < T / 64; ++c) {
        const bf16_t* gp_ = PROJ + (m0 + (size_t)c * 64 + (tid >> 3)) * LDP + C_BO + h * 128 + (tid & 7) * 16; const u32x4 g0 = *(const u32x4*)gp_, g1 = *(const u32x4*)(gp_ + 8);
        if (w == 0) {
            float bc = lfr;
#pragma unroll
            for (int o = 1; o < 64; o <<= 1) { const float x = sidx(bc, lane - o); if (lane >= o) bc += x; }
            const float c1 = igr - bc; float pm = c1;
#pragma unroll
            for (int o = 1; o < 64; o <<= 1) { const float x = sidx(pm, lane - o); if (lane >= o) pm = fmaxf(pm, x); }
            const float mt = fmaxf(bc + pm, bc + m_prev);
            const float wi = __expf(bc + m_prev - mt);
            const float m_new = sidx(mt, 63), b63 = sidx(bc, 63);
            const float wst = __expf(b63 + c1 - m_new), decay = __expf(b63 + m_prev - m_new);
            LAS float* sc = (LAS float*)(lds + SCAL);
            sc[lane] = c1; sc[64 + lane] = bc - mt; sc[128 + lane] = wi; sc[192 + lane] = wst; sc[256 + lane] = __expf(-mt); if (lane == 0) sc[320] = decay;
            m_prev = m_new;
        }
        *(LAS bf16x8*)(lds + QA + te * SK + d0 * 2) = qreg; *(LAS bf16x8*)(lds + KB + te * SK + d0 * 2) = kreg;
        { u32x4 o; o.x = (vv[0] & 0xffffu) | (vv[1] << 16); o.y = (vv[2] & 0xffffu) | (vv[3] << 16); o.z = (vv[4] & 0xffffu) | (vv[5] << 16); o.w = (vv[6] & 0xffffu) | (vv[7] << 16);
          *(LAS u32x4*)(lds + VT + k0 * SK + w * 16) = o;
          o.x = (vv[0] >> 16) | (vv[1] & 0xffff0000u); o.y = (vv[2] >> 16) | (vv[3] & 0xffff0000u); o.z = (vv[4] >> 16) | (vv[5] & 0xffff0000u); o.w = (vv[6] >> 16) | (vv[7] & 0xffff0000u);
          *(LAS u32x4*)(lds + VT + (k0 + 1) * SK + w * 16) = o; }
        __syncthreads();
        { const LAS float* sc = (const LAS float*)(lds + SCAL); const float wi = sc[128 + te], wst = sc[192 + te];
          float qf[8], kf[8];
#pragma unroll
          for (int i = 0; i < 8; ++i) { qf[i] = bf2f((bf16_t)qreg[i]) * wi; kf[i] = bf2f((bf16_t)kreg[i]) * wst; }
          u32x4 o; o.x = cvt_pk_bf16(qf[0], qf[1]); o.y = cvt_pk_bf16(qf[2], qf[3]); o.z = cvt_pk_bf16(qf[4], qf[5]); o.w = cvt_pk_bf16(qf[6], qf[7]);
          *(LAS u32x4*)(lds + QI + te * SK + d0 * 2) = o;
#pragma unroll
          for (int i = 0; i < 8; ++i) *(LAS unsigned short*)(lds + KHT + (d0 + i) * SK + te * 2) = bf1(kf[i]); }
        if (c + 1 < T / 64) ML_LOAD(c + 1);
        __syncthreads();
        f32x16 pacc = {}, nacc0 = {}, nacc1 = {};
        const int ti = w >> 1, sj = w & 1;
        const float decay = ((const LAS float*)(lds + SCAL))[320];
        if (w < 4 && !(ti == 0 && sj == 1)) mma_nt<4>(pacc, lds + QA + ti * 32 * SK, SK, lds + KB + sj * 32 * SK, SK, lane);
        mma_nt<4>(nacc0, lds + QI + (w & 1) * 32 * SK, SK, lds + CT + (w >> 1) * 32 * SK, SK, lane);
        if (w < 2) mma_nt<4>(nacc1, lds + QI + w * 32 * SK, SK, lds + CT + 4 * 32 * SK, SK, lane);
#pragma unroll
        for (int r = 0; r < 16; ++r) cacc[0][r] *= decay;
        mma_nt<4>(cacc[0], lds + VT + (w >> 1) * 32 * SK, SK, lds + KHT + (w & 1) * 32 * SK, SK, lane);
        if (w < 2) {
#pragma unroll
            for (int r = 0; r < 16; ++r) cacc[1][r] *= decay;
            mma_nt<4>(cacc[1], lds + VT + 4 * 32 * SK, SK, lds + KHT + w * 32 * SK, SK, lane); }
        __syncthreads();
        if (w < 4) { const LAS float* sc = (const LAS float*)(lds + SCAL); const int s_ = 32 * sj + c32; const float c1s = sc[s_];
#pragma unroll
            for (int r = 0; r < 16; ++r) { const int t = 32 * ti + att::crow(r, hi); const float v = (s_ <= t) ? pacc[r] * __expf(c1s + sc[64 + t]) : 0.f;
                *(LAS unsigned short*)(lds + PP + t * SK + s_ * 2) = bf1(v); } }
#pragma unroll
        for (int r = 0; r < 16; ++r) { const int v_ = 32 * (w >> 1) + att::crow(r, hi), d_ = 32 * (w & 1) + c32; *(LAS unsigned short*)(lds + CT + v_ * SK + d_ * 2) = bf1(cacc[0][r]); }
        if (w < 2) {
#pragma unroll
            for (int r = 0; r < 16; ++r) { const int v_ = 128 + att::crow(r, hi), d_ = 32 * w + c32; *(LAS unsigned short*)(lds + CT + v_ * SK + d_ * 2) = bf1(cacc[1][r]); } }
        __syncthreads();
        mma_nt<4>(nacc0, lds + PP + (w & 1) * 32 * SK, SK, lds + VT + (w >> 1) * 32 * SK, SK, lane);
        if (w < 2) mma_nt<4>(nacc1, lds + PP + w * 32 * SK, SK, lds + VT + 4 * 32 * SK, SK, lane);
#pragma unroll
        for (int r = 0; r < 16; ++r) { const int t = 32 * (w & 1) + att::crow(r, hi), v_ = 32 * (w >> 1) + c32; *(LAS float*)(lds + NUM + (t * SN + v_) * 4) = nacc0[r]; }
        if (w < 2) {
#pragma unroll
            for (int r = 0; r < 16; ++r) { const int t = 32 * w + att::crow(r, hi), v_ = 128 + c32; *(LAS float*)(lds + NUM + (t * SN + v_) * 4) = nacc1[r]; } }
        __syncthreads();
        { const int t = tid >> 3, sg = tid & 7; const size_t row = m0 + (size_t)c * 64 + t;
          const float den = *(const LAS float*)(lds + NUM + (t * SN + 128) * 4); const float emt = ((const LAS float*)(lds + SCAL))[256 + t];
          const float inv = 1.f / fmaxf(fabsf(den), emt);
          float v[16]; float ss = 0.f;
#pragma unroll
          for (int q = 0; q < 4; ++q) { const f32x4 x = *(const LAS f32x4*)(lds + NUM + (t * SN + sg * 16 + 4 * q) * 4);
#pragma unroll
              for (int j = 0; j < 4; ++j) { const float y = x[j] * inv; v[4 * q + j] = y; ss += y * y; } }
          ss = sum8(ss);
          const float rs = 1.f / sqrtf(ss * (1.f / 128.f) + EPS);
          const float (&gg)[16] = ggv;
          u32x4 o0, o1;
          o0.x = cvt_pk_bf16(v[0] * rs * gg[0] * bf_lo(g0.x), v[1] * rs * gg[1] * bf_hi(g0.x)); o0.y = cvt_pk_bf16(v[2] * rs * gg[2] * bf_lo(g0.y), v[3] * rs * gg[3] * bf_hi(g0.y));
          o0.z = cvt_pk_bf16(v[4] * rs * gg[4] * bf_lo(g0.z), v[5] * rs * gg[5] * bf_hi(g0.z)); o0.w = cvt_pk_bf16(v[6] * rs * gg[6] * bf_lo(g0.w), v[7] * rs * gg[7] * bf_hi(g0.w));
          o1.x = cvt_pk_bf16(v[8] * rs * gg[8] * bf_lo(g1.x), v[9] * rs * gg[9] * bf_hi(g1.x)); o1.y = cvt_pk_bf16(v[10] * rs * gg[10] * bf_lo(g1.y), v[11] * rs * gg[11] * bf_hi(g1.y));
          o1.z = cvt_pk_bf16(v[12] * rs * gg[12] * bf_lo(g1.z), v[13] * rs * gg[13] * bf_hi(g1.z)); o1.w = cvt_pk_bf16(v[14] * rs * gg[14] * bf_lo(g1.w), v[15] * rs * gg[15] * bf_hi(g1.w));
          bf16_t* yo = Y + tiled_off(row, 1024 + h * 128 + sg * 16, DM); *(u32x4*)yo = o0; *(u32x4*)(yo + 8) = o1; }
    }
#undef ML_LOAD
    __syncthreads();
}

template <int STG2>
__device__ __forceinline__ void dsa_index_item2(const Frame& F, KA* ap, int item) {
    const int tid_ = my_tid();
    const int tid = tid_, lane = tid & 63, w = __builtin_amdgcn_readfirstlane(tid >> 6), hi = lane >> 5, c32 = lane & 31;
    unsigned char* ws = ap->ws; LAS unsigned char* lds = F.lds;
    const int b = item / (T / 32), tb = (T / 32 - 1) - item % (T / 32);
    const int t0 = tb * 32 + 4 * w; const size_t m0 = (size_t)b * T;
    const int n = 64 * (t0 / 64 + 1), nkb = n / 32, nj = n / 64;
    unsigned* MK = (unsigned*)(ws + WS_MASK) + (size_t)b * 256 * T;
    if (n <= 256) { for (int i = lane; i < nkb * 4; i += 64) MK[(size_t)(i >> 2) * T + t0 + (i & 3)] = 0xFFFFFFFFu; return; }
    const bf16_t* PROJ = (const bf16_t*)(ws + WS_PROJ); const bf16_t* KI = (const bf16_t*)(ws + WS_KI) + m0 * 64; const float* ODD = (const float*)(ws + WS_ODD);
    unsigned* SCB = (unsigned*)(ws + WS_SCB) + ((size_t)blockIdx.x * 8 + w) * 4 * T;
    LAS unsigned* hist = (LAS unsigned*)(lds + w * 8192);
    LAS unsigned* wb = hist + 1024;
    {
        bf16x8 af[2][4]; float wv[2][16];
#pragma unroll
        for (int rt = 0; rt < 2; ++rt) {
#pragma unroll
            for (int ks = 0; ks < 4; ++ks) af[rt][ks] = *(const bf16x8*)(PROJ + (m0 + t0 + 2 * rt + (c32 >> 4)) * LDP + C_DQI + (c32 & 15) * 64 + ks * 16 + hi * 8);
#pragma unroll
            for (int r = 0; r < 16; ++r) { const int tok = 2 * rt + (r >> 3), head = (r & 3) + 8 * ((r >> 2) & 1) + 4 * hi; wv[rt][r] = ODD[(m0 + t0 + tok) * LDO + 64 + head]; } }
        f32x2 wv2[2][8]; const f32x2 one2 = {1.f, 1.f};
#pragma unroll
        for (int rt = 0; rt < 2; ++rt)
#pragma unroll
            for (int i = 0; i < 8; ++i) wv2[rt][i] = (f32x2){wv[rt][2 * i], wv[rt][2 * i + 1]};
        LAS unsigned char* kbuf = lds + 65536;
#define IDX_LOADB(dst, base_, t_) do { _Pragma("unroll") for (int ks = 0; ks < 4; ++ks) dst[ks] = *(const LAS bf16x8*)((base_) + (((t_) * 4 + ks) * 64 + lane) * 16); } while (0)
#define IDX_MMA(src, A0, A1) do { A0 = f32x16{}; A1 = f32x16{}; _Pragma("unroll") for (int ks = 0; ks < 4; ++ks) { \
            A0 = __builtin_amdgcn_mfma_f32_32x32x16_bf16(af[0][ks], src[ks], A0, 0, 0, 0); A1 = __builtin_amdgcn_mfma_f32_32x32x16_bf16(af[1][ks], src[ks], A1, 0, 0, 0); } } while (0)
#define IDX_PKACC(SP, ACC, i_, W2) do { f32x2 x2_ = {ACC[2 * (i_)], ACC[2 * (i_) + 1]}, r2_; \
            asm("v_pk_mul_f32 %0, %1, %2 clamp" : "=v"(r2_) : "v"(x2_), "v"(one2));     \
            asm("v_pk_fma_f32 %0, %1, %2, %0" : "+v"(SP) : "v"(r2_), "v"(W2)); } while (0)
#define IDX_RED1(ACC, rt, kb_) do { f32x2 sp0 = {0.f, 0.f}, sp1 = {0.f, 0.f}; \
            _Pragma("unroll") for (int i = 0; i < 4; ++i) { IDX_PKACC(sp0, ACC, i, wv2[rt][i]); IDX_PKACC(sp1, ACC, 4 + i, wv2[rt][4 + i]); } \
            const float s0 = sp0.x + sp0.y, s1 = sp1.x + sp1.y; \
            const auto pr_ = __builtin_amdgcn_permlane32_swap(__float_as_uint(s0), __float_as_uint(s1), false, false); \
            const float sv = fminf(fmaxf(__uint_as_float(pr_[0]) + __uint_as_float(pr_[1]), -15.99f), 15.99f); \
            const unsigned key_ = ((unsigned)(int)(sv * 134217728.f) + 0x80000000u) >> 8; SCB[(size_t)(2 * rt + hi) * T + 32 * (kb_) + c32] = key_; \
            { const unsigned bin_ = key_ >> 15; __hip_atomic_fetch_add(&hist[(2 * rt + hi) * 256 + (bin_ >> 1)], 1u << (16 * (bin_ & 1u)), __ATOMIC_RELAXED, __HIP_MEMORY_SCOPE_WORKGROUP); } } while (0)
#define IDX_RED(A0, A1, kb_) do { IDX_RED1(A0, 0, kb_); IDX_RED1(A1, 1, kb_); } while (0)
        const int ngrp = (nkb + 7) >> 3;
        u32x4 stg[4];
#pragma unroll
        for (int i = 0; i < 16; ++i) hist[64 * i + lane] = 0u;
        asm volatile("s_waitcnt lgkmcnt(0)" ::: "memory");
#pragma unroll
        for (int i = 0; i < 4; ++i) { const int ch = tid + 512 * i; if ((ch >> 8) < nkb) stg[i] = *(const u32x4*)((const char*)KI + (size_t)ch * 16); }
#pragma unroll
        for (int i = 0; i < 4; ++i) { const int ch = tid + 512 * i; if ((ch >> 8) < nkb) *(LAS u32x4*)(kbuf + ch * 16) = stg[i]; }
        __syncthreads();
        for (int g = 0; g < ngrp; ++g) {
            const int kb0 = 8 * g, nt_ = (nkb - kb0) < 8 ? (nkb - kb0) : 8;
            if (g + 1 < ngrp) {
#pragma unroll
                for (int i = 0; i < 4; ++i) { const int ch = tid + 512 * i; if (kb0 + 8 + (ch >> 8) < nkb) stg[i] = *(const u32x4*)((const char*)KI + ((size_t)(kb0 + 8) * 256 + ch) * 16); } }
            const LAS unsigned char* cb = kbuf + (g & 1) * 32768;
            bf16x8 ra[4], rb[4]; f32x16 P0, P1, Q0, Q1;
            IDX_LOADB(ra, cb, 0); IDX_MMA(ra, P0, P1);
            for (int t = 0; t < nt_; t += 2) {
                IDX_LOADB(rb, cb, t + 1); IDX_MMA(rb, Q0, Q1);
                IDX_RED(P0, P1, kb0 + t);
                if (t + 2 < nt_) { IDX_LOADB(ra, cb, t + 2); IDX_MMA(ra, P0, P1); }
                IDX_RED(Q0, Q1, kb0 + t + 1);
            }
            if (g + 1 < ngrp) {
#pragma unroll
                for (int i = 0; i < 4; ++i) { const int ch = tid + 512 * i; if (kb0 + 8 + (ch >> 8) < nkb) *(LAS u32x4*)(kbuf + ((g + 1) & 1) * 32768 + ch * 16) = stg[i]; } }
            __syncthreads();
        }
#undef IDX_MMA
#undef IDX_PKACC
#undef IDX_RED1
#undef IDX_RED
#undef IDX_LOADB
    }
    asm volatile("s_waitcnt vmcnt(0)" ::: "memory");
    if (STG2 == 1) return;
#define WSYNC() asm volatile("s_waitcnt lgkmcnt(0)" ::: "memory")
    for (int row = 0; row < 4; ++row) {
        const unsigned* sc = SCB + (size_t)row * T;
        unsigned kv[128];
#pragma unroll
        for (int j = 0; j < 128; ++j) kv[j] = 0u;
        { int njl = nj; asm volatile("" : "+s"(njl));
#pragma unroll
        for (int j = 0; j < 128; ++j) { if (j < njl) kv[j] = sc[64 * j + lane]; } }
        unsigned prefix, kth = 256u;
        LAS unsigned* hrow = hist + row * 256;
        {   unsigned hw[4]; unsigned tot = 0u;
#pragma unroll
            for (int i = 0; i < 4; ++i) { hw[i] = hrow[4 * lane + i]; tot += (hw[i] & 0xffffu) + (hw[i] >> 16); }
            unsigned suf = tot;
#pragma unroll
            for (int o = 1; o < 64; o <<= 1) { const unsigned x = sidxu(suf, lane + o); if (lane + o < 64) suf += x; }
            const unsigned above = suf - tot;
            unsigned selv = 0u, selk = 0u; const bool mine = (suf >= kth && above < kth);
            if (mine) { unsigned cnt = above; int bin = 0; bool found = false;
#pragma unroll
                for (int i = 7; i >= 0; --i) { const unsigned c = (i & 1) ? (hw[i >> 1] >> 16) : (hw[i >> 1] & 0xffffu);
                    if (!found) { if (cnt + c >= kth) { bin = i; found = true; } else cnt += c; } }
                selv = (unsigned)(8 * lane + bin); selk = kth - cnt; }
            const unsigned long long bm = __ballot(mine); const int src = (int)__builtin_ctzll(bm ? bm : 1ull);
            prefix = sidxu(selv, src); kth = sidxu(selk, src);
            WSYNC();
        }
#pragma unroll
        for (int pass = 1; pass < 3; ++pass) {
            const int shift = (pass == 1) ? 7 : 0, hshift = (pass == 1) ? 15 : 7; const unsigned dmask = (pass == 1) ? 255u : 127u;
#pragma unroll
            for (int i = 0; i < 4; ++i) hrow[64 * i + lane] = 0u;
            WSYNC();
            { int njl = nj; asm volatile("" : "+s"(njl));
#pragma unroll
            for (int j = 0; j < 128; ++j) { if (j < njl) { const unsigned key = kv[j];
                if ((key >> hshift) == prefix) __hip_atomic_fetch_add(&hrow[(key >> shift) & dmask], 1u, __ATOMIC_RELAXED, __HIP_MEMORY_SCOPE_WORKGROUP); } } }
            WSYNC();
            const unsigned h0 = hrow[4 * lane], h1 = hrow[4 * lane + 1], h2 = hrow[4 * lane + 2], h3 = hrow[4 * lane + 3];
            unsigned suf = h0 + h1 + h2 + h3;
#pragma unroll
            for (int o = 1; o < 64; o <<= 1) { const unsigned x = sidxu(suf, lane + o); if (lane + o < 64) suf += x; }
            const unsigned above = suf - (h0 + h1 + h2 + h3);
            unsigned selv = 0u, selk = 0u; const bool mine = (suf >= kth && above < kth);
            if (mine) { unsigned cnt = above; int bin;
                if (cnt + h3 >= kth) { bin = 3; } else { cnt += h3; if (cnt + h2 >= kth) { bin = 2; } else { cnt += h2; if (cnt + h1 >= kth) { bin = 1; } else { cnt += h1; bin = 0; } } }
                selv = (unsigned)(4 * lane + bin); selk = kth - cnt; }
            const unsigned long long bm = __ballot(mine); const int src = (int)__builtin_ctzll(bm ? bm : 1ull);
            prefix = (prefix << ((pass == 1) ? 8 : 7)) | sidxu(selv, src); kth = sidxu(selk, src);
            WSYNC();
        }
        if (STG2 == 2) { if (prefix == 0xdeadbeefu) MK[0] = kth; continue; }
        { int njl = nj; asm volatile("" : "+s"(njl));
#pragma unroll
        for (int j = 0; j < 128; ++j) { if (j < njl) { const unsigned long long bal = __ballot(kv[j] >= prefix);
            if (lane == 0) { wb[(2 * j) * 4 + row] = (unsigned)bal; wb[(2 * j + 1) * 4 + row] = (unsigned)(bal >> 32); } } } }
    }
    WSYNC();
    for (int kb = lane; kb < nkb; kb += 64) { const u32x4 v = *(const LAS u32x4*)(wb + kb * 4); *(u32x4*)(MK + (size_t)kb * T + t0) = v; }
    WSYNC();
#undef WSYNC
}

__device__ __forceinline__ int qn(unsigned* ctr, volatile LAS unsigned* slot, int lo, int hi) { const int v = q_next(ctr, slot) + lo; return v < hi ? v : 0x7fffffff; }
constexpr int IT_A = 16, IT_B = 32, IT_C = 32 + 1024, IT_D = IT_C + NB * (T / 32);
template <int ISTG>
__device__ __forceinline__ void mixer_a_phase(const Frame& F, KA* ap, int l, unsigned* qctr, int it_lo, int it_hi) {
    volatile LAS unsigned* slot = (volatile LAS unsigned*)(F.lds + LDS_MISC) + 16;
    unsigned char* ws = ap->ws;
    int it = qn(qctr, slot, it_lo, it_hi);
#ifndef NO_A
    while (it < IT_A) { hgrn_scan(F, ap, l, it); it = qn(qctr, slot, it_lo, it_hi); }
#endif
#ifndef NO_B
    while (it < IT_B) { mlstm_scan(F, ap, l, it - IT_A); it = qn(qctr, slot, it_lo, it_hi); }
#endif
    {
        const bf16_t* PROJ = (const bf16_t*)(ws + WS_PROJ); float* CATT = (float*)(ws + WS_CATT);
        att::Seam S;
        while (it < IT_C) {
            const int i = it - IT_B, y = 31 - (i >> 5), r = i & 31, b = r >> 4, vh = r & 15, h = vh >> 2, mm = (vh >> 1) & 1, vhalf = vh & 1;
            const bf16_t* base = PROJ + (size_t)b * T * LDP;
            att::BlockRef<float> r0;
            r0.Q = base + (size_t)(y * 256) * LDP + C_CQ + (h * 2 + mm) * 128; r0.K = base + C_CK + (h * 2 + mm) * 128; r0.V = base + C_CV + h * 256 + vhalf * 128;
            r0.O = CATT + ((size_t)b * T + y * 256) * 2048 + mm * 1024 + h * 256 + vhalf * 128; r0.MK = nullptr; r0.P0 = y * 256; r0.orow = 0; r0.ocol = 0;
#ifndef NO_C
            att::attn_prime<float>(r0, (char*)F.lds, S);
            att::attn_block<float, false, 2048>(r0, r0, (char*)F.lds, S);
#endif
            it = qn(qctr, slot, it_lo, it_hi);
        }
    }
#ifndef NO_D
    while (it < IT_D) { dsa_index_item2<4>(F, ap, it - IT_C); it = qn(qctr, slot, it_lo, it_hi); }
#endif
}
__device__ __forceinline__ void mixer_b_phase(const Frame& F, KA* ap, int l, unsigned* qctr) {
    volatile LAS unsigned* slot = (volatile LAS unsigned*)(F.lds + LDS_MISC) + 16;
    unsigned char* ws = ap->ws;
    const bf16_t* PROJ = (const bf16_t*)(ws + WS_PROJ); bf16_t* Y = (bf16_t*)(ws + WS_Y); const unsigned* MASK = (const unsigned*)(ws + WS_MASK);
    att::Seam S;
    int it = q_next(qctr, slot);
    while (it < 512) {
        const int y = 31 - (it >> 4), r = it & 15, b = r >> 3, h = r & 7;
        const bf16_t* base = PROJ + (size_t)b * T * LDP;
        att::BlockRef<bf16_t> r0;
        r0.Q = base + (size_t)(y * 256) * LDP + C_DQ + h * 128; r0.K = base + C_DK + h * 128; r0.V = base + C_DV + h * 128;
        r0.O = Y; r0.orow = b * T + y * 256; r0.ocol = 3072 + h * 128; r0.MK = MASK + (size_t)b * 256 * T; r0.P0 = y * 256;
#ifndef NO_E
        att::attn_prime<bf16_t>(r0, (char*)F.lds, S);
        att::attn_block<bf16_t, true, DM>(r0, r0, (char*)F.lds, S);
#endif
        it = q_next(qctr, slot);
    }
}

__global__ void __launch_bounds__(512, 2) mk_fwd(Args args) {
    extern __shared__ __attribute__((aligned(16))) unsigned char lds_raw[];
    LAS unsigned char* lds = (LAS unsigned char*)lds_raw;
    volatile LAS unsigned* MISC = (volatile LAS unsigned*)(lds + LDS_MISC);
    if (threadIdx.x < 64) MISC[threadIdx.x] = 0u;
    if ((threadIdx.x & 63) == 0) *(volatile LAS unsigned*)(lds + LDS_WTAB + ((unsigned)__builtin_amdgcn_s_getreg((5 << 11) | 4) & 63u) * 4) = threadIdx.x >> 6;
    __syncthreads();
    if (my_tid() != (int)threadIdx.x) __builtin_trap();
    const int lo = args.ph_lo, hi = args.ph_hi;
    XcdBarrier bar; bar.bar = (unsigned*)(args.ws + WS_CTL) + CW_BAR; bar.x = 0; bar.st = nullptr;
    if (hi - lo > 1) bar = xcd_barrier_post((unsigned*)(args.ws + WS_CTL) + CW_BAR, MISC + 8);
#define IN(k) (lo <= (k) && (k) < hi)
#define SEAM(k) do { if (IN(k) && IN((k) + 1)) { XcdBarrier b_; b_.bar = (unsigned*)(PH_ARGS()->ws + WS_CTL) + CW_BAR; b_.x = xb_xcc_id(); b_.st = MISC + 8; xcd_barrier(b_); } } while (0)

#ifndef REP_P0
#define REP_P0 1
#endif
    if (IN(0)) { for (int rep = 0; rep < REP_P0; ++rep) { KA* ap = PH_ARGS(); const Frame F = make_frame(lds); p0_prologue(F, ap); } SEAM(0); }

#pragma unroll
    for (int l = 0; l < DEPTH; ++l) {
        const int pb = 1 + 9 * l;
        if (IN(pb + 0)) {
            KA* ap = PH_ARGS(); unsigned char* ws = ap->ws;
            pg8::Gemm g{(const bf16_t*)(ws + WS_XB), (const bf16_t*)(ws + WS_WIN + l * SZ_WIN), M, LDP, DM, DM}; pg8::StaticOrder S; S.init(M, LDP, gridDim.x, (int)blockIdx.x);
            EpiInProj E{(bf16_t*)(ws + WS_PROJ), (float*)(ws + WS_GLOG), (float*)(ws + WS_ODD), (const float*)(ws + WS_LB) + l * 1024, ap->in[6] + l * 16, (const float*)(ws + WS_SSQP), ap->in[8] + l * 256, ap->in[11] + l * 256, (LAS float*)(lds + 131072), (LAS float*)(lds + 139264), (volatile LAS int*)(MISC + 28), (float*)(ws + WS_RS)};
            if (my_tid() == 0) MISC[28] = 0xFFFFFFFFu;
#ifndef REP_G1
#define REP_G1 1
#endif
            for (int rep = 0; rep < REP_G1; ++rep) pg8::gemm_phase<EpiInProj, pg8::StaticOrder>(lds, g, S, E);
            { pg8::Gemm g2{(const bf16_t*)(ws + WS_XB), (const bf16_t*)(ws + WS_WIN + l * SZ_WIN) + (size_t)56 * 256 * DM, M, 256, DM / 4, DM}; pg8::SplitKOrder S2; S2.init(M, 4, gridDim.x, (int)blockIdx.x);
              EpiOddPart E2{(float*)(ws + WS_Y)};
              pg8::gemm_phase<EpiOddPart, pg8::SplitKOrder>(lds, g2, S2, E2); }
            if (l == 0) { KA* apb = PH_ARGS(); const Frame Fb = make_frame(lds); bg_convert(Fb, apb, (unsigned*)(apb->ws + WS_CTL) + CW_BGQ + 64 * (1 + 0), false); }
            SEAM(pb + 0);
        }
#ifndef NO_F
        if (IN(pb + 1)) { { KA* ap = PH_ARGS(); const Frame F = make_frame(lds); fixup_phase<false>(F, ap, l); }
#ifdef REP_FX
            for (int rep = 0; rep < REP_FX; ++rep) { KA* ap = PH_ARGS(); const Frame F = make_frame(lds); fixup_phase<true>(F, ap, l); }
#endif
            if (l == 0) { KA* apb = PH_ARGS(); const Frame Fb = make_frame(lds); bg_convert(Fb, apb, (unsigned*)(apb->ws + WS_CTL) + CW_BGQ + 64 * (1 + 4), false); } SEAM(pb + 1); }
#endif
        if (IN(pb + 2)) {
#ifndef REP_A
#define REP_A 1
#endif
#ifdef PROBE_LO
            for (int rep = 0; rep < 2; ++rep)
            { KA* ap = PH_ARGS(); const Frame F = make_frame(lds); mixer_a_phase<4>(F, ap, l, (unsigned*)(ap->ws + WS_CTL) + CW_Q + 64 * (2 * l) + 16 * rep, rep ? PROBE_LO : 0, rep ? PROBE_HI : IT_D); }
#else
            if (l == 0 && blockIdx.x < NCVW) { KA* apc = PH_ARGS(); const Frame Fc = make_frame(lds); conv_side(Fc, apc); }
            { KA* ap = PH_ARGS(); const Frame F = make_frame(lds); mixer_a_phase<4>(F, ap, l, (unsigned*)(ap->ws + WS_CTL) + CW_Q + 64 * (2 * l), 0, IT_D); }
#endif
            if (l == 0) { KA* apb = PH_ARGS(); const Frame Fb = make_frame(lds); bg_convert(Fb, apb, (unsigned*)(apb->ws + WS_CTL) + CW_BGQ + 64 * (1 + 5), false); } SEAM(pb + 2); }
        if (IN(pb + 3)) {
#ifndef REP_B
#define REP_B 1
#endif
            { int bx = (int)blockIdx.x; asm volatile("" : "+s"(bx)); if ((bx >> 3) & 1) { KA* ap = PH_ARGS(); const Frame F = make_frame(lds); ccombine_phase(F, ap, l); __syncthreads(); } }
            for (int rep = 0; rep < REP_B; ++rep) { KA* ap = PH_ARGS(); const Frame F = make_frame(lds); mixer_b_phase(F, ap, l, (unsigned*)(ap->ws + WS_CTL) + CW_Q + 64 * (2 * l + 1) + 16 * rep); }
            { int bx = (int)blockIdx.x; asm volatile("" : "+s"(bx)); if (!((bx >> 3) & 1)) { KA* ap = PH_ARGS(); const Frame F = make_frame(lds); ccombine_phase(F, ap, l); } }
            if (l == 0) { KA* apb = PH_ARGS(); const Frame Fb = make_frame(lds); bg_convert(Fb, apb, (unsigned*)(apb->ws + WS_CTL) + CW_BGQ + 64 * (1 + 6), false); } SEAM(pb + 3); }
        if (IN(pb + 4)) {
            KA* ap = PH_ARGS(); unsigned char* ws = ap->ws;
            pg8::Gemm g{(const bf16_t*)(ws + WS_Y), (const bf16_t*)(ws + WS_WOUT + l * SZ_WOUT), M, DM, DM, DM}; pg8::StaticOrder S; S.init(M, DM, gridDim.x, (int)blockIdx.x);
            EpiResidBf E{(bf16_t*)(ws + WS_XB), (float*)(ws + WS_SSQP)};
            pg8::gemm_phase<EpiResidBf, pg8::StaticOrder>(lds, g, S, E);
            if (l == 0) { KA* apb = PH_ARGS(); const Frame Fb = make_frame(lds); bg_convert(Fb, apb, (unsigned*)(apb->ws + WS_CTL) + CW_BGQ + 64 * (1 + 1), false); }
            SEAM(pb + 4);
        }
#ifndef REP_RN
#define REP_RN 1
#endif
        if (IN(pb + 6)) {
            KA* ap = PH_ARGS(); unsigned char* ws = ap->ws;
            pg8::Gemm g{(const bf16_t*)(ws + WS_XB), (const bf16_t*)(ws + WS_W1 + l * SZ_W1), M, FF, DM, DM}; pg8::StaticOrder S; S.init(M, FF, gridDim.x, (int)blockIdx.x);
            EpiRelu2 E{(bf16_t*)(ws + WS_PROJ), (const float*)(ws + WS_SSQP), (LAS float*)(lds + 139264), (volatile LAS int*)(MISC + 28)};
            if (my_tid() == 0) MISC[28] = 0xFFFFFFFFu;
#ifndef REP_G3
#define REP_G3 1
#endif
            for (int rep = 0; rep < REP_G3; ++rep) pg8::gemm_phase<EpiRelu2, pg8::StaticOrder>(lds, g, S, E);
            if (l == 0) { KA* apb = PH_ARGS(); const Frame Fb = make_frame(lds); bg_convert(Fb, apb, (unsigned*)(apb->ws + WS_CTL) + CW_BGQ + 64 * (1 + 2), false); }
            SEAM(pb + 6);
        }
        if (IN(pb + 7)) {
            KA* ap = PH_ARGS(); unsigned char* ws = ap->ws;
            pg8::Gemm g{(const bf16_t*)(ws + WS_PROJ), (const bf16_t*)(ws + WS_W2 + l * SZ_W2), M, DM, FF, FF}; pg8::StaticOrder S; S.init(M, DM, gridDim.x, (int)blockIdx.x);
            if (l + 1 < DEPTH) { EpiResidBf E{(bf16_t*)(ws + WS_XB), (float*)(ws + WS_SSQP)}; pg8::gemm_phase<EpiResidBf, pg8::StaticOrder>(lds, g, S, E); }
            else { EpiFinal E{(const bf16_t*)(ws + WS_XB), ap->out}; pg8::gemm_phase<EpiFinal, pg8::StaticOrder>(lds, g, S, E); }
            if (l == 0) { KA* apb = PH_ARGS(); const Frame Fb = make_frame(lds); bg_convert(Fb, apb, nullptr, true); }
            SEAM(pb + 7);
        }
    }
#undef IN
#undef SEAM
}

extern "C" void kernel_launch(void* const* d_in, const int* in_sizes, int n_in, void* d_out, int out_size, void* d_ws, size_t ws_size, hipStream_t stream) {
    static int grid = 0;
    if (grid == 0) {
        if (n_in != 17 || in_sizes[0] != M * DM || out_size != M * DM || ws_size < WS_END) { fprintf(stderr, "kernel_launch: unexpected shapes (n_in %d in0 %d out %d ws %zu need %zu)\n", n_in, in_sizes[0], out_size, ws_size, (size_t)WS_END); grid = -1; return; }
        int dev = 0, cus = 0;
        if (hipGetDevice(&dev) != hipSuccess || hipDeviceGetAttribute(&cus, hipDeviceAttributeMultiprocessorCount, dev) != hipSuccess) { grid = -1; return; }
        if (hipFuncSetAttribute((const void*)mk_fwd, hipFuncAttributeMaxDynamicSharedMemorySize, LDS_BYTES) != hipSuccess) { fprintf(stderr, "kernel_launch: hipFuncSetAttribute failed\n"); grid = -1; return; }
        int per_cu = 0;
        if (hipOccupancyMaxActiveBlocksPerMultiprocessor(&per_cu, (const void*)mk_fwd, 512, LDS_BYTES) != hipSuccess || per_cu < 1) fprintf(stderr, "kernel_launch: occupancy query reports %d\n", per_cu);
        (void)hipGetLastError();
        grid = cus < 256 ? cus : 256;
    }
    if (grid < 0) return;
    if (hipMemsetAsync((char*)d_ws + WS_CTL, 0, CTL_BYTES, stream) != hipSuccess) return;
    Args a{};
    for (int i = 0; i < 17; ++i) a.in[i] = (const float*)d_in[i];
    a.out = (float*)d_out; a.ws = (unsigned char*)d_ws;
#if ONE_LAUNCH
    a.ph_lo = 0; a.ph_hi = NPHASE;
    hipLaunchKernelGGL(mk_fwd, dim3(grid), dim3(512), LDS_BYTES, stream, a);
#else
    for (int p = 0; p < NPHASE; ++p) { a.ph_lo = p; a.ph_hi = p + 1; hipLaunchKernelGGL(mk_fwd, dim3(grid), dim3(512), LDS_BYTES, stream, a); }
#endif
}
```

```cpp
#include <hip/hip_runtime.h>
#include <cstdio>
#include <cstdint>

#ifndef ONE_LAUNCH
#define ONE_LAUNCH 1
#endif

#define LAS __attribute__((address_space(3)))
typedef unsigned short bf16_t;
typedef short bf16x8 __attribute__((ext_vector_type(8)));
typedef short s16x4 __attribute__((ext_vector_type(4)));
typedef float f32x2 __attribute__((ext_vector_type(2)));
typedef float f32x4 __attribute__((ext_vector_type(4)));
typedef float f32x16 __attribute__((ext_vector_type(16)));
typedef unsigned u32x2 __attribute__((ext_vector_type(2)));
typedef unsigned u32x4 __attribute__((ext_vector_type(4)));

constexpr int T = 8192, NB = 2, M = NB * T, DM = 4096, FF = 16384, DEPTH = 2;
constexpr int NIN = 14432, NINP = 14592;
constexpr int LDP = 14336;
constexpr int C_AQ = 0, C_AF = 1024, C_AI = 2048, C_AG = 3072, C_BQK = 4096, C_BV = 5120, C_BO = 6144;
constexpr int C_CQ = 7168, C_CK = 8192, C_CV = 9216, C_DQ = 10240, C_DK = 11264, C_DV = 12288, C_DQI = 13312;
constexpr int LDO = 128;
constexpr float EPS = 1e-6f;

constexpr size_t MiB = 1u << 20;
constexpr size_t WS_CTL = 0, CTL_BYTES = 2 * MiB;
constexpr size_t SZ_WIN = (size_t)NINP * DM * 2, SZ_WOUT = (size_t)DM * DM * 2, SZ_W1 = (size_t)FF * DM * 2, SZ_W2 = (size_t)DM * FF * 2;
constexpr size_t WS_WIN = WS_CTL + CTL_BYTES;
constexpr size_t WS_WOUT = WS_WIN + 2 * SZ_WIN;
constexpr size_t WS_W1 = WS_WOUT + 2 * SZ_WOUT;
constexpr size_t WS_W2 = WS_W1 + 2 * SZ_W1;
constexpr size_t WS_XB = WS_W2 + 2 * SZ_W2;
constexpr size_t WS_PROJ = WS_XB + (size_t)M * DM * 2;
constexpr size_t WS_GLOG = WS_PROJ + (size_t)M * LDP * 2;
constexpr size_t WS_ODD = WS_GLOG + (size_t)M * 1024 * 4;
constexpr size_t WS_Y = WS_ODD + (size_t)M * LDO * 4;
constexpr size_t WS_MASK = WS_Y + (size_t)M * DM * 2;
constexpr size_t WS_BQK = WS_MASK + (size_t)NB * 256 * T * 4;
constexpr size_t WS_KI = WS_BQK + (size_t)M * 1024 * 2;
constexpr size_t WS_LB = WS_KI + (size_t)M * 64 * 2;
constexpr size_t WS_SCB = WS_LB + 65536;
constexpr size_t WS_CATT = WS_SCB + (size_t)256 * 8 * 4 * T * 4;
constexpr size_t WS_SSQP = WS_CATT + (size_t)M * 2048 * 4;
constexpr size_t WS_RS = WS_SSQP + (size_t)64 * M * 4;
constexpr size_t WS_END = WS_RS + (size_t)M * 4;
static_assert((size_t)M * LDP * 2 + (size_t)M * 1024 * 4 == (size_t)M * FF * 2, "HID overlay");

constexpr int CW_BAR = 1024;
constexpr int CW_BGQ = 12288;
constexpr int CW_Q = 8192;

constexpr int LDS_BYTES = 147456;
constexpr int LDS_MISC = LDS_BYTES - 512;
constexpr int LDS_WTAB = LDS_BYTES - 256;
constexpr int NPHASE = 1 + 9 * DEPTH;

__host__ __device__ __forceinline__ size_t tiled_off(size_t row, int col, int K) { return ((((row >> 8) * (size_t)(K >> 6)) + (size_t)(col >> 6)) * 256 + (row & 255)) * 64 + (col & 63); }
__device__ __forceinline__ unsigned cvt_pk_bf16(float lo, float hi) { unsigned r; asm volatile("v_cvt_pk_bf16_f32 %0, %1, %2" : "=v"(r) : "v"(lo), "v"(hi)); return r; }
__device__ __forceinline__ float bf_lo(unsigned u) { return __uint_as_float(u << 16); }
__device__ __forceinline__ float bf_hi(unsigned u) { return __uint_as_float(u & 0xffff0000u); }
__device__ __forceinline__ float bf2f(bf16_t b) { return __uint_as_float(((unsigned)b) << 16); }
__device__ __forceinline__ float fast_sigmoid(float v) { return __builtin_amdgcn_rcpf(1.f + __expf(-v)); }
__device__ __forceinline__ float fast_silu(float v) { return v * fast_sigmoid(v); }
__device__ __forceinline__ int my_tid() {
    unsigned lane; asm volatile("v_mbcnt_lo_u32_b32 %0, -1, 0\n\tv_mbcnt_hi_u32_b32 %0, -1, %0" : "=v"(lane));
    const unsigned slot = (unsigned)__builtin_amdgcn_s_getreg((5 << 11) | 4) & 63u;
    const unsigned wv = *(volatile LAS unsigned*)(uintptr_t)(LDS_WTAB + slot * 4);
    return __builtin_amdgcn_readfirstlane((int)wv) * 64 + (int)lane;
}
__device__ __forceinline__ float sx(float v, int o, int lane) { return __int_as_float(__builtin_amdgcn_ds_bpermute((lane ^ o) << 2, __float_as_int(v))); }
#define DPPF(v, ctrl) __int_as_float(__builtin_amdgcn_update_dpp(0, __float_as_int(v), (ctrl), 0xf, 0xf, true))
__device__ __forceinline__ float xrow16_sum(float x) {
    auto s = __builtin_amdgcn_permlane16_swap(__float_as_uint(x), __float_as_uint(x), false, false);
    x = __uint_as_float(s[0]) + __uint_as_float(s[1]);
    auto t = __builtin_amdgcn_permlane32_swap(__float_as_uint(x), __float_as_uint(x), false, false);
    return __uint_as_float(t[0]) + __uint_as_float(t[1]);
}
__device__ __forceinline__ float sum8(float v) { v += DPPF(v, 0xB1); v += DPPF(v, 0x4E); v += DPPF(v, 0x141); return v; }
__device__ __forceinline__ float sum16(float v) { v = sum8(v); v += DPPF(v, 0x140); return v; }
__device__ __forceinline__ float sidx(float v, int src) { return __int_as_float(__builtin_amdgcn_ds_bpermute(src << 2, __float_as_int(v))); }
__device__ __forceinline__ unsigned sidxu(unsigned v, int src) { return (unsigned)__builtin_amdgcn_ds_bpermute(src << 2, (int)v); }
__device__ __forceinline__ u32x4 zero4() { unsigned z = 0u; asm volatile("" : "+v"(z)); return (u32x4){z, z, z, z}; }

namespace pg8 {
constexpr int BM = 256, BK = 64, HALF = 128, HTB = HALF * BK * 2, STAGE_BYTES = 8 * HTB, NXCD = 8, WGM = 8;
__host__ __device__ __forceinline__ int lds_byte(int r, int c) { const int st = (r >> 4) * 2 + (c >> 5), rr = r & 15, cc = c & 31, ob = rr * 64 + cc * 2; return st * 1024 + (ob ^ (((ob >> 9) & 1) << 5)); }
__host__ __device__ __forceinline__ void stage_rc(int b, int& R, int& C) { const int st = b / 1024, sb = b % 1024, swz = sb ^ (((sb >> 9) & 1) << 5); R = (st >> 1) * 16 + swz / 64; C = (st & 1) * 32 + (swz % 64) / 2; }
__host__ __device__ __forceinline__ int perm32(int rho) { const int n = rho >> 4, i = rho & 15; return 8 * (i >> 2) + 4 * n + (i & 3); }
struct Unit { int pm, pn; };
struct Gemm { const bf16_t* A; const bf16_t* Bt; int M, N, K, Kld; };
struct StaticOrder {
    int nM, nN, nwg, G, c;
    __host__ __device__ void init(int M_, int N_, int G_, int c_) { nM = M_ / BM; nN = N_ / BM; nwg = nM * nN; G = G_; c = c_; }
    __host__ __device__ bool next(int i, Unit& u) const {
        const long L = (long)i * G + c; if (L >= nwg) return false;
        int wgid = (int)L; { const int q = nwg / NXCD, r = nwg % NXCD, xcd = wgid % NXCD, off = wgid / NXCD; wgid = (xcd < r ? xcd * (q + 1) : r * (q + 1) + (xcd - r) * q) + off; }
        const int nig = WGM * nN, gid = wgid / nig, fm = gid * WGM, gsz = (nM - fm) < WGM ? (nM - fm) : WGM;
        u.pm = fm + ((wgid % nig) % gsz); u.pn = (wgid % nig) / gsz; return true;
    }
    __device__ __forceinline__ void a_ready(const Unit&) const {}
    __device__ __forceinline__ void done(const Unit&) const {}
    __device__ __forceinline__ size_t aoff(const Unit& u, size_t tstep, size_t) const { return (size_t)u.pm * tstep; }
    __device__ __forceinline__ size_t boff(const Unit& u, size_t tstep, size_t) const { return (size_t)u.pn * tstep; }
};
struct SplitKOrder {
    int G, c, nunits, nsplit;
    __device__ void init(int M_, int nsplit_, int G_, int c_) { nsplit = nsplit_; nunits = (M_ / BM) * nsplit_; G = G_; c = c_; }
    __device__ bool next(int i, Unit& u) const { const int L = i * G + c; if (L >= nunits) return false; u.pm = L / nsplit; u.pn = L % nsplit; return true; }
    __device__ __forceinline__ void a_ready(const Unit&) const {}
    __device__ __forceinline__ size_t aoff(const Unit& u, size_t tstep, size_t kspan) const { return (size_t)u.pm * tstep + (size_t)u.pn * kspan; }
    __device__ __forceinline__ size_t boff(const Unit& u, size_t, size_t kspan) const { return (size_t)u.pn * kspan; }
};

template <class Epi, class Sched>
__device__ __forceinline__ void gemm_phase(LAS unsigned char* lds, const Gemm g, const Sched& S, const Epi& E) {
    const int tid_ = my_tid();
    const int tid = tid_, wid = __builtin_amdgcn_readfirstlane(tid >> 6), lane = tid & 63, wr = wid >> 2, wc = wid & 3, fr = lane & 15, fq = lane >> 4;
    const int K = g.K, nt = K / BK;
    unsigned voffA[2], voffB[2];
#pragma unroll
    for (int i = 0; i < 2; ++i) { int R, C; stage_rc(tid * 16 + i * 8192, R, C); const int Rb = Epi::PERM ? ((R & ~31) + perm32(R & 31)) : R;
        voffA[i] = (unsigned)(R * 64 + C) * 2u; voffB[i] = (unsigned)(Rb * 64 + C) * 2u; }
    const size_t kstep = (size_t)(BM * BK * 2);
    const size_t hstep = (size_t)HALF * BK * 2;
    const size_t tstep = (size_t)BM * g.Kld * 2, kspan = (size_t)nt * kstep;
    const unsigned ldsw = (unsigned)wid * 1024u;
    const int aoff = lds_byte(wr * 64 + fr, fq * 8), boff = lds_byte(wc * 32 + fr, fq * 8);
#define PG8_SA(b, h) (((b) * 2 + (h)) * HTB)
#define PG8_SB(b, h) ((4 + (b) * 2 + (h)) * HTB)
#define PG8_STAGE(bufoff, gbase, voff) do { _Pragma("unroll") for (int _i = 0; _i < 2; ++_i) \
        __builtin_amdgcn_global_load_lds((const unsigned*)((const char*)(gbase) + (voff)[_i]), (LAS unsigned*)(lds + (bufoff) + ldsw + _i * 8192), 16, 0, 0); } while (0)
#define PG8_LDA(dst, b, h) do { _Pragma("unroll") for (int m = 0; m < 4; ++m) _Pragma("unroll") for (int k = 0; k < 2; ++k) dst[m][k] = *(const LAS bf16x8*)(lds + PG8_SA(b, h) + aoff + m * 2048 + k * 1024); } while (0)
#define PG8_LDB(dst, b, h) do { _Pragma("unroll") for (int n = 0; n < 2; ++n) _Pragma("unroll") for (int k = 0; k < 2; ++k) dst[n][k] = *(const LAS bf16x8*)(lds + PG8_SB(b, h) + boff + n * 2048 + k * 1024); } while (0)
#define PG8_MMA(ai, bj, At, Bt) do { __builtin_amdgcn_s_setprio(1); _Pragma("unroll") for (int m = 0; m < 4; ++m) _Pragma("unroll") for (int n = 0; n < 2; ++n) _Pragma("unroll") for (int k = 0; k < 2; ++k) \
        acc[ai][bj][m][n] = __builtin_amdgcn_mfma_f32_16x16x32_bf16(Bt[n][k], At[m][k], acc[ai][bj][m][n], 0, 0, 0); __builtin_amdgcn_s_setprio(0); } while (0)
#define PG8_WAIT_V(n) asm volatile("s_waitcnt vmcnt(" #n ")" ::: "memory")
#define PG8_WAIT_L(n) asm volatile("s_waitcnt lgkmcnt(" #n ")" ::: "memory")
#define PG8_BAR __builtin_amdgcn_s_barrier()
#define PG8_SCHED __builtin_amdgcn_sched_barrier(0)
    Unit cur, nxt; int ui = 0;
    if (!S.next(0, cur)) return;
    f32x4 acc[2][2][4][2];
#pragma unroll
    for (int a = 0; a < 2; ++a)
#pragma unroll
        for (int b = 0; b < 2; ++b)
#pragma unroll
            for (int m = 0; m < 4; ++m)
#pragma unroll
                for (int n = 0; n < 2; ++n) acc[a][b][m][n] = (f32x4){0.f, 0.f, 0.f, 0.f};
    bf16x8 At[4][2], B0[2][2], B1[2][2];
    const char* cA = (const char*)g.A + S.aoff(cur, tstep, kspan); const char* cB = (const char*)g.Bt + S.boff(cur, tstep, kspan);
    S.a_ready(cur);
    PG8_STAGE(PG8_SB(0, 0), cB, voffB); PG8_STAGE(PG8_SB(0, 1), cB + hstep, voffB); PG8_STAGE(PG8_SA(0, 0), cA, voffA); PG8_STAGE(PG8_SA(0, 1), cA + hstep, voffA);
    if (wr == 1) PG8_BAR;
    PG8_WAIT_V(2); PG8_BAR;
    PG8_STAGE(PG8_SB(1, 0), cB + kstep, voffB); PG8_STAGE(PG8_SA(1, 0), cA + kstep, voffA); PG8_STAGE(PG8_SB(1, 1), cB + hstep + kstep, voffB);
    PG8_WAIT_V(6); PG8_BAR;
    for (;;) {
        const bool has_next = S.next(ui + 1, nxt);
        const char* nA = has_next ? (const char*)g.A + S.aoff(nxt, tstep, kspan) : cA; const char* nB = has_next ? (const char*)g.Bt + S.boff(nxt, tstep, kspan) : cB;
        for (int t = 0; t < nt; t += 2) {
            const bool last = (t == nt - 2);
            const char* a1 = cA + (size_t)(t + 1) * kstep;
            const char* a2 = last ? nA : cA + (size_t)(t + 2) * kstep; const char* b2 = last ? nB : cB + (size_t)(t + 2) * kstep;
            const char* a3 = a2 + kstep; const char* b3 = b2 + kstep;
            if (last && has_next) S.a_ready(nxt);
            PG8_LDB(B0, 0, 0); PG8_LDB(B1, 0, 1); PG8_SCHED; PG8_LDA(At, 0, 0); PG8_STAGE(PG8_SA(1, 1), a1 + hstep, voffA);
            PG8_WAIT_V(8); PG8_WAIT_L(0); PG8_BAR; PG8_MMA(0, 0, At, B0); if constexpr (!Epi::HALF_ALL) PG8_MMA(0, 1, At, B1); PG8_BAR; PG8_SCHED;
            PG8_LDA(At, 0, 1); PG8_STAGE(PG8_SB(0, 0), b2, voffB); PG8_STAGE(PG8_SB(0, 1), b2 + hstep, voffB); PG8_STAGE(PG8_SA(0, 0), a2, voffA);
            PG8_WAIT_V(8); PG8_WAIT_L(0); PG8_BAR; PG8_MMA(1, 0, At, B0); if constexpr (!Epi::HALF_ALL) PG8_MMA(1, 1, At, B1); PG8_BAR; PG8_SCHED;
            PG8_LDB(B0, 1, 0); PG8_LDB(B1, 1, 1); PG8_SCHED; PG8_LDA(At, 1, 0); PG8_STAGE(PG8_SA(0, 1), a2 + hstep, voffA);
            PG8_WAIT_V(8); PG8_WAIT_L(0); PG8_BAR; PG8_MMA(0, 0, At, B0); if constexpr (!Epi::HALF_ALL) PG8_MMA(0, 1, At, B1); PG8_BAR; PG8_SCHED;
            PG8_LDA(At, 1, 1); PG8_STAGE(PG8_SB(1, 0), b3, voffB); PG8_STAGE(PG8_SB(1, 1), b3 + hstep, voffB); PG8_STAGE(PG8_SA(1, 0), a3, voffA);
            PG8_WAIT_V(8); PG8_WAIT_L(0); PG8_BAR; PG8_MMA(1, 0, At, B0); if constexpr (!Epi::HALF_ALL) PG8_MMA(1, 1, At, B1); PG8_BAR; PG8_SCHED;
        }
        if (wr == 0) PG8_BAR;
        E(acc, cur, wr, wc, fr, fq);
        if (!has_next) break;
#pragma unroll
        for (int a = 0; a < 2; ++a)
#pragma unroll
            for (int b = 0; b < 2; ++b)
#pragma unroll
                for (int m = 0; m < 4; ++m)
#pragma unroll
                    for (int n = 0; n < 2; ++n) acc[a][b][m][n] = (f32x4){0.f, 0.f, 0.f, 0.f};
        cur = nxt; cA = nA; cB = nB; ++ui;
        if (wr == 1) PG8_BAR;
    }
    PG8_WAIT_V(0);
    PG8_BAR;
#undef PG8_SA
#undef PG8_SB
#undef PG8_STAGE
#undef PG8_LDA
#undef PG8_LDB
#undef PG8_MMA
#undef PG8_WAIT_V
#undef PG8_WAIT_L
#undef PG8_BAR
#undef PG8_SCHED
}
}

__device__ __forceinline__ void rs_panel(const float* SSQP, int pm, LAS float* rsl, volatile LAS int* tag, int tid, float* rsg = nullptr) {
    if (*tag == pm) return;
    const int row = tid >> 1, h = tid & 1; const float* p = SSQP + (size_t)(h * 32) * M + pm * 256 + row; float s = 0.f;
#pragma unroll 8
    for (int j = 0; j < 32; ++j) s += p[(size_t)j * M];
    s += DPPF(s, 0xB1);
    __syncthreads();
    if (h == 0) { const float rv = 1.f / sqrtf(s * (1.f / DM) + EPS); rsl[row] = rv; if (rsg) rsg[pm * 256 + row] = rv; }
    if (tid == 0) *tag = pm;
    __syncthreads();
}
struct EpiResidBf {
    static constexpr bool PERM = true; static constexpr bool HALF_ALL = false;
    bf16_t* XR; float* SSQP;
    __device__ __forceinline__ void operator()(const f32x4 (&acc)[2][2][4][2], const pg8::Unit& u, int wr, int wc, int fr, int fq) const {
        const int row0 = u.pm * 256 + wr * 64 + fr, col0 = u.pn * 256 + wc * 32 + 8 * fq;
#pragma unroll
        for (int ai = 0; ai < 2; ++ai) {
            u32x4 xr[4][2]; float ssv[4];
#pragma unroll
            for (int m = 0; m < 4; ++m)
#pragma unroll
                for (int bj = 0; bj < 2; ++bj) xr[m][bj] = *(const u32x4*)(XR + tiled_off((size_t)(row0 + ai * 128 + m * 16), col0, DM) + (size_t)bj * 2 * 256 * 64);
#pragma unroll
            for (int m = 0; m < 4; ++m) { bf16_t* rowp = XR + tiled_off((size_t)(row0 + ai * 128 + m * 16), col0, DM); float ss = 0.f;
#pragma unroll
                for (int bj = 0; bj < 2; ++bj) { const u32x4 x = xr[m][bj];
                    const f32x4 a0 = acc[ai][bj][m][0], a1 = acc[ai][bj][m][1];
                    u32x4 o; o.x = cvt_pk_bf16(bf_lo(x.x) + a0[0], bf_hi(x.x) + a0[1]); o.y = cvt_pk_bf16(bf_lo(x.y) + a0[2], bf_hi(x.y) + a0[3]);
                    o.z = cvt_pk_bf16(bf_lo(x.z) + a1[0], bf_hi(x.z) + a1[1]); o.w = cvt_pk_bf16(bf_lo(x.w) + a1[2], bf_hi(x.w) + a1[3]);
                    *(u32x4*)(rowp + (size_t)bj * 2 * 256 * 64) = o;
                    ss += bf_lo(o.x) * bf_lo(o.x) + bf_hi(o.x) * bf_hi(o.x) + bf_lo(o.y) * bf_lo(o.y) + bf_hi(o.y) * bf_hi(o.y)
                        + bf_lo(o.z) * bf_lo(o.z) + bf_hi(o.z) * bf_hi(o.z) + bf_lo(o.w) * bf_lo(o.w) + bf_hi(o.w) * bf_hi(o.w); }
                ssv[m] = xrow16_sum(ss); }
            if (fq == 0) {
#pragma unroll
                for (int m = 0; m < 4; ++m) SSQP[(size_t)(u.pn * 4 + wc) * M + row0 + ai * 128 + m * 16] = ssv[m]; }
        }
    }
};
struct EpiFinal {
    static constexpr bool PERM = true; static constexpr bool HALF_ALL = false;
    const bf16_t* XR; float* out;
    __device__ __forceinline__ void operator()(const f32x4 (&acc)[2][2][4][2], const pg8::Unit& u, int wr, int wc, int fr, int fq) const {
        const int row0 = u.pm * 256 + wr * 64 + fr, col0 = u.pn * 256 + wc * 32 + 8 * fq;
#pragma unroll
        for (int ai = 0; ai < 2; ++ai) {
          u32x4 xr[4][2];
#pragma unroll
          for (int m = 0; m < 4; ++m)
#pragma unroll
              for (int bj = 0; bj < 2; ++bj) xr[m][bj] = *(const u32x4*)(XR + tiled_off((size_t)(row0 + ai * 128 + m * 16), col0, DM) + (size_t)bj * 2 * 256 * 64);
#pragma unroll
            for (int m = 0; m < 4; ++m) { const int row = row0 + ai * 128 + m * 16; float* op = out + (size_t)row * DM + col0;
#pragma unroll
                for (int bj = 0; bj < 2; ++bj) { const u32x4 x = xr[m][bj];
                    const f32x4 a0 = acc[ai][bj][m][0], a1 = acc[ai][bj][m][1];
                    *(f32x4*)(op + bj * 128) = (f32x4){bf_lo(x.x) + a0[0], bf_hi(x.x) + a0[1], bf_lo(x.y) + a0[2], bf_hi(x.y) + a0[3]};
                    *(f32x4*)(op + bj * 128 + 4) = (f32x4){bf_lo(x.z) + a1[0], bf_hi(x.z) + a1[1], bf_lo(x.w) + a1[2], bf_hi(x.w) + a1[3]}; } }
        }
    }
};
struct EpiRelu2 {
    static constexpr bool PERM = true; static constexpr bool HALF_ALL = false;
    bf16_t* O; const float* SSQP; LAS float* rsl; volatile LAS int* tag;
    __device__ __forceinline__ void operator()(const f32x4 (&acc)[2][2][4][2], const pg8::Unit& u, int wr, int wc, int fr, int fq) const {
        const int row0 = u.pm * 256 + wr * 64 + fr, col0 = u.pn * 256 + wc * 32 + 8 * fq;
        rs_panel(SSQP, u.pm, rsl, tag, (wr * 4 + wc) * 64 + fq * 16 + fr);
        float rsv[8];
#pragma unroll
        for (int q = 0; q < 8; ++q) rsv[q] = rsl[wr * 64 + fr + (q >> 2) * 128 + (q & 3) * 16];
#pragma unroll
        for (int ai = 0; ai < 2; ++ai)
#pragma unroll
            for (int m = 0; m < 4; ++m) { bf16_t* rowp = O + tiled_off((size_t)(row0 + ai * 128 + m * 16), col0, FF);
#pragma unroll
                for (int bj = 0; bj < 2; ++bj) { const float rs = rsv[ai * 4 + m]; f32x4 v0 = acc[ai][bj][m][0] * rs, v1 = acc[ai][bj][m][1] * rs;
#pragma unroll
                    for (int j = 0; j < 4; ++j) { const float a = fmaxf(v0[j], 0.f), b = fmaxf(v1[j], 0.f); v0[j] = a * a; v1[j] = b * b; }
                    u32x4 o; o.x = cvt_pk_bf16(v0[0], v0[1]); o.y = cvt_pk_bf16(v0[2], v0[3]); o.z = cvt_pk_bf16(v1[0], v1[1]); o.w = cvt_pk_bf16(v1[2], v1[3]);
                    *(u32x4*)(rowp + (size_t)bj * 2 * 256 * 64) = o; } }
    }
};
struct EpiOddPart {
    static constexpr bool PERM = true; static constexpr bool HALF_ALL = true;
    float* ODDP;
    __device__ __forceinline__ void operator()(const f32x4 (&acc)[2][2][4][2], const pg8::Unit& u, int wr, int wc, int fr, int fq) const {
        const int row0 = u.pm * 256 + wr * 64 + fr, c0 = wc * 32 + 8 * fq;
        if (c0 >= 96) return;
#pragma unroll
        for (int ai = 0; ai < 2; ++ai)
#pragma unroll
            for (int m = 0; m < 4; ++m) { float* p = ODDP + ((size_t)u.pn * M + row0 + ai * 128 + m * 16) * 128 + c0; *(f32x4*)p = acc[ai][0][m][0]; *(f32x4*)(p + 4) = acc[ai][0][m][1]; }
    }
};
struct EpiInProj {
    static constexpr bool PERM = true; static constexpr bool HALF_ALL = false;
    bf16_t* PROJ; float* GLOG; float* ODD; const float* lb; const float* gbias; const float* SSQP;
    const float* gcqk; const float* gdqk; LAS float* xch; LAS float* rsl; volatile LAS int* tag; float* RSG;
    __device__ __forceinline__ void operator()(const f32x4 (&acc)[2][2][4][2], const pg8::Unit& u, int wr, int wc, int fr, int fq) const {
        const int row0 = u.pm * 256 + wr * 64 + fr; const int pn = u.pn;
        const int seg = pn >> 2;
        rs_panel(SSQP, u.pm, rsl, tag, (wr * 4 + wc) * 64 + fq * 16 + fr, RSG);
        float rsv[8];
#pragma unroll
        for (int q = 0; q < 8; ++q) rsv[q] = rsl[wr * 64 + fr + (q >> 2) * 128 + (q & 3) * 16];
        int kind = 0;
        if (pn >= 56) kind = 6; else if (seg == 0) kind = 1; else if (seg == 1) kind = 5; else if (seg == 3) kind = 2; else if (seg == 6) kind = 3; else if (seg == 13) kind = 4; else if (seg == 7 || seg == 8 || seg == 10 || seg == 11) kind = 7;
        if (kind == 6) {
            const int c0 = wc * 32 + 8 * fq;
            if (c0 >= 96) return;
#pragma unroll
            for (int ai = 0; ai < 2; ++ai)
#pragma unroll
                for (int m = 0; m < 4; ++m) { float* rowp = ODD + (size_t)(row0 + ai * 128 + m * 16) * LDO + c0;
                    const float rs = rsv[ai * 4 + m]; f32x4 v0 = acc[ai][0][m][0] * rs, v1 = acc[ai][0][m][1] * rs;
                    if (c0 >= 64 && c0 < 80) { v0 = v0 * 0.25f; v1 = v1 * 0.25f; }
                    else if (c0 == 80) {
#pragma unroll
                        for (int j = 0; j < 4; ++j) { v0[j] += gbias[j]; v1[j] += gbias[4 + j]; } }
                    else if (c0 == 88) {
#pragma unroll
                        for (int j = 0; j < 4; ++j) { const float a = v0[j] + gbias[8 + j], b = v1[j] + gbias[12 + j];
                            v0[j] = fminf(a, 0.f) - __logf(1.f + __expf(-fabsf(a))); v1[j] = fminf(b, 0.f) - __logf(1.f + __expf(-fabsf(b))); } }
                    *(f32x4*)rowp = v0; *(f32x4*)(rowp + 4) = v1; }
            return;
        }
        const int col0 = pn * 256 + wc * 32 + 8 * fq;
        if (kind == 7) {
            const float* gp = ((seg < 9) ? gcqk : gdqk) + ((seg == 8 || seg == 11) ? 128 : 0) + wc * 32 + 8 * fq;
            const f32x4 g0 = *(const f32x4*)gp, g1 = *(const f32x4*)(gp + 4);
            float ssv[16];
#pragma unroll
            for (int ai = 0; ai < 2; ++ai)
#pragma unroll
                for (int m = 0; m < 4; ++m)
#pragma unroll
                    for (int bj = 0; bj < 2; ++bj) { const f32x4 a0 = acc[ai][bj][m][0], a1 = acc[ai][bj][m][1];
                        const float ss = (a0[0] * a0[0] + a0[1] * a0[1]) + (a0[2] * a0[2] + a0[3] * a0[3]) + (a1[0] * a1[0] + a1[1] * a1[1]) + (a1[2] * a1[2] + a1[3] * a1[3]);
                        ssv[(ai * 4 + m) * 2 + bj] = xrow16_sum(ss); }
            if (fq == 0) {
#pragma unroll
                for (int q = 0; q < 16; ++q) xch[((((q >> 3) * 128 + wr * 64 + ((q >> 1) & 3) * 16 + fr) * 2 + (q & 1)) * 4) + wc] = ssv[q];
            }
            __syncthreads();
#pragma unroll
            for (int ai = 0; ai < 2; ++ai)
#pragma unroll
                for (int m = 0; m < 4; ++m) { bf16_t* rowp = PROJ + (size_t)(row0 + ai * 128 + m * 16) * LDP + col0; const float rs = rsv[ai * 4 + m];
#pragma unroll
                    for (int bj = 0; bj < 2; ++bj) { const f32x4 pq = *(const LAS f32x4*)(xch + ((ai * 128 + wr * 64 + m * 16 + fr) * 2 + bj) * 4);
                        const float rn = rs * __builtin_amdgcn_rsqf(rs * rs * ((pq[0] + pq[1]) + (pq[2] + pq[3])) * (1.f / 128.f) + EPS);
                        const f32x4 v0 = acc[ai][bj][m][0] * rn * g0, v1 = acc[ai][bj][m][1] * rn * g1;
                        u32x4 o; o.x = cvt_pk_bf16(v0[0], v0[1]); o.y = cvt_pk_bf16(v0[2], v0[3]); o.z = cvt_pk_bf16(v1[0], v1[1]); o.w = cvt_pk_bf16(v1[2], v1[3]);
                        *(u32x4*)(rowp + bj * 128) = o; } }
            return;
        }
        if (kind == 5) {
            const int lc = col0 - C_AF;
            f32x4 l0[2], l1[2];
#pragma unroll
            for (int bj = 0; bj < 2; ++bj) { l0[bj] = *(const f32x4*)(lb + lc + bj * 128); l1[bj] = *(const f32x4*)(lb + lc + bj * 128 + 4); }
#pragma unroll
            for (int ai = 0; ai < 2; ++ai)
#pragma unroll
                for (int m = 0; m < 4; ++m) { float* rowp = GLOG + (size_t)(row0 + ai * 128 + m * 16) * 1024 + lc;
#pragma unroll
                    for (int bj = 0; bj < 2; ++bj) { const float rs = rsv[ai * 4 + m]; f32x4 v0 = acc[ai][bj][m][0] * rs, v1 = acc[ai][bj][m][1] * rs;
#pragma unroll
                        for (int j = 0; j < 4; ++j) { const float fa = l0[bj][j] + (1.f - l0[bj][j]) * fast_sigmoid(v0[j]), fb = l1[bj][j] + (1.f - l1[bj][j]) * fast_sigmoid(v1[j]);
                            v0[j] = __logf(fmaxf(fa, 1e-20f)); v1[j] = __logf(fmaxf(fb, 1e-20f)); }
                        *(f32x4*)(rowp + bj * 128) = v0; *(f32x4*)(rowp + bj * 128 + 4) = v1; } }
            return;
        }
#pragma unroll
        for (int ai = 0; ai < 2; ++ai)
#pragma unroll
            for (int m = 0; m < 4; ++m) { bf16_t* rowp = PROJ + (size_t)(row0 + ai * 128 + m * 16) * LDP + col0;
#pragma unroll
                for (int bj = 0; bj < 2; ++bj) { const float rs = rsv[ai * 4 + m]; f32x4 v0 = acc[ai][bj][m][0] * rs, v1 = acc[ai][bj][m][1] * rs;
                    if (kind == 1) {
#pragma unroll
                        for (int j = 0; j < 4; ++j) { v0[j] = fast_silu(v0[j]) * 0.08838834764831845f; v1[j] = fast_silu(v1[j]) * 0.08838834764831845f; } }
                    else if (kind == 2) {
#pragma unroll
                        for (int j = 0; j < 4; ++j) { v0[j] = fast_silu(v0[j]); v1[j] = fast_silu(v1[j]); } }
                    else if (kind == 3) {
#pragma unroll
                        for (int j = 0; j < 4; ++j) { v0[j] = fast_sigmoid(v0[j]); v1[j] = fast_sigmoid(v1[j]); } }
                    else if (kind == 4) { v0 = v0 * 0.015625f; v1 = v1 * 0.015625f; }
                    u32x4 o; o.x = cvt_pk_bf16(v0[0], v0[1]); o.y = cvt_pk_bf16(v0[2], v0[3]); o.z = cvt_pk_bf16(v1[0], v1[1]); o.w = cvt_pk_bf16(v1[2], v1[3]);
                    *(u32x4*)(rowp + bj * 128) = o; } }
    }
};


namespace att {
constexpr int D = 128, NW = 8, QBLK = 32, KVBLK = 64, QB = NW * QBLK;
constexpr int SHM_V = KVBLK * D * 2, SHM_K = KVBLK * D * 2;
constexpr int ATT_LDS = 2 * SHM_V + 2 * SHM_K + NW * 64 * 4;
constexpr float SCALE = 0.08838834764831845f, THR = 8.f;
#define KSWZ(row, colB) ((row) * 256 + ((colB) ^ (((row) & 7) << 4)))
#define SBAR() __builtin_amdgcn_sched_barrier(0)
__device__ __forceinline__ int v_st(int k, int c) { const int kk = (k & ~0xC) | ((k & 4) << 1) | ((k & 8) >> 1); return ((kk >> 3) * 4 + (c >> 5)) * 512 + ((kk & 7) * 32 + (c & 31)) * 2; }
__device__ __forceinline__ int v_rd_base(int lane) { return ((lane & 3) << 3) | (((lane >> 2) & 3) << 6) | (((lane >> 4) & 1) << 5) | (((lane >> 5) & 1) << 8); }
constexpr int v_rd_off(int d0, int ks, int half) { return d0 * 512 + ks * 4096 + half * 2048; }
__device__ __forceinline__ int crow(int r, int hi) { return (r & 3) + 8 * (r >> 2) + 4 * hi; }
__device__ __forceinline__ bf16x8 ld8(const bf16_t* p) { return *reinterpret_cast<const bf16x8*>(p); }
__device__ __forceinline__ void partialSM(f32x16& p0, f32x16& p1, float& m_reg, float& mn, float& alpha) {
    float pmax = p0[0];
#pragma unroll
    for (int r = 1; r < 16; ++r) pmax = fmaxf(pmax, p0[r]);
#pragma unroll
    for (int r = 0; r < 16; ++r) pmax = fmaxf(pmax, p1[r]);
    { auto rr = __builtin_amdgcn_permlane32_swap(__float_as_uint(pmax), __float_as_uint(pmax), false, false);
      pmax = fmaxf(__uint_as_float(rr[0]), __uint_as_float(rr[1])); }
    constexpr float C2 = 1.4426950408889634f * SCALE;
    if (__builtin_expect(__all((pmax - m_reg) * SCALE <= THR), 1)) { mn = m_reg; alpha = 1.f; }
    else { mn = fmaxf(m_reg, pmax); alpha = __builtin_amdgcn_exp2f((m_reg - mn) * C2); m_reg = mn; }
    const float mnL = -mn * C2;
#pragma unroll
    for (int r = 0; r < 16; ++r) p0[r] = fmaf(p0[r], C2, mnL);
#pragma unroll
    for (int r = 0; r < 16; ++r) p1[r] = fmaf(p1[r], C2, mnL);
#pragma unroll
    for (int r = 0; r < 16; ++r) p0[r] = __builtin_amdgcn_exp2f(p0[r]);
}
__device__ __forceinline__ void finishSM(f32x16& p0, f32x16& p1, float alpha, float& l_reg, bf16x8& pa0, bf16x8& pa1, bf16x8& pa2, bf16x8& pa3) {
#pragma unroll
    for (int r = 0; r < 16; ++r) p1[r] = __builtin_amdgcn_exp2f(p1[r]);
    float ps = 0;
#pragma unroll
    for (int r = 0; r < 16; ++r) ps += p0[r];
#pragma unroll
    for (int r = 0; r < 16; ++r) ps += p1[r];
    { auto rr = __builtin_amdgcn_permlane32_swap(__float_as_uint(ps), __float_as_uint(ps), false, false);
      ps = __uint_as_float(rr[0]) + __uint_as_float(rr[1]); }
    l_reg = l_reg * alpha + ps;
#define PK4(P, B_, OUT) do { unsigned a0 = cvt_pk_bf16(P[B_+0], P[B_+1]), a1 = cvt_pk_bf16(P[B_+2], P[B_+3]);                          \
        unsigned b0 = cvt_pk_bf16(P[B_+4], P[B_+5]), b1 = cvt_pk_bf16(P[B_+6], P[B_+7]);                                             \
        auto r0 = __builtin_amdgcn_permlane32_swap(a0, b0, false, false); auto r1 = __builtin_amdgcn_permlane32_swap(a1, b1, false, false); \
        u32x4 w = {r0[0], r1[0], r0[1], r1[1]}; OUT = *reinterpret_cast<bf16x8*>(&w); } while (0)
    PK4(p0, 0, pa0); PK4(p0, 8, pa1); PK4(p1, 0, pa2); PK4(p1, 8, pa3);
#undef PK4
}
template <int KB>
__device__ __forceinline__ void qkt(f32x16& p0, f32x16& p1, const char* K_lds, int r32, int hi, const bf16x8* qr) {
    p0 = f32x16{}; p1 = f32x16{};
    const char* kb[4];
#pragma unroll
    for (int dd = 0; dd < 4; ++dd) kb[dd] = K_lds + KB * SHM_K + KSWZ(r32, (dd * 16 + hi * 8) * 2);
#pragma unroll
    for (int d0 = 0; d0 < 8; ++d0) { const char* a = kb[d0 & 3] + (d0 >> 2) * 128;
        bf16x8 b0 = *reinterpret_cast<const bf16x8*>(a);
        bf16x8 b1 = *reinterpret_cast<const bf16x8*>(a + 32 * 256);
        p0 = __builtin_amdgcn_mfma_f32_32x32x16_bf16(b0, qr[d0], p0, 0, 0, 0);
        p1 = __builtin_amdgcn_mfma_f32_32x32x16_bf16(b1, qr[d0], p1, 0, 0, 0); }
}
template <int VB>
__device__ __forceinline__ void pv_tile(f32x16* o, int vb0, bf16x8 pa0, bf16x8 pa1, bf16x8 pa2, bf16x8 pa3) {
#define TRRD(dst, off) asm volatile("ds_read_b64_tr_b16 %0, %1 offset:%2" : "=&v"(dst) : "v"(vb0), "i"(off) : "memory")
#define PV_D0(d0) do { s16x4 l0, l1, l2, l3, h0, h1, h2, h3; constexpr int b_ = VB * SHM_V + v_rd_off(d0, 0, 0); \
        TRRD(l0, b_); TRRD(h0, b_ + 2048); TRRD(l1, b_ + 4096); TRRD(h1, b_ + 6144); TRRD(l2, b_ + 8192); TRRD(h2, b_ + 10240); TRRD(l3, b_ + 12288); TRRD(h3, b_ + 14336); \
        asm volatile("s_waitcnt lgkmcnt(0)" ::: "memory"); SBAR();   \
        o[d0] = __builtin_amdgcn_mfma_f32_32x32x16_bf16(pa0, (bf16x8){l0[0], l0[1], l0[2], l0[3], h0[0], h0[1], h0[2], h0[3]}, o[d0], 0, 0, 0);   \
        o[d0] = __builtin_amdgcn_mfma_f32_32x32x16_bf16(pa1, (bf16x8){l1[0], l1[1], l1[2], l1[3], h1[0], h1[1], h1[2], h1[3]}, o[d0], 0, 0, 0);   \
        o[d0] = __builtin_amdgcn_mfma_f32_32x32x16_bf16(pa2, (bf16x8){l2[0], l2[1], l2[2], l2[3], h2[0], h2[1], h2[2], h2[3]}, o[d0], 0, 0, 0);   \
        o[d0] = __builtin_amdgcn_mfma_f32_32x32x16_bf16(pa3, (bf16x8){l3[0], l3[1], l3[2], l3[3], h3[0], h3[1], h3[2], h3[3]}, o[d0], 0, 0, 0); } while (0)
    PV_D0(0); PV_D0(1); PV_D0(2); PV_D0(3);
#undef PV_D0
#undef TRRD
}
template <class TOut> struct BlockRef { const bf16_t* Q; const bf16_t* K; const bf16_t* V; TOut* O; const unsigned* MK; int P0; int orow, ocol; };
struct Seam { bf16x8 qr[8]; bf16x8 st_v0, st_v1, st_k0, st_k1; };
#define ROW(p, k0, rr) ((p) + (size_t)((k0) + (rr)) * LDP + sc)
#define VMW() asm volatile("s_waitcnt vmcnt(0)" ::: "memory")
#define VMWN(n) asm volatile("s_waitcnt vmcnt(%0)" :: "i"(n) : "memory")
#define SLOAD_H(Kp, Vp, k0) do { S.st_v0 = ld8(ROW(Vp, k0, sr)); S.st_v1 = ld8(ROW(Vp, k0, 32 + sr)); S.st_k0 = ld8(ROW(Kp, k0, sr)); S.st_k1 = ld8(ROW(Kp, k0, 32 + sr)); } while (0)
#define SWRITE_HK(bf) do { *(bf16x8*)(K_lds + (bf) * SHM_K + kws) = S.st_k0; *(bf16x8*)(K_lds + (bf) * SHM_K + kws + 32 * 256) = S.st_k1; } while (0)
#define SWRITE_HV(bf) do { *(bf16x8*)(V_lds + (bf) * SHM_V + vst0) = S.st_v0; *(bf16x8*)(V_lds + (bf) * SHM_V + vst1) = S.st_v1; } while (0)
#define SWRITE_H(bf) do { SWRITE_HV(bf); SWRITE_HK(bf); } while (0)
template <class TOut>
__device__ __forceinline__ void attn_prime(const BlockRef<TOut>& cur, char* lds, Seam& S) {
    const int tid_ = my_tid();
    const int tid = tid_, wid = __builtin_amdgcn_readfirstlane(tid >> 6), lane = tid & 63, r32 = lane & 31, hi = lane >> 5;
    const int sr = tid >> 4, sc = (tid & 15) * 8, kws = KSWZ(sr, sc * 2); char* K_lds = lds + 2 * SHM_V;
#pragma unroll
    for (int d0 = 0; d0 < 8; ++d0) S.qr[d0] = ld8(cur.Q + (size_t)(wid * QBLK + r32) * LDP + d0 * 16 + hi * 8);
    SLOAD_H(cur.K, cur.V, 0); VMW(); SWRITE_HK(0);
    __syncthreads();
}
template <class TOut, bool BM, int OS>
__device__ __forceinline__ void attn_block(const BlockRef<TOut>& cur, const BlockRef<TOut>& nxt, char* lds, Seam& S) {
    const int tid_ = my_tid();
    const int tid = tid_, wid = __builtin_amdgcn_readfirstlane(tid >> 6), lane = tid & 63, r32 = lane & 31, hi = lane >> 5;
    const int NT = (cur.P0 + QB - 1) / KVBLK + 1;
    const int qlo = cur.P0 + wid * QBLK;
    const int klim = (qlo & ~63) + 64;
    char* V_lds = lds; char* K_lds = lds + 2 * SHM_V;
    float* wsl = (float*)(lds + 2 * SHM_V + 2 * SHM_K) + wid * 64; float* li_l = wsl, * al_l = wsl + 32;
    float m_reg = -1e30f, l_reg = 0; f32x16 o[4] = {};
    const int sr = tid >> 4, sc = (tid & 15) * 8, vst0 = v_st(sr, sc), vst1 = v_st(32 + sr, sc), kws = KSWZ(sr, sc * 2);
    const int vb0 = (int)(uintptr_t)V_lds + v_rd_base(lane);
    const bf16_t* Kh = cur.K; const bf16_t* Vh = cur.V;
    const unsigned moff = (unsigned)(qlo + r32) * 4u;
    unsigned mw0 = 0, mw1 = 0;
#define RESC(a) do { if (__any((a) < 1.f)) { if (hi == 0) al_l[r32] = (a); asm volatile("s_waitcnt lgkmcnt(0)" ::: "memory");              \
                     _Pragma("unroll") for (int d_ = 0; d_ < 4; ++d_) _Pragma("unroll") for (int r = 0; r < 16; ++r) o[d_][r] *= al_l[crow(r, hi)]; } } while (0)
#define KBASE(t) ((t) * KVBLK)
#define MLOAD(t) do { if (BM) { const char* mb_ = (const char*)cur.MK + (size_t)(2 * (t)) * (T * 4); mw0 = *(const unsigned*)(mb_ + (size_t)moff); mw1 = *(const unsigned*)(mb_ + (size_t)(T * 4) + (size_t)moff); } } while (0)
#define MASKT(P0_, P1_, t) do { const float NEGI = -__builtin_inff(); \
        if (KBASE(t) >= klim) { _Pragma("unroll") for (int r = 0; r < 16; ++r) { P0_[r] = NEGI; P1_[r] = NEGI; } } \
        else if (BM) { const unsigned a_ = mw0 >> (4 * hi), b_ = mw1 >> (4 * hi); \
            _Pragma("unroll") for (int r = 0; r < 16; ++r) { const int cb = (r & 3) + 8 * (r >> 2); \
                const unsigned ma_ = (unsigned)__builtin_amdgcn_sbfe((int)a_, cb, 1), mb_ = (unsigned)__builtin_amdgcn_sbfe((int)b_, cb, 1);     \
                P0_[r] = __uint_as_float((__float_as_uint(P0_[r]) & ma_) | (0xFF800000u & ~ma_)); P1_[r] = __uint_as_float((__float_as_uint(P1_[r]) & mb_) | (0xFF800000u & ~mb_)); } } } while (0)
#define SEAM_K0() do { VMWN(8); SWRITE_HK(0); SBAR(); } while (0)
    f32x16 pA0, pA1, pB0, pB1; float mnA, mnB, alA, alB; bf16x8 pa0, pa1, pa2, pa3;
    SWRITE_HV(0); SBAR();
    MLOAD(0);
    if (NT > 1) { SLOAD_H(Kh, Vh, KBASE(1)); }
    SBAR(); qkt<0>(pA0, pA1, K_lds, r32, hi, S.qr);
    if (BM) VMW();
    MASKT(pA0, pA1, 0); partialSM(pA0, pA1, m_reg, mnA, alA);
    if (NT > 1) { VMW(); SWRITE_H(1); }
    __syncthreads();
#define HALF_STEP(PX0, PX1, mnX, alX, PY0, PY1, alY, t, KB, VB, SB) do {                                                      \
        MLOAD(t);                                                                                                             \
        SBAR(); qkt<KB>(PX0, PX1, K_lds, r32, hi, S.qr);                                                                      \
        finishSM(PY0, PY1, alY, l_reg, pa0, pa1, pa2, pa3); SBAR();                                                           \
        if ((t) + 1 < NT) { SLOAD_H(Kh, Vh, KBASE((t) + 1)); SBAR(); }                                                        \
        pv_tile<VB>(o, vb0, pa0, pa1, pa2, pa3);                                                                              \
        if (BM) { if ((t) + 1 < NT) VMWN(4); else VMW(); }                                                                    \
        MASKT(PX0, PX1, (t)); partialSM(PX0, PX1, m_reg, mnX, alX);                                                           \
        __syncthreads();                                                                                                      \
        if ((t) + 1 < NT) { VMW(); SWRITE_H(SB); }                                                                            \
        RESC(alX); __syncthreads(); } while (0)
    for (int t = 1; t + 1 < NT; t += 2) {
        HALF_STEP(pB0, pB1, mnB, alB, pA0, pA1, alA, t, 1, 0, 0);
        HALF_STEP(pA0, pA1, mnA, alA, pB0, pB1, alB, t + 1, 0, 1, 1);
    }
    const bool even = (NT & 1) == 0;
    if (even) { MLOAD(NT - 1); SBAR(); qkt<1>(pB0, pB1, K_lds, r32, hi, S.qr); SBAR(); }
    SLOAD_H(nxt.K, nxt.V, 0); SBAR();
#pragma unroll
    for (int d0 = 0; d0 < 8; ++d0) S.qr[d0] = ld8(nxt.Q + (size_t)(wid * QBLK + r32) * LDP + d0 * 16 + hi * 8);
    SBAR();
    finishSM(pA0, pA1, alA, l_reg, pa0, pa1, pa2, pa3); SBAR();
    pv_tile<0>(o, vb0, pa0, pa1, pa2, pa3);
    if (even) { if (BM) VMWN(12); MASKT(pB0, pB1, NT - 1); partialSM(pB0, pB1, m_reg, mnB, alB); __syncthreads(); RESC(alB);
        finishSM(pB0, pB1, alB, l_reg, pa0, pa1, pa2, pa3); SBAR(); pv_tile<1>(o, vb0, pa0, pa1, pa2, pa3); }
    SBAR(); SEAM_K0();
    if (hi == 0) li_l[r32] = l_reg; asm volatile("s_waitcnt lgkmcnt(0)" ::: "memory");
    float rli[16];
#pragma unroll
    for (int r = 0; r < 16; ++r) rli[r] = __builtin_amdgcn_rcpf(li_l[crow(r, hi)]);
    TOut* obase_ = cur.O; asm volatile("" : "+s"(obase_));
    TOut* Ow = obase_ + (size_t)(wid * QBLK) * OS;
#pragma unroll
    for (int r = 0; r < 16; ++r) { const int orow = crow(r, hi);
#pragma unroll
        for (int d0 = 0; d0 < 4; ++d0) { const float v = o[d0][r] * rli[r];
            if constexpr (sizeof(TOut) == 4) { Ow[(size_t)orow * OS + d0 * 32 + r32] = v; }
            else { const float vn = sx(v, 1, lane);
                   if ((r32 & 1) == 0) *(unsigned*)(obase_ + tiled_off((size_t)(cur.orow + wid * QBLK + orow), cur.ocol + d0 * 32 + r32, OS)) = cvt_pk_bf16(v, vn); } } }
    __syncthreads();
#undef RESC
#undef KBASE
#undef MLOAD
#undef MASKT
#undef SEAM_K0
#undef HALF_STEP
}
#undef ROW
#undef VMW
#undef VMWN
#undef SLOAD_H
#undef SWRITE_HK
#undef SWRITE_HV
#undef SWRITE_H
}

#define XB_TMO      128
#define XB_XCNT(j)  (256  + 64 * (j))
#define XB_XSUB(j)  (1280 + 64 * (j))
#define XB_XGEN(j)  (2304 + 64 * (j))
#define XB_TOP      3328
#define XB_TOPGEN   3392
#define XCD_BAR_WORDS 3456
#define XB_SPIN_CAP (1u << 22)
__device__ __forceinline__ unsigned xb_ld(unsigned* p)              { return __hip_atomic_load(p, __ATOMIC_RELAXED, __HIP_MEMORY_SCOPE_AGENT); }
__device__ __forceinline__ unsigned xb_add(unsigned* p, unsigned v) { return __hip_atomic_fetch_add(p, v, __ATOMIC_RELAXED, __HIP_MEMORY_SCOPE_AGENT); }
__device__ __forceinline__ unsigned xb_xcc_id() { return (unsigned)__builtin_amdgcn_s_getreg((3 << 11) | 20) & 0xFu; }
#define XB_SPIN(cond, bar) do { unsigned _sp = 0; while (cond) { __builtin_amdgcn_s_sleep(1); \
    if ((++_sp & 255u) == 0u) { if (xb_ld(&(bar)[XB_TMO])) break; if (_sp > XB_SPIN_CAP) { atomicAdd(&(bar)[XB_TMO], 1u); break; } } } } while (0)
struct XcdBarrier { unsigned* bar; unsigned x; volatile LAS unsigned* st; };
__device__ __forceinline__ XcdBarrier xcd_barrier_post(unsigned* bar, volatile LAS unsigned* st) {
    XcdBarrier b; b.bar = bar; b.x = xb_xcc_id(); b.st = st;
    if (my_tid() == 0) (void)xb_add(&bar[XB_XCNT(b.x)], 1u);
    return b;
}
__device__ __forceinline__ void xcd_barrier_complete(unsigned* bar, unsigned x, unsigned& nloc, unsigned& nx) {
    const unsigned G = gridDim.x * gridDim.y * gridDim.z;
    unsigned sum, cnt, mine, sp = 0u;
    for (;;) {
        sum = 0u; cnt = 0u; mine = 0u;
#pragma unroll
        for (unsigned j = 0; j < 16; ++j) { const unsigned c = xb_ld(&bar[XB_XCNT(j)]); sum += c; cnt += (c > 0u) ? 1u : 0u; mine = (j == x) ? c : mine; }
        if (sum == G) break;
        __builtin_amdgcn_s_sleep(1);
        if ((++sp & 255u) == 0u) { if (xb_ld(&bar[XB_TMO])) break; if (sp > XB_SPIN_CAP) { atomicAdd(&bar[XB_TMO], 1u); break; } }
    }
    nloc = mine > 0u ? mine : 1u; nx = cnt > 0u ? cnt : 1u;
}
__device__ __forceinline__ void xcd_barrier(const XcdBarrier& b) {
    asm volatile("s_waitcnt vmcnt(0)" ::: "memory");
    __syncthreads();
    if (my_tid() == 0) {
        unsigned* bar = b.bar;
        __builtin_amdgcn_s_waitcnt(0);
        unsigned nloc = b.st[0], nx = b.st[1];
        if (nloc == 0u) { xcd_barrier_complete(bar, b.x, nloc, nx); b.st[0] = nloc; b.st[1] = nx; }
        const unsigned old = xb_add(&bar[XB_XSUB(b.x)], 1u);
        const unsigned gen = old / nloc;
        if (old + 1u == (gen + 1u) * nloc) {
            __builtin_amdgcn_fence(__ATOMIC_RELEASE, "agent");
            asm volatile("s_waitcnt vmcnt(0)" ::: "memory");
            const unsigned og = xb_add(&bar[XB_TOP], 1u);
            const unsigned tg = og / nx;
            if (og + 1u == (tg + 1u) * nx) xb_add(&bar[XB_TOPGEN], 1u);
            else XB_SPIN(xb_ld(&bar[XB_TOPGEN]) == tg, bar);
            __builtin_amdgcn_fence(__ATOMIC_ACQUIRE, "agent");
            xb_add(&bar[XB_XGEN(b.x)], 1u);
            asm volatile("s_waitcnt vmcnt(0)" ::: "memory");
        } else {
            XB_SPIN(xb_ld(&bar[XB_XGEN(b.x)]) == gen, bar);
            __builtin_amdgcn_fence(__ATOMIC_ACQUIRE, "agent");
            asm volatile("s_waitcnt vmcnt(0)" ::: "memory");
        }
    }
    __syncthreads();
}

struct Args {
    const float* in[17]; float* out; unsigned char* ws; int ph_lo, ph_hi;
};
typedef const __attribute__((address_space(4))) Args KA;
#define PH_ARGS() ({ KA* p_ = (KA*)__builtin_amdgcn_kernarg_segment_ptr(); asm volatile("" : "+s"(p_)); p_; })
struct Frame {
    LAS unsigned char* lds; int tid, lane, wave, G, vcu;
};
__device__ __forceinline__ Frame make_frame(LAS unsigned char* lds) {
    Frame F; F.lds = lds; const int t = my_tid();
    F.tid = t; F.lane = t & 63; F.wave = __builtin_amdgcn_readfirstlane(t >> 6);
    F.G = gridDim.x; { const int bx = blockIdx.x; F.vcu = (F.G % 8 == 0) ? (bx % 8) * (F.G / 8) + bx / 8 : bx; }
    return F;
}
__device__ __forceinline__ float wave_sum(float v, int lane) {
    v = sum16(v); v += sx(v, 16, lane); v += sx(v, 32, lane);
    return v;
}
#define LDS_WAIT() asm volatile("s_waitcnt lgkmcnt(0)" ::: "memory")

__device__ __forceinline__ void p0_transpose_item(const float* W, int K, int N, bf16_t* WT, const float* gain, bool remap, LAS float* scr, int item, int lane) {
    const int nblk = N / 32, kb = item / nblk, nb = item % nblk, k0 = 128 * kb, n0 = 32 * nb;
    const int r = lane >> 3, c = lane & 7;
    f32x4 v[16];
#pragma unroll
    for (int i = 0; i < 16; ++i) v[i] = *(const f32x4*)(W + (size_t)(k0 + 8 * i + r) * N + n0 + 4 * c);
    if (gain) {
#pragma unroll
        for (int i = 0; i < 16; ++i) v[i] = v[i] * gain[k0 + 8 * i + r]; }
#pragma unroll
    for (int i = 0; i < 16; ++i) { const int k = 8 * i + r;
        scr[(4 * c + 0) * 132 + k] = v[i].x; scr[(4 * c + 1) * 132 + k] = v[i].y; scr[(4 * c + 2) * 132 + k] = v[i].z; scr[(4 * c + 3) * 132 + k] = v[i].w; }
    LDS_WAIT(); asm volatile("" ::: "memory");
    const int nl = lane >> 4, ck = lane & 15;
#pragma unroll
    for (int j = 0; j < 8; ++j) { const int n = 4 * j + nl; const f32x4 a = *(const LAS f32x4*)(scr + n * 132 + 8 * ck), b = *(const LAS f32x4*)(scr + n * 132 + 8 * ck + 4);
        u32x4 o; o.x = cvt_pk_bf16(a.x, a.y); o.y = cvt_pk_bf16(a.z, a.w); o.z = cvt_pk_bf16(b.x, b.y); o.w = cvt_pk_bf16(b.z, b.w);
        int nd = n0 + n;
        if (remap) { if (nd >= 7168) nd = (nd < 7184) ? nd + 7248 : nd - 16; }
        *(u32x4*)(WT + tiled_off((size_t)nd, k0 + 8 * ck, K)) = o; }
    LDS_WAIT(); asm volatile("" ::: "memory");
}
__device__ __forceinline__ void rownorm_row(const float* xrow, bf16_t* xb, float* SSQP, int m, int lane) {
    const f32x4* xr = (const f32x4*)xrow + lane;
    f32x4 v[16]; float s = 0.f;
#pragma unroll
    for (int j = 0; j < 16; ++j) { v[j] = xr[64 * j]; s += (v[j].x * v[j].x + v[j].y * v[j].y) + (v[j].z * v[j].z + v[j].w * v[j].w); }
    const float st = wave_sum(s, lane);
    SSQP[(size_t)lane * M + m] = lane == 0 ? st : 0.f;
#pragma unroll
    for (int j = 0; j < 16; ++j) { u32x2 o; o.x = cvt_pk_bf16(v[j].x, v[j].y); o.y = cvt_pk_bf16(v[j].z, v[j].w); *(u32x2*)(xb + tiled_off((size_t)m, 256 * j + 4 * lane, DM)) = o; }
}
__device__ __forceinline__ void rownorm_phase(const Frame& F, const float* x, bf16_t* xb, float* SSQP) {
    const int gw = F.vcu * 8 + F.wave, NGW = F.G * 8;
    for (int m = gw; m < M; m += NGW) rownorm_row(x + (size_t)m * DM, xb, SSQP, m, F.lane);
}
__device__ __forceinline__ void rs_reduce_phase(const Frame& F, const float* SSQP, float* RS) {
    const int gt = (F.vcu * 8 + F.wave) * 64 + F.lane, NGT = F.G * 512;
    for (int m = gt; m < M; m += NGT) { float s = 0.f;
#pragma unroll 8
        for (int j = 0; j < 64; ++j) s += SSQP[(size_t)j * M + m];
        RS[m] = 1.f / sqrtf(s * (1.f / DM) + EPS); }
}

constexpr int CONV_I_IN = (DM / 128) * (NIN / 32), CONV_I_O = (DM / 128) * (DM / 32), CONV_I_1 = (DM / 128) * (FF / 32), CONV_I_2 = (FF / 128) * (DM / 32);
constexpr int CONV_PER_L = CONV_I_IN + CONV_I_O + CONV_I_1 + CONV_I_2;
__device__ __forceinline__ void conv_item(KA* ap, int l, int r, LAS float* scr, int lane) {
    unsigned char* ws = ap->ws;
    if (r < CONV_I_IN) { p0_transpose_item(ap->in[2] + (size_t)l * DM * NIN, DM, NIN, (bf16_t*)(ws + WS_WIN + l * SZ_WIN), ap->in[1] + l * DM, true, scr, r, lane); return; } r -= CONV_I_IN;
    if (r < CONV_I_O) { p0_transpose_item(ap->in[13] + (size_t)l * DM * DM, DM, DM, (bf16_t*)(ws + WS_WOUT + l * SZ_WOUT), nullptr, false, scr, r, lane); return; } r -= CONV_I_O;
    if (r < CONV_I_1) { p0_transpose_item(ap->in[15] + (size_t)l * DM * FF, DM, FF, (bf16_t*)(ws + WS_W1 + l * SZ_W1), ap->in[14] + l * DM, false, scr, r, lane); return; } r -= CONV_I_1;
    p0_transpose_item(ap->in[16] + (size_t)l * FF * DM, FF, DM, (bf16_t*)(ws + WS_W2 + l * SZ_W2), nullptr, false, scr, r, lane);
}
__device__ __forceinline__ void bg_convert(const Frame& F, KA* ap, unsigned* arrive, bool drain) {
    unsigned* ctl = (unsigned*)(ap->ws + WS_CTL); unsigned* head = ctl + CW_BGQ;
    volatile LAS unsigned* slot = (volatile LAS unsigned*)(F.lds + LDS_MISC) + 24;
    LAS float* scr = (LAS float*)(F.lds + F.wave * 16896);
    if (!drain && F.tid == 0) (void)__hip_atomic_fetch_add(arrive, 1u, __ATOMIC_RELAXED, __HIP_MEMORY_SCOPE_AGENT);
    for (;;) {
        __syncthreads();
        if (F.tid == 0) { unsigned done = 0u; if (!drain) done = (__hip_atomic_load(arrive, __ATOMIC_RELAXED, __HIP_MEMORY_SCOPE_AGENT) >= (unsigned)F.G) ? 1u : 0u;
            unsigned ch = 0xFFFFFFFFu; if (!done) ch = __hip_atomic_fetch_add(head, 1u, __ATOMIC_RELAXED, __HIP_MEMORY_SCOPE_AGENT);
            slot[0] = ch; }
        __syncthreads();
        const unsigned ch = (unsigned)__builtin_amdgcn_readfirstlane((int)slot[0]);
        if (ch == 0xFFFFFFFFu || ch * 8u >= (unsigned)CONV_PER_L) break;
        const int it = (int)ch * 8 + F.wave;
        if (it < CONV_PER_L) conv_item(ap, 1, it, scr, F.lane);
    }
    __syncthreads();
}
constexpr int NCVW = 32;
__device__ __forceinline__ void conv_side(const Frame& F, KA* ap) {
    LAS float* scr = (LAS float*)(F.lds + F.wave * 16896);
    const int ncv = F.G < NCVW ? F.G : NCVW;
    for (int it = CONV_I_IN + (int)blockIdx.x * 8 + F.wave; it < CONV_PER_L; it += ncv * 8) conv_item(ap, 0, it, scr, F.lane);
    __syncthreads();
}
__device__ __forceinline__ void p0_prologue(const Frame& F, KA* ap) {
    unsigned char* ws = ap->ws;
    LAS float* scr = (LAS float*)(F.lds + F.wave * 16896);
    const int gw = F.vcu * 8 + F.wave, NGW = F.G * 8;
    for (int it = gw; it < CONV_I_IN; it += NGW) conv_item(ap, 0, it, scr, F.lane);
    { const int gt = (F.vcu * 8 + F.wave) * 64 + F.lane, NGT = F.G * 512; constexpr int PADV = (NINP - NIN) * DM / 8;
      for (int i = gt; i < DEPTH * PADV; i += NGT) { const int l = i / PADV, r = i % PADV; const int n = NIN + r / (DM / 8), k = (r % (DM / 8)) * 8;
          *(u32x4*)((bf16_t*)(ws + WS_WIN + l * SZ_WIN) + tiled_off((size_t)n, k, DM)) = zero4(); } }
    { const int gt = (F.vcu * 8 + F.wave) * 64 + F.lane; float* lb = (float*)(ws + WS_LB);
      if (gt < 1024) { const float g0 = ap->in[3][gt], g1 = ap->in[3][1024 + gt]; lb[gt] = 0.f; lb[1024 + gt] = 1.f / (1.f + expf(g0 - g1)); } }
    rownorm_phase(F, ap->in[0], (bf16_t*)(ws + WS_XB), (float*)(ws + WS_SSQP));
}


__device__ __forceinline__ int q_next(unsigned* ctr, volatile LAS unsigned* slot) {
    __syncthreads();
    if (my_tid() == 0) *slot = atomicAdd(ctr, 1u);
    __syncthreads();
    return __builtin_amdgcn_readfirstlane((int)*slot);
}

template <bool DRY>
__device__ __forceinline__ void norm128_inplace(bf16_t* p, const float (&g)[16], int lane) {
    u32x4 a = *(const u32x4*)(p + lane * 16), b = *(const u32x4*)(p + lane * 16 + 8);
    float v[16];
    v[0] = bf_lo(a.x); v[1] = bf_hi(a.x); v[2] = bf_lo(a.y); v[3] = bf_hi(a.y); v[4] = bf_lo(a.z); v[5] = bf_hi(a.z); v[6] = bf_lo(a.w); v[7] = bf_hi(a.w);
    v[8] = bf_lo(b.x); v[9] = bf_hi(b.x); v[10] = bf_lo(b.y); v[11] = bf_hi(b.y); v[12] = bf_lo(b.z); v[13] = bf_hi(b.z); v[14] = bf_lo(b.w); v[15] = bf_hi(b.w);
    float ss = 0.f;
#pragma unroll
    for (int i = 0; i < 16; ++i) ss += v[i] * v[i];
    ss = sum8(ss);
    const float rs = 1.f / sqrtf(ss * (1.f / 128.f) + EPS);
#pragma unroll
    for (int i = 0; i < 16; ++i) v[i] = v[i] * rs * g[i];
    a.x = cvt_pk_bf16(v[0], v[1]); a.y = cvt_pk_bf16(v[2], v[3]); a.z = cvt_pk_bf16(v[4], v[5]); a.w = cvt_pk_bf16(v[6], v[7]);
    b.x = cvt_pk_bf16(v[8], v[9]); b.y = cvt_pk_bf16(v[10], v[11]); b.z = cvt_pk_bf16(v[12], v[13]); b.w = cvt_pk_bf16(v[14], v[15]);
    if (!DRY || rs == 1234.5f) { *(u32x4*)(p + lane * 16) = a; *(u32x4*)(p + lane * 16 + 8) = b; }
}
template <bool DRY>
__device__ __forceinline__ void fixup_phase(const Frame& F, KA* ap, int l) {
    unsigned char* ws = ap->ws;
    bf16_t* PROJ = (bf16_t*)(ws + WS_PROJ); float* ODDW = (float*)(ws + WS_ODD); const float* ODDP = (const float*)(ws + WS_Y); const float* RS = (const float*)(ws + WS_RS); const float* gbias = ap->in[6] + l * 16;
    bf16_t* BQK = (bf16_t*)(ws + WS_BQK); bf16_t* KI = (bf16_t*)(ws + WS_KI);
    const float* kin = ap->in[12] + l * 64; const float* cw = ap->in[5] + l * 4096;
    const int gw = F.vcu * 8 + F.wave, NGW = F.G * 8, lane = F.lane;
    float wcv[4][16];
#pragma unroll
    for (int j = 0; j < 4; ++j)
#pragma unroll
        for (int i = 0; i < 16; ++i) wcv[j][i] = cw[j * 1024 + lane * 16 + i];
    for (int m = gw; m < M; m += NGW) {
        {
          const float* op = ODDP + (size_t)m * 128; const float rs = RS[m];
          const float x = rs * ((op[lane] + op[(size_t)M * 128 + lane]) + (op[(size_t)2 * M * 128 + lane] + op[(size_t)3 * M * 128 + lane]));
          if (lane < 32) { const int c2 = 64 + lane; float v = rs * ((op[c2] + op[(size_t)M * 128 + c2]) + (op[(size_t)2 * M * 128 + c2] + op[(size_t)3 * M * 128 + c2]));
              if (c2 < 80) v *= 2.0f;   else { v += gbias[c2 - 80]; if (c2 >= 88) v = fminf(v, 0.f) - __logf(1.f + __expf(-fabsf(v))); }
              if (!DRY || v == 1234.5f) ODDW[(size_t)m * LDO + c2] = v; }
          const float ss = wave_sum(x * x, lane); const float y = x * (1.f / sqrtf(ss * (1.f / 64.f) + EPS)) * kin[lane];
          if (!DRY || y == 1234.5f) KI[(((size_t)(m >> 5) * 4 + (lane >> 4)) * 64 + ((lane >> 3) & 1) * 32 + (m & 31)) * 8 + (lane & 7)] = (bf16_t)(cvt_pk_bf16(y, y) & 0xffffu); }
        { const int tt = m & (T - 1); float acc[16];
#pragma unroll
          for (int i = 0; i < 16; ++i) acc[i] = 0.f;
#pragma unroll
          for (int j = 0; j < 4; ++j) { if (tt - 3 + j >= 0) { const bf16_t* rp = PROJ + (size_t)(m - 3 + j) * LDP + C_BQK + lane * 16;
                const u32x4 x0 = *(const u32x4*)rp, x1 = *(const u32x4*)(rp + 8); const float (&wj)[16] = wcv[j];
                acc[0] += bf_lo(x0.x) * wj[0]; acc[1] += bf_hi(x0.x) * wj[1]; acc[2] += bf_lo(x0.y) * wj[2]; acc[3] += bf_hi(x0.y) * wj[3];
                acc[4] += bf_lo(x0.z) * wj[4]; acc[5] += bf_hi(x0.z) * wj[5]; acc[6] += bf_lo(x0.w) * wj[6]; acc[7] += bf_hi(x0.w) * wj[7];
                acc[8] += bf_lo(x1.x) * wj[8]; acc[9] += bf_hi(x1.x) * wj[9]; acc[10] += bf_lo(x1.y) * wj[10]; acc[11] += bf_hi(x1.y) * wj[11];
                acc[12] += bf_lo(x1.z) * wj[12]; acc[13] += bf_hi(x1.z) * wj[13]; acc[14] += bf_lo(x1.w) * wj[14]; acc[15] += bf_hi(x1.w) * wj[15]; } }
          const float sc = (lane >= 32) ? 0.125f : 1.f;
#pragma unroll
          for (int i = 0; i < 16; ++i) acc[i] = fast_silu(acc[i]) * sc;
          u32x4 o0, o1; o0.x = cvt_pk_bf16(acc[0], acc[1]); o0.y = cvt_pk_bf16(acc[2], acc[3]); o0.z = cvt_pk_bf16(acc[4], acc[5]); o0.w = cvt_pk_bf16(acc[6], acc[7]);
          o1.x = cvt_pk_bf16(acc[8], acc[9]); o1.y = cvt_pk_bf16(acc[10], acc[11]); o1.z = cvt_pk_bf16(acc[12], acc[13]); o1.w = cvt_pk_bf16(acc[14], acc[15]);
          if (!DRY || acc[0] == 1234.5f) { *(u32x4*)(BQK + (size_t)m * 1024 + lane * 16) = o0; *(u32x4*)(BQK + (size_t)m * 1024 + lane * 16 + 8) = o1; } }
    }
}
__device__ __forceinline__ void ccombine_phase(const Frame& F, KA* ap, int l) {
    unsigned char* ws = ap->ws; const float* CATT = (const float*)(ws + WS_CATT); bf16_t* Y = (bf16_t*)(ws + WS_Y);
    const float* lam = ap->in[9] + l * 512; const float* sub = ap->in[10] + l * 256; const int lane = F.lane;
    const float linit = (l == 0) ? 0.2f : 0.35550906759f;
    const float s1 = wave_sum(lam[lane] * lam[128 + lane] + lam[64 + lane] * lam[192 + lane], lane);
    const float s2 = wave_sum(lam[256 + lane] * lam[384 + lane] + lam[320 + lane] * lam[448 + lane], lane);
    const float lamf = expf(s1) - expf(s2) + linit;
    const int gw = F.vcu * 8 + F.wave, NGW = F.G * 8;
    float g[16];
#pragma unroll
    for (int i = 0; i < 16; ++i) g[i] = sub[(lane & 15) * 16 + i] * (1.f - linit);
    for (int m = gw; m < M; m += NGW) {
        const float* r1 = CATT + (size_t)m * 2048 + lane * 16; const float* r2 = r1 + 1024;
        float v[16]; float ss = 0.f;
#pragma unroll
        for (int q = 0; q < 4; ++q) { const f32x4 x = *(const f32x4*)(r1 + 4 * q), y = *(const f32x4*)(r2 + 4 * q);
#pragma unroll
            for (int j = 0; j < 4; ++j) { const float d = x[j] - lamf * y[j]; v[4 * q + j] = d; ss += d * d; } }
        ss = sum16(ss);
        const float rs = 1.f / sqrtf(ss * (1.f / 256.f) + EPS);
        u32x4 o0, o1;
        o0.x = cvt_pk_bf16(v[0] * rs * g[0], v[1] * rs * g[1]); o0.y = cvt_pk_bf16(v[2] * rs * g[2], v[3] * rs * g[3]); o0.z = cvt_pk_bf16(v[4] * rs * g[4], v[5] * rs * g[5]); o0.w = cvt_pk_bf16(v[6] * rs * g[6], v[7] * rs * g[7]);
        o1.x = cvt_pk_bf16(v[8] * rs * g[8], v[9] * rs * g[9]); o1.y = cvt_pk_bf16(v[10] * rs * g[10], v[11] * rs * g[11]); o1.z = cvt_pk_bf16(v[12] * rs * g[12], v[13] * rs * g[13]); o1.w = cvt_pk_bf16(v[14] * rs * g[14], v[15] * rs * g[15]);
        bf16_t* yo = Y + tiled_off((size_t)m, 2048 + lane * 16, DM);
        *(u32x4*)yo = o0; *(u32x4*)(yo + 8) = o1;
    }
}

template <int KS>
__device__ __forceinline__ void mma_nt(f32x16& acc, const LAS unsigned char* A, int sa, const LAS unsigned char* B, int sb, int lane) {
    const LAS unsigned char* ap = A + (lane & 31) * sa + (lane >> 5) * 16;
    const LAS unsigned char* bp = B + (lane & 31) * sb + (lane >> 5) * 16;
#pragma unroll
    for (int ks = 0; ks < KS; ++ks) { const bf16x8 x = *(const LAS bf16x8*)(ap + ks * 32), y = *(const LAS bf16x8*)(bp + ks * 32);
        acc = __builtin_amdgcn_mfma_f32_32x32x16_bf16(x, y, acc, 0, 0, 0); }
}
__device__ __forceinline__ unsigned short bf1(float v) { return (unsigned short)(cvt_pk_bf16(v, v) & 0xffffu); }

__device__ __forceinline__ void hgrn_scan(const Frame& F, KA* ap, int l, int bh) {
    const int tid_ = my_tid();
    const int tid = tid_, lane = tid & 63, w = __builtin_amdgcn_readfirstlane(tid >> 6), hi = lane >> 5, c32 = lane & 31;
    unsigned char* ws = ap->ws; LAS unsigned char* lds = F.lds;
    const int b = bh >> 3, h = bh & 7; const size_t m0 = (size_t)b * T;
    const bf16_t* PROJ = (const bf16_t*)(ws + WS_PROJ); const float* GL = (const float*)(ws + WS_GLOG) + h * 128;
    bf16_t* Y = (bf16_t*)(ws + WS_Y); const float* gn = ap->in[4] + l * 128;
    constexpr int QT = 0, KT = 17408, QH = 34816, KHT = 52224, VT = 70656, ST = 89088, PP = 123904, TOT = 133120, DEC = 137216, OO = 0;
    constexpr int SQ = 272, SK = 144;
    { const u32x4 z4 = zero4(); for (int i = tid; i < 34816 / 16; i += 512) *(LAS u32x4*)(lds + ST + i * 16) = z4; }
    f32x16 sacc[2] = {};
    f32x2 gv[8]; unsigned qv[8], vv[8];
    const int k0 = 2 * lane;
#define HG_LOAD(c) do { _Pragma("unroll") for (int i = 0; i < 8; ++i) { const size_t row = m0 + (size_t)(c) * 64 + 8 * w + i; \
        gv[i] = *(const f32x2*)(GL + row * 1024 + k0); qv[i] = *(const unsigned*)(PROJ + row * LDP + C_AQ + h * 128 + k0); vv[i] = *(const unsigned*)(PROJ + row * LDP + C_AI + h * 128 + k0); } } while (0)
    float ggv[16];
#pragma unroll
    for (int i = 0; i < 16; ++i) ggv[i] = gn[(tid & 7) * 16 + i];
    HG_LOAD(0);
    for (int c = 0; c < T / 64; ++c) {
        const bf16_t* gp_ = PROJ + (m0 + (size_t)c * 64 + (tid >> 3)) * LDP + C_AG + h * 128 + (tid & 7) * 16; const u32x4 g0 = *(const u32x4*)gp_, g1 = *(const u32x4*)(gp_ + 8);
        f32x2 cs[8]; { f32x2 run = {0.f, 0.f};
#pragma unroll
            for (int i = 0; i < 8; ++i) { run += gv[i]; cs[i] = run; }
            *(LAS f32x2*)(lds + TOT + (w * 128 + k0) * 4) = run; }
        __syncthreads();
        { f32x2 off = {0.f, 0.f}, b31 = {0.f, 0.f}, b63 = {0.f, 0.f};
#pragma unroll
          for (int j = 0; j < 8; ++j) { const f32x2 tj = *(const LAS f32x2*)(lds + TOT + (j * 128 + k0) * 4); if (j < w) off += tj; if (j < 4) b31 += tj; b63 += tj; }
          float kh0[8], kh1[8];
#pragma unroll
          for (int i = 0; i < 8; ++i) { const int t = 8 * w + i; const f32x2 bt = off + cs[i];
              const float q0 = bf_lo(qv[i]), q1 = bf_hi(qv[i]);
              const float ki0 = 1.f - __expf(gv[i].x), ki1 = 1.f - __expf(gv[i].y);
              *(LAS unsigned*)(lds + QT + t * SQ + k0 * 2) = cvt_pk_bf16(q0 * __expf(fminf(bt.x - b31.x, 80.f)), q1 * __expf(fminf(bt.y - b31.y, 80.f)));
              *(LAS unsigned*)(lds + KT + t * SQ + k0 * 2) = cvt_pk_bf16(ki0 * __expf(fminf(b31.x - bt.x, 80.f)), ki1 * __expf(fminf(b31.y - bt.y, 80.f)));
              *(LAS unsigned*)(lds + QH + t * SQ + k0 * 2) = cvt_pk_bf16(q0 * __expf(bt.x), q1 * __expf(bt.y));
              kh0[i] = ki0 * __expf(b63.x - bt.x); kh1[i] = ki1 * __expf(b63.y - bt.y); }
          u32x4 o; o.x = cvt_pk_bf16(kh0[0], kh0[1]); o.y = cvt_pk_bf16(kh0[2], kh0[3]); o.z = cvt_pk_bf16(kh0[4], kh0[5]); o.w = cvt_pk_bf16(kh0[6], kh0[7]);
          *(LAS u32x4*)(lds + KHT + k0 * SK + w * 16) = o;
          o.x = cvt_pk_bf16(kh1[0], kh1[1]); o.y = cvt_pk_bf16(kh1[2], kh1[3]); o.z = cvt_pk_bf16(kh1[4], kh1[5]); o.w = cvt_pk_bf16(kh1[6], kh1[7]);
          *(LAS u32x4*)(lds + KHT + (k0 + 1) * SK + w * 16) = o;
          o.x = (vv[0] & 0xffffu) | (vv[1] << 16); o.y = (vv[2] & 0xffffu) | (vv[3] << 16); o.z = (vv[4] & 0xffffu) | (vv[5] << 16); o.w = (vv[6] & 0xffffu) | (vv[7] << 16);
          *(LAS u32x4*)(lds + VT + k0 * SK + w * 16) = o;
          o.x = (vv[0] >> 16) | (vv[1] & 0xffff0000u); o.y = (vv[2] >> 16) | (vv[3] & 0xffff0000u); o.z = (vv[4] >> 16) | (vv[5] & 0xffff0000u); o.w = (vv[6] >> 16) | (vv[7] & 0xffff0000u);
          *(LAS u32x4*)(lds + VT + (k0 + 1) * SK + w * 16) = o;
          if (w == 7) { f32x2 d; d.x = __expf(b63.x); d.y = __expf(b63.y); *(LAS f32x2*)(lds + DEC + k0 * 4) = d; } }
        if (c + 1 < T / 64) HG_LOAD(c + 1);
        __syncthreads();
        f32x16 pacc = {}, oacc = {};
        const int ti = w >> 1, sj = w & 1;
        if (w < 4 && !(ti == 0 && sj == 1)) mma_nt<8>(pacc, lds + QT + ti * 32 * SQ, SQ, lds + KT + sj * 32 * SQ, SQ, lane);
        mma_nt<8>(oacc, lds + QH + (w & 1) * 32 * SQ, SQ, lds + ST + (w >> 1) * 32 * SQ, SQ, lane);
#pragma unroll
        for (int j = 0; j < 2; ++j) { const int kj = 2 * (w & 1) + j; const float dec = *(const LAS float*)(lds + DEC + (32 * kj + c32) * 4);
#pragma unroll
            for (int r = 0; r < 16; ++r) sacc[j][r] *= dec;
            mma_nt<4>(sacc[j], lds + VT + (w >> 1) * 32 * SK, SK, lds + KHT + kj * 32 * SK, SK, lane); }
        __syncthreads();
        if (w < 4) {
#pragma unroll
            for (int r = 0; r < 16; ++r) { const int t = 32 * ti + att::crow(r, hi), s_ = 32 * sj + c32; const float v = (s_ <= t) ? pacc[r] : 0.f;
                *(LAS unsigned short*)(lds + PP + t * SK + s_ * 2) = bf1(v); } }
#pragma unroll
        for (int j = 0; j < 2; ++j) { const int kj = 2 * (w & 1) + j;
#pragma unroll
            for (int r = 0; r < 16; ++r) { const int v_ = 32 * (w >> 1) + att::crow(r, hi), k_ = 32 * kj + c32;
                *(LAS unsigned short*)(lds + ST + v_ * SQ + k_ * 2) = bf1(sacc[j][r]); } }
        __syncthreads();
        mma_nt<4>(oacc, lds + PP + (w & 1) * 32 * SK, SK, lds + VT + (w >> 1) * 32 * SK, SK, lane);
#pragma unroll
        for (int r = 0; r < 16; ++r) { const int t = 32 * (w & 1) + att::crow(r, hi), v_ = 32 * (w >> 1) + c32; *(LAS float*)(lds + OO + (t * 132 + v_) * 4) = oacc[r]; }
        __syncthreads();
        { const int t = tid >> 3, sg = tid & 7; const size_t row = m0 + (size_t)c * 64 + t;
          float v[16]; float ss = 0.f;
#pragma unroll
          for (int q = 0; q < 4; ++q) { const f32x4 x = *(const LAS f32x4*)(lds + OO + (t * 132 + sg * 16 + 4 * q) * 4);
#pragma unroll
              for (int j = 0; j < 4; ++j) { v[4 * q + j] = x[j]; ss += x[j] * x[j]; } }
          ss = sum8(ss);
          const float rs = 1.f / sqrtf(ss * (1.f / 128.f) + EPS);
          const float (&gg)[16] = ggv;
          u32x4 o0, o1;
          o0.x = cvt_pk_bf16(v[0] * rs * gg[0] * bf_lo(g0.x), v[1] * rs * gg[1] * bf_hi(g0.x)); o0.y = cvt_pk_bf16(v[2] * rs * gg[2] * bf_lo(g0.y), v[3] * rs * gg[3] * bf_hi(g0.y));
          o0.z = cvt_pk_bf16(v[4] * rs * gg[4] * bf_lo(g0.z), v[5] * rs * gg[5] * bf_hi(g0.z)); o0.w = cvt_pk_bf16(v[6] * rs * gg[6] * bf_lo(g0.w), v[7] * rs * gg[7] * bf_hi(g0.w));
          o1.x = cvt_pk_bf16(v[8] * rs * gg[8] * bf_lo(g1.x), v[9] * rs * gg[9] * bf_hi(g1.x)); o1.y = cvt_pk_bf16(v[10] * rs * gg[10] * bf_lo(g1.y), v[11] * rs * gg[11] * bf_hi(g1.y));
          o1.z = cvt_pk_bf16(v[12] * rs * gg[12] * bf_lo(g1.z), v[13] * rs * gg[13] * bf_hi(g1.z)); o1.w = cvt_pk_bf16(v[14] * rs * gg[14] * bf_lo(g1.w), v[15] * rs * gg[15] * bf_hi(g1.w));
          bf16_t* yo = Y + tiled_off(row, h * 128 + sg * 16, DM); *(u32x4*)yo = o0; *(u32x4*)(yo + 8) = o1; }
    }
#undef HG_LOAD
    __syncthreads();
}

__device__ __forceinline__ void mlstm_scan(const Frame& F, KA* ap, int l, int bh) {
    const int tid_ = my_tid();
    const int tid = tid_, lane = tid & 63, w = __builtin_amdgcn_readfirstlane(tid >> 6), hi = lane >> 5, c32 = lane & 31;
    unsigned char* ws = ap->ws; LAS unsigned char* lds = F.lds;
    const int b = bh >> 3, h = bh & 7; const size_t m0 = (size_t)b * T;
    const bf16_t* PROJ = (const bf16_t*)(ws + WS_PROJ); const bf16_t* BQK = (const bf16_t*)(ws + WS_BQK); const float* ODD = (const float*)(ws + WS_ODD);
    bf16_t* Y = (bf16_t*)(ws + WS_Y); const float* hn = ap->in[7] + l * 128;
    constexpr int QA = 0, QI = 9216, KB = 18432, KHT = 27648, VT = 36864, CT = 59904, PP = 82944, SCAL = 92160, NUM = 94208;
    constexpr int SK = 144, SN = 164;
    { const u32x4 z4 = zero4(); for (int i = tid; i < 23040 / 16; i += 512) *(LAS u32x4*)(lds + CT + i * 16) = z4; }
    for (int i = tid; i < 32 * SK / 16; i += 512) { const int off = i * 16; const unsigned vone = (off < SK) ? 0x3F803F80u : 0u;
        *(LAS u32x4*)(lds + VT + 128 * SK + off) = (u32x4){vone, vone, vone, vone}; }
    f32x16 cacc[2] = {};
    float m_prev = 0.f;
    const int te = tid >> 3, d0 = (tid & 7) * 8, k0 = 2 * lane;
    bf16x8 qreg, kreg; unsigned vv[8]; float igr = 0.f, lfr = 0.f;
#define ML_LOAD(c) do { const size_t rb = m0 + (size_t)(c) * 64; \
        qreg = *(const bf16x8*)(BQK + (rb + te) * 1024 + h * 64 + d0); kreg = *(const bf16x8*)(BQK + (rb + te) * 1024 + 512 + h * 64 + d0); \
        _Pragma("unroll") for (int i = 0; i < 8; ++i) vv[i] = *(const unsigned*)(PROJ + (rb + 8 * w + i) * LDP + C_BV + h * 128 + k0); \
        if (w == 0) { igr = ODD[(rb + lane) * LDO + 80 + h]; lfr = ODD[(rb + lane) * LDO + 88 + h]; } } while (0)
    float ggv[16];
#pragma unroll
    for (int i = 0; i < 16; ++i) ggv[i] = hn[(tid & 7) * 16 + i];
    ML_LOAD(0);
    for (int c = 0; c < T / 64; ++c) {
        const bf16_t* gp_ = PROJ + (m0 + (size_t)c * 64 + (tid >> 3)) * LDP + C_BO + h * 128 + (tid & 7) * 16; const u32x4 g0 = *(const u32x4*)gp_, g1 = *(const u32x4*)(gp_ + 8);
        if (w == 0) {
            float bc = lfr;
#pragma unroll
            for (int o = 1; o < 64; o <<= 1) { const float x = sidx(bc, lane - o); if (lane >= o) bc += x; }
            const float c1 = igr - bc; float pm = c1;
#pragma unroll
            for (int o = 1; o < 64; o <<= 1) { const float x = sidx(pm, lane - o); if (lane >= o) pm = fmaxf(pm, x); }
            const float mt = fmaxf(bc + pm, bc + m_prev);
            const float wi = __expf(bc + m_prev - mt);
            const float m_new = sidx(mt, 63), b63 = sidx(bc, 63);
            const float wst = __expf(b63 + c1 - m_new), decay = __expf(b63 + m_prev - m_new);
            LAS float* sc = (LAS float*)(lds + SCAL);
            sc[lane] = c1; sc[64 + lane] = bc - mt; sc[128 + lane] = wi; sc[192 + lane] = wst; sc[256 + lane] = __expf(-mt); if (lane == 0) sc[320] = decay;
            m_prev = m_new;
        }
        *(LAS bf16x8*)(lds + QA + te * SK + d0 * 2) = qreg; *(LAS bf16x8*)(lds + KB + te * SK + d0 * 2) = kreg;
        { u32x4 o; o.x = (vv[0] & 0xffffu) | (vv[1] << 16); o.y = (vv[2] & 0xffffu) | (vv[3] << 16); o.z = (vv[4] & 0xffffu) | (vv[5] << 16); o.w = (vv[6] & 0xffffu) | (vv[7] << 16);
          *(LAS u32x4*)(lds + VT + k0 * SK + w * 16) = o;
          o.x = (vv[0] >> 16) | (vv[1] & 0xffff0000u); o.y = (vv[2] >> 16) | (vv[3] & 0xffff0000u); o.z = (vv[4] >> 16) | (vv[5] & 0xffff0000u); o.w = (vv[6] >> 16) | (vv[7] & 0xffff0000u);
          *(LAS u32x4*)(lds + VT + (k0 + 1) * SK + w * 16) = o; }
        __syncthreads();
        { const LAS float* sc = (const LAS float*)(lds + SCAL); const float wi = sc[128 + te], wst = sc[192 + te];
          float qf[8], kf[8];
#pragma unroll
          for (int i = 0; i < 8; ++i) { qf[i] = bf2f((bf16_t)qreg[i]) * wi; kf[i] = bf2f((bf16_t)kreg[i]) * wst; }
          u32x4 o; o.x = cvt_pk_bf16(qf[0], qf[1]); o.y = cvt_pk_bf16(qf[2], qf[3]); o.z = cvt_pk_bf16(qf[4], qf[5]); o.w = cvt_pk_bf16(qf[6], qf[7]);
          *(LAS u32x4*)(lds + QI + te * SK + d0 * 2) = o;
#pragma unroll
          for (int i = 0; i < 8; ++i) *(LAS unsigned short*)(lds + KHT + (d0 + i) * SK + te * 2) = bf1(kf[i]); }
        if (c + 1 < T / 64) ML_LOAD(c + 1);
        __syncthreads();
        f32x16 pacc = {}, nacc0 = {}, nacc1 = {};
        const int ti = w >> 1, sj = w & 1;
        const float decay = ((const LAS float*)(lds + SCAL))[320];
        if (w < 4 && !(ti == 0 && sj == 1)) mma_nt<4>(pacc, lds + QA + ti * 32 * SK, SK, lds + KB + sj * 32 * SK, SK, lane);
        mma_nt<4>(nacc0, lds + QI + (w & 1) * 32 * SK, SK, lds + CT + (w >> 1) * 32 * SK, SK, lane);
        if (w < 2) mma_nt<4>(nacc1, lds + QI + w * 32 * SK, SK, lds + CT + 4 * 32 * SK, SK, lane);
#pragma unroll
        for (int r = 0; r < 16; ++r) cacc[0][r] *= decay;
        mma_nt<4>(cacc[0], lds + VT + (w >> 1) * 32 * SK, SK, lds + KHT + (w & 1) * 32 * SK, SK, lane);
        if (w < 2) {
#pragma unroll
            for (int r = 0; r < 16; ++r) cacc[1][r] *= decay;
            mma_nt<4>(cacc[1], lds + VT + 4 * 32 * SK, SK, lds + KHT + w * 32 * SK, SK, lane); }
        __syncthreads();
        if (w < 4) { const LAS float* sc = (const LAS float*)(lds + SCAL); const int s_ = 32 * sj + c32; const float c1s = sc[s_];
#pragma unroll
            for (int r = 0; r < 16; ++r) { const int t = 32 * ti + att::crow(r, hi); const float v = (s_ <= t) ? pacc[r] * __expf(c1s + sc[64 + t]) : 0.f;
                *(LAS unsigned short*)(lds + PP + t * SK + s_ * 2) = bf1(v); } }
#pragma unroll
        for (int r = 0; r < 16; ++r) { const int v_ = 32 * (w >> 1) + att::crow(r, hi), d_ = 32 * (w & 1) + c32; *(LAS unsigned short*)(lds + CT + v_ * SK + d_ * 2) = bf1(cacc[0][r]); }
        if (w < 2) {
#pragma unroll
            for (int r = 0; r < 16; ++r) { const int v_ = 128 + att::crow(r, hi), d_ = 32 * w + c32; *(LAS unsigned short*)(lds + CT + v_ * SK + d_ * 2) = bf1(cacc[1][r]); } }
        __syncthreads();
        mma_nt<4>(nacc0, lds + PP + (w & 1) * 32 * SK, SK, lds + VT + (w >> 1) * 32 * SK, SK, lane);
        if (w < 2) mma_nt<4>(nacc1, lds + PP + w * 32 * SK, SK, lds + VT + 4 * 32 * SK, SK, lane);
#pragma unroll
        for (int r = 0; r < 16; ++r) { const int t = 32 * (w & 1) + att::crow(r, hi), v_ = 32 * (w >> 1) + c32; *(LAS float*)(lds + NUM + (t * SN + v_) * 4) = nacc0[r]; }
        if (w < 2) {
#pragma unroll
            for (int r = 0; r < 16; ++r) { const int t = 32 * w + att::crow(r, hi), v_ = 128 + c32; *(LAS float*)(lds + NUM + (t * SN + v_) * 4) = nacc1[r]; } }
        __syncthreads();
        { const int t = tid >> 3, sg = tid & 7; const size_t row = m0 + (size_t)c * 64 + t;
          const float den = *(const LAS float*)(lds + NUM + (t * SN + 128) * 4); const float emt = ((const LAS float*)(lds + SCAL))[256 + t];
          const float inv = 1.f / fmaxf(fabsf(den), emt);
          float v[16]; float ss = 0.f;
#pragma unroll
          for (int q = 0; q < 4; ++q) { const f32x4 x = *(const LAS f32x4*)(lds + NUM + (t * SN + sg * 16 + 4 * q) * 4);
#pragma unroll
              for (int j = 0; j < 4; ++j) { const float y = x[j] * inv; v[4 * q + j] = y; ss += y * y; } }
          ss = sum8(ss);
          const float rs = 1.f / sqrtf(ss * (1.f / 128.f) + EPS);
          const float (&gg)[16] = ggv;
          u32x4 o0, o1;
          o0.x = cvt_pk_bf16(v[0] * rs * gg[0] * bf_lo(g0.x), v[1] * rs * gg[1] * bf_hi(g0.x)); o0.y = cvt_pk_bf16(v[2] * rs * gg[2] * bf_lo(g0.y), v[3] * rs * gg[3] * bf_hi(g0.y));
          o0.z = cvt_pk_bf16(v[4] * rs * gg[4] * bf_lo(g0.z), v[5] * rs * gg[5] * bf_hi(g0.z)); o0.w = cvt_pk_bf16(v[6] * rs * gg[6] * bf_lo(g0.w), v[7] * rs * gg[7] * bf_hi(g0.w));
          o1.x = cvt_pk_bf16(v[8] * rs * gg[8] * bf_lo(g1.x), v[9] * rs * gg[9] * bf_hi(g1.x)); o1.y = cvt_pk_bf16(v[10] * rs * gg[10] * bf_lo(g1.y), v[11] * rs * gg[11] * bf_hi(g1.y));
          o1.z = cvt_pk_bf16(v[12] * rs * gg[12] * bf_lo(g1.z), v[13] * rs * gg[13] * bf_hi(g1.z)); o1.w = cvt_pk_bf16(v[14] * rs * gg[14] * bf_lo(g1.w), v[15] * rs * gg[15] * bf_hi(g1.w));
          bf16_t* yo = Y + tiled_off(row, 1024 + h * 128 + sg * 16, DM); *(u32x4*)yo = o0; *(u32x4*)(yo + 8) = o1; }
    }
#undef ML_LOAD
    __syncthreads();
}

template <int STG2>
__device__ __forceinline__ void dsa_index_item2(const Frame& F, KA* ap, int item) {
    const int tid_ = my_tid();
    const int tid = tid_, lane = tid & 63, w = __builtin_amdgcn_readfirstlane(tid >> 6), hi = lane >> 5, c32 = lane & 31;
    unsigned char* ws = ap->ws; LAS unsigned char* lds = F.lds;
    const int b = item % NB, tb = (T / 32 - 1) - item / NB;
    const int t0 = tb * 32 + 4 * w; const size_t m0 = (size_t)b * T;
    const int n = 64 * (t0 / 64 + 1), nkb = n / 32, nj = n / 64;
    unsigned* MK = (unsigned*)(ws + WS_MASK) + (size_t)b * 256 * T;
    if (n <= 256) { for (int i = lane; i < nkb * 4; i += 64) MK[(size_t)(i >> 2) * T + t0 + (i & 3)] = 0xFFFFFFFFu; return; }
    const bf16_t* PROJ = (const bf16_t*)(ws + WS_PROJ); const bf16_t* KI = (const bf16_t*)(ws + WS_KI) + m0 * 64; const float* ODD = (const float*)(ws + WS_ODD);
    unsigned* SCB = (unsigned*)(ws + WS_SCB) + ((size_t)blockIdx.x * 8 + w) * 4 * T;
    LAS unsigned* hist = (LAS unsigned*)(lds + w * 8192);
    LAS unsigned* wb = hist + 1024;
    {
        bf16x8 af[2][4]; float wv[2][16];
#pragma unroll
        for (int rt = 0; rt < 2; ++rt) {
#pragma unroll
            for (int ks = 0; ks < 4; ++ks) af[rt][ks] = *(const bf16x8*)(PROJ + (m0 + t0 + 2 * rt + (c32 >> 4)) * LDP + C_DQI + (c32 & 15) * 64 + ks * 16 + hi * 8);
#pragma unroll
            for (int r = 0; r < 16; ++r) { const int tok = 2 * rt + (r >> 3), head = (r & 3) + 8 * ((r >> 2) & 1) + 4 * hi; wv[rt][r] = ODD[(m0 + t0 + tok) * LDO + 64 + head]; } }
        f32x2 wv2[2][8]; const f32x2 one2 = {1.f, 1.f};
#pragma unroll
        for (int rt = 0; rt < 2; ++rt)
#pragma unroll
            for (int i = 0; i < 8; ++i) wv2[rt][i] = (f32x2){wv[rt][2 * i], wv[rt][2 * i + 1]};
        LAS unsigned char* kbuf = lds + 65536;
#define IDX_LOADB(dst, base_, t_) do { _Pragma("unroll") for (int ks = 0; ks < 4; ++ks) dst[ks] = *(const LAS bf16x8*)((base_) + (((t_) * 4 + ks) * 64 + lane) * 16); } while (0)
#define IDX_MMA(src, A0, A1) do { A0 = f32x16{}; A1 = f32x16{}; _Pragma("unroll") for (int ks = 0; ks < 4; ++ks) { \
            A0 = __builtin_amdgcn_mfma_f32_32x32x16_bf16(af[0][ks], src[ks], A0, 0, 0, 0); A1 = __builtin_amdgcn_mfma_f32_32x32x16_bf16(af[1][ks], src[ks], A1, 0, 0, 0); } } while (0)
#define IDX_PKACC(SP, ACC, i_, W2) do { f32x2 x2_ = {ACC[2 * (i_)], ACC[2 * (i_) + 1]}, r2_; \
            asm("v_pk_mul_f32 %0, %1, %2 clamp" : "=v"(r2_) : "v"(x2_), "v"(one2));     \
            asm("v_pk_fma_f32 %0, %1, %2, %0" : "+v"(SP) : "v"(r2_), "v"(W2)); } while (0)
#define IDX_RED1(ACC, rt, kb_) do { f32x2 sp0 = {0.f, 0.f}, sp1 = {0.f, 0.f}; \
            _Pragma("unroll") for (int i = 0; i < 4; ++i) { IDX_PKACC(sp0, ACC, i, wv2[rt][i]); IDX_PKACC(sp1, ACC, 4 + i, wv2[rt][4 + i]); } \
            const float s0 = sp0.x + sp0.y, s1 = sp1.x + sp1.y; \
            const auto pr_ = __builtin_amdgcn_permlane32_swap(__float_as_uint(s0), __float_as_uint(s1), false, false); \
            const float sv = fminf(fmaxf(__uint_as_float(pr_[0]) + __uint_as_float(pr_[1]), -15.99f), 15.99f); \
            const unsigned key_ = ((unsigned)(int)(sv * 134217728.f) + 0x80000000u) >> 8; SCB[(size_t)(2 * rt + hi) * T + 32 * (kb_) + c32] = key_; \
            { const unsigned bin_ = key_ >> 15; __hip_atomic_fetch_add(&hist[(2 * rt + hi) * 256 + (bin_ >> 1)], 1u << (16 * (bin_ & 1u)), __ATOMIC_RELAXED, __HIP_MEMORY_SCOPE_WORKGROUP); } } while (0)
#define IDX_RED(A0, A1, kb_) do { IDX_RED1(A0, 0, kb_); IDX_RED1(A1, 1, kb_); } while (0)
        const int ngrp = (nkb + 7) >> 3;
        u32x4 stg[4];
#pragma unroll
        for (int i = 0; i < 16; ++i) hist[64 * i + lane] = 0u;
        asm volatile("s_waitcnt lgkmcnt(0)" ::: "memory");
#pragma unroll
        for (int i = 0; i < 4; ++i) { const int ch = tid + 512 * i; if ((ch >> 8) < nkb) stg[i] = *(const u32x4*)((const char*)KI + (size_t)ch * 16); }
#pragma unroll
        for (int i = 0; i < 4; ++i) { const int ch = tid + 512 * i; if ((ch >> 8) < nkb) *(LAS u32x4*)(kbuf + ch * 16) = stg[i]; }
        __syncthreads();
        for (int g = 0; g < ngrp; ++g) {
            const int kb0 = 8 * g, nt_ = (nkb - kb0) < 8 ? (nkb - kb0) : 8;
            if (g + 1 < ngrp) {
#pragma unroll
                for (int i = 0; i < 4; ++i) { const int ch = tid + 512 * i; if (kb0 + 8 + (ch >> 8) < nkb) stg[i] = *(const u32x4*)((const char*)KI + ((size_t)(kb0 + 8) * 256 + ch) * 16); } }
            const LAS unsigned char* cb = kbuf + (g & 1) * 32768;
            bf16x8 ra[4], rb[4]; f32x16 P0, P1, Q0, Q1;
            IDX_LOADB(ra, cb, 0); IDX_MMA(ra, P0, P1);
            for (int t = 0; t < nt_; t += 2) {
                IDX_LOADB(rb, cb, t + 1); IDX_MMA(rb, Q0, Q1);
                IDX_RED(P0, P1, kb0 + t);
                if (t + 2 < nt_) { IDX_LOADB(ra, cb, t + 2); IDX_MMA(ra, P0, P1); }
                IDX_RED(Q0, Q1, kb0 + t + 1);
            }
            if (g + 1 < ngrp) {
#pragma unroll
                for (int i = 0; i < 4; ++i) { const int ch = tid + 512 * i; if (kb0 + 8 + (ch >> 8) < nkb) *(LAS u32x4*)(kbuf + ((g + 1) & 1) * 32768 + ch * 16) = stg[i]; } }
            __syncthreads();
        }
#undef IDX_MMA
#undef IDX_PKACC
#undef IDX_RED1
#undef IDX_RED
#undef IDX_LOADB
    }
    asm volatile("s_waitcnt vmcnt(0)" ::: "memory");
    if (STG2 == 1) return;
#define WSYNC() asm volatile("s_waitcnt lgkmcnt(0)" ::: "memory")
    for (int row = 0; row < 4; ++row) {
        const unsigned* sc = SCB + (size_t)row * T;
        unsigned kv[128];
#pragma unroll
        for (int j = 0; j < 128; ++j) kv[j] = 0u;
        { int njl = nj; asm volatile("" : "+s"(njl));
#pragma unroll
        for (int j = 0; j < 128; ++j) { if (j < njl) kv[j] = sc[64 * j + lane]; } }
        unsigned prefix, kth = 256u;
        LAS unsigned* hrow = hist + row * 256;
        {   unsigned hw[4]; unsigned tot = 0u;
#pragma unroll
            for (int i = 0; i < 4; ++i) { hw[i] = hrow[4 * lane + i]; tot += (hw[i] & 0xffffu) + (hw[i] >> 16); }
            unsigned suf = tot;
#pragma unroll
            for (int o = 1; o < 64; o <<= 1) { const unsigned x = sidxu(suf, lane + o); if (lane + o < 64) suf += x; }
            const unsigned above = suf - tot;
            unsigned selv = 0u, selk = 0u; const bool mine = (suf >= kth && above < kth);
            if (mine) { unsigned cnt = above; int bin = 0; bool found = false;
#pragma unroll
                for (int i = 7; i >= 0; --i) { const unsigned c = (i & 1) ? (hw[i >> 1] >> 16) : (hw[i >> 1] & 0xffffu);
                    if (!found) { if (cnt + c >= kth) { bin = i; found = true; } else cnt += c; } }
                selv = (unsigned)(8 * lane + bin); selk = kth - cnt; }
            const unsigned long long bm = __ballot(mine); const int src = (int)__builtin_ctzll(bm ? bm : 1ull);
            prefix = sidxu(selv, src); kth = sidxu(selk, src);
            WSYNC();
        }
#pragma unroll
        for (int pass = 1; pass < 3; ++pass) {
            const int shift = (pass == 1) ? 7 : 0, hshift = (pass == 1) ? 15 : 7; const unsigned dmask = (pass == 1) ? 255u : 127u;
#pragma unroll
            for (int i = 0; i < 4; ++i) hrow[64 * i + lane] = 0u;
            WSYNC();
            { int njl = nj; asm volatile("" : "+s"(njl));
#pragma unroll
            for (int j = 0; j < 128; ++j) { if (j < njl) { const unsigned key = kv[j];
                if ((key >> hshift) == prefix) __hip_atomic_fetch_add(&hrow[(key >> shift) & dmask], 1u, __ATOMIC_RELAXED, __HIP_MEMORY_SCOPE_WORKGROUP); } } }
            WSYNC();
            const unsigned h0 = hrow[4 * lane], h1 = hrow[4 * lane + 1], h2 = hrow[4 * lane + 2], h3 = hrow[4 * lane + 3];
            unsigned suf = h0 + h1 + h2 + h3;
#pragma unroll
            for (int o = 1; o < 64; o <<= 1) { const unsigned x = sidxu(suf, lane + o); if (lane + o < 64) suf += x; }
            const unsigned above = suf - (h0 + h1 + h2 + h3);
            unsigned selv = 0u, selk = 0u; const bool mine = (suf >= kth && above < kth);
            if (mine) { unsigned cnt = above; int bin;
                if (cnt + h3 >= kth) { bin = 3; } else { cnt += h3; if (cnt + h2 >= kth) { bin = 2; } else { cnt += h2; if (cnt + h1 >= kth) { bin = 1; } else { cnt += h1; bin = 0; } } }
                selv = (unsigned)(4 * lane + bin); selk = kth - cnt; }
            const unsigned long long bm = __ballot(mine); const int src = (int)__builtin_ctzll(bm ? bm : 1ull);
            prefix = (prefix << ((pass == 1) ? 8 : 7)) | sidxu(selv, src); kth = sidxu(selk, src);
            WSYNC();
        }
        if (STG2 == 2) { if (prefix == 0xdeadbeefu) MK[0] = kth; continue; }
        { int njl = nj; asm volatile("" : "+s"(njl));
#pragma unroll
        for (int j = 0; j < 128; ++j) { if (j < njl) { const unsigned long long bal = __ballot(kv[j] >= prefix);
            if (lane == 0) { wb[(2 * j) * 4 + row] = (unsigned)bal; wb[(2 * j + 1) * 4 + row] = (unsigned)(bal >> 32); } } } }
    }
    WSYNC();
    for (int kb = lane; kb < nkb; kb += 64) { const u32x4 v = *(const LAS u32x4*)(wb + kb * 4); *(u32x4*)(MK + (size_t)kb * T + t0) = v; }
    WSYNC();
#undef WSYNC
}

__device__ __forceinline__ int qn(unsigned* ctr, volatile LAS unsigned* slot, int lo, int hi) { const int v = q_next(ctr, slot) + lo; return v < hi ? v : 0x7fffffff; }
constexpr int IT_A = 16, IT_B = 32, IT_C = 32 + 1024, IT_D = IT_C + NB * (T / 32);
template <int ISTG>
__device__ __forceinline__ void mixer_a_phase(const Frame& F, KA* ap, int l, unsigned* qctr, int it_lo, int it_hi) {
    volatile LAS unsigned* slot = (volatile LAS unsigned*)(F.lds + LDS_MISC) + 16;
    unsigned char* ws = ap->ws;
    int it = qn(qctr, slot, it_lo, it_hi);
#ifndef NO_A
    while (it < IT_A) { hgrn_scan(F, ap, l, it); it = qn(qctr, slot, it_lo, it_hi); }
#endif
#ifndef NO_B
    while (it < IT_B) { mlstm_scan(F, ap, l, it - IT_A); it = qn(qctr, slot, it_lo, it_hi); }
#endif
    {
        const bf16_t* PROJ = (const bf16_t*)(ws + WS_PROJ); float* CATT = (float*)(ws + WS_CATT);
        att::Seam S;
        while (it < IT_C) {
            const int i = it - IT_B, y = 31 - (i >> 5), r = i & 31, b = r >> 4, vh = r & 15, h = vh >> 2, mm = (vh >> 1) & 1, vhalf = vh & 1;
            const bf16_t* base = PROJ + (size_t)b * T * LDP;
            att::BlockRef<float> r0;
            r0.Q = base + (size_t)(y * 256) * LDP + C_CQ + (h * 2 + mm) * 128; r0.K = base + C_CK + (h * 2 + mm) * 128; r0.V = base + C_CV + h * 256 + vhalf * 128;
            r0.O = CATT + ((size_t)b * T + y * 256) * 2048 + mm * 1024 + h * 256 + vhalf * 128; r0.MK = nullptr; r0.P0 = y * 256; r0.orow = 0; r0.ocol = 0;
#ifndef NO_C
            att::attn_prime<float>(r0, (char*)F.lds, S);
            att::attn_block<float, false, 2048>(r0, r0, (char*)F.lds, S);
#endif
            it = qn(qctr, slot, it_lo, it_hi);
        }
    }
#ifndef NO_D
    while (it < IT_D) { dsa_index_item2<4>(F, ap, it - IT_C); it = qn(qctr, slot, it_lo, it_hi); }
#endif
}
__device__ __forceinline__ void mixer_b_phase(const Frame& F, KA* ap, int l, unsigned* qctr) {
    volatile LAS unsigned* slot = (volatile LAS unsigned*)(F.lds + LDS_MISC) + 16;
    unsigned char* ws = ap->ws;
    const bf16_t* PROJ = (const bf16_t*)(ws + WS_PROJ); bf16_t* Y = (bf16_t*)(ws + WS_Y); const unsigned* MASK = (const unsigned*)(ws + WS_MASK);
    att::Seam S;
    int it = q_next(qctr, slot);
    while (it < 512) {
        const int y = 31 - (it >> 4), r = it & 15, b = r >> 3, h = r & 7;
        const bf16_t* base = PROJ + (size_t)b * T * LDP;
        att::BlockRef<bf16_t> r0;
        r0.Q = base + (size_t)(y * 256) * LDP + C_DQ + h * 128; r0.K = base + C_DK + h * 128; r0.V = base + C_DV + h * 128;
        r0.O = Y; r0.orow = b * T + y * 256; r0.ocol = 3072 + h * 128; r0.MK = MASK + (size_t)b * 256 * T; r0.P0 = y * 256;
#ifndef NO_E
        att::attn_prime<bf16_t>(r0, (char*)F.lds, S);
        att::attn_block<bf16_t, true, DM>(r0, r0, (char*)F.lds, S);
#endif
        it = q_next(qctr, slot);
    }
#ifndef NO_G
    { const Frame F2 = make_frame(F.lds); ccombine_phase(F2, ap, l); }
#endif
}

__global__ void __launch_bounds__(512, 2) mk_fwd(Args args) {
    extern __shared__ __attribute__((aligned(16))) unsigned char lds_raw[];
    LAS unsigned char* lds = (LAS unsigned char*)lds_raw;
    volatile LAS unsigned* MISC = (volatile LAS unsigned*)(lds + LDS_MISC);
    if (threadIdx.x < 64) MISC[threadIdx.x] = 0u;
    if ((threadIdx.x & 63) == 0) *(volatile LAS unsigned*)(lds + LDS_WTAB + ((unsigned)__builtin_amdgcn_s_getreg((5 << 11) | 4) & 63u) * 4) = threadIdx.x >> 6;
    __syncthreads();
    if (my_tid() != (int)threadIdx.x) __builtin_trap();
    const int lo = args.ph_lo, hi = args.ph_hi;
    XcdBarrier bar; bar.bar = (unsigned*)(args.ws + WS_CTL) + CW_BAR; bar.x = 0; bar.st = nullptr;
    if (hi - lo > 1) bar = xcd_barrier_post((unsigned*)(args.ws + WS_CTL) + CW_BAR, MISC + 8);
#define IN(k) (lo <= (k) && (k) < hi)
#define SEAM(k) do { if (IN(k) && IN((k) + 1)) { XcdBarrier b_; b_.bar = (unsigned*)(PH_ARGS()->ws + WS_CTL) + CW_BAR; b_.x = xb_xcc_id(); b_.st = MISC + 8; xcd_barrier(b_); } } while (0)

#ifndef REP_P0
#define REP_P0 1
#endif
    if (IN(0)) { for (int rep = 0; rep < REP_P0; ++rep) { KA* ap = PH_ARGS(); const Frame F = make_frame(lds); p0_prologue(F, ap); } SEAM(0); }

#pragma unroll
    for (int l = 0; l < DEPTH; ++l) {
        const int pb = 1 + 9 * l;
        if (IN(pb + 0)) {
            KA* ap = PH_ARGS(); unsigned char* ws = ap->ws;
            pg8::Gemm g{(const bf16_t*)(ws + WS_XB), (const bf16_t*)(ws + WS_WIN + l * SZ_WIN), M, LDP, DM, DM}; pg8::StaticOrder S; S.init(M, LDP, gridDim.x, (int)blockIdx.x);
            EpiInProj E{(bf16_t*)(ws + WS_PROJ), (float*)(ws + WS_GLOG), (float*)(ws + WS_ODD), (const float*)(ws + WS_LB) + l * 1024, ap->in[6] + l * 16, (const float*)(ws + WS_SSQP), ap->in[8] + l * 256, ap->in[11] + l * 256, (LAS float*)(lds + 131072), (LAS float*)(lds + 139264), (volatile LAS int*)(MISC + 28), (float*)(ws + WS_RS)};
            if (my_tid() == 0) MISC[28] = 0xFFFFFFFFu;
#ifndef REP_G1
#define REP_G1 1
#endif
            for (int rep = 0; rep < REP_G1; ++rep) pg8::gemm_phase<EpiInProj, pg8::StaticOrder>(lds, g, S, E);
            { pg8::Gemm g2{(const bf16_t*)(ws + WS_XB), (const bf16_t*)(ws + WS_WIN + l * SZ_WIN) + (size_t)56 * 256 * DM, M, 256, DM / 4, DM}; pg8::SplitKOrder S2; S2.init(M, 4, gridDim.x, (int)blockIdx.x);
              EpiOddPart E2{(float*)(ws + WS_Y)};
              pg8::gemm_phase<EpiOddPart, pg8::SplitKOrder>(lds, g2, S2, E2); }
            if (l == 0) { KA* apb = PH_ARGS(); const Frame Fb = make_frame(lds); bg_convert(Fb, apb, (unsigned*)(apb->ws + WS_CTL) + CW_BGQ + 64 * (1 + 0), false); }
            SEAM(pb + 0);
        }
#ifndef NO_F
        if (IN(pb + 1)) { { KA* ap = PH_ARGS(); const Frame F = make_frame(lds); fixup_phase<false>(F, ap, l); }
#ifdef REP_FX
            for (int rep = 0; rep < REP_FX; ++rep) { KA* ap = PH_ARGS(); const Frame F = make_frame(lds); fixup_phase<true>(F, ap, l); }
#endif
            if (l == 0) { KA* apb = PH_ARGS(); const Frame Fb = make_frame(lds); bg_convert(Fb, apb, (unsigned*)(apb->ws + WS_CTL) + CW_BGQ + 64 * (1 + 4), false); } SEAM(pb + 1); }
#endif
        if (IN(pb + 2)) {
#ifndef REP_A
#define REP_A 1
#endif
#ifdef PROBE_LO
            for (int rep = 0; rep < 2; ++rep)
            { KA* ap = PH_ARGS(); const Frame F = make_frame(lds); mixer_a_phase<4>(F, ap, l, (unsigned*)(ap->ws + WS_CTL) + CW_Q + 64 * (2 * l) + 16 * rep, rep ? PROBE_LO : 0, rep ? PROBE_HI : IT_D); }
#else
            if (l == 0 && blockIdx.x < NCVW) { KA* apc = PH_ARGS(); const Frame Fc = make_frame(lds); conv_side(Fc, apc); }
            { KA* ap = PH_ARGS(); const Frame F = make_frame(lds); mixer_a_phase<4>(F, ap, l, (unsigned*)(ap->ws + WS_CTL) + CW_Q + 64 * (2 * l), 0, IT_D); }
#endif
            if (l == 0) { KA* apb = PH_ARGS(); const Frame Fb = make_frame(lds); bg_convert(Fb, apb, (unsigned*)(apb->ws + WS_CTL) + CW_BGQ + 64 * (1 + 5), false); } SEAM(pb + 2); }
        if (IN(pb + 3)) {
#ifndef REP_B
#define REP_B 1
#endif
            for (int rep = 0; rep < REP_B; ++rep) { KA* ap = PH_ARGS(); const Frame F = make_frame(lds); mixer_b_phase(F, ap, l, (unsigned*)(ap->ws + WS_CTL) + CW_Q + 64 * (2 * l + 1) + 16 * rep); }
            if (l == 0) { KA* apb = PH_ARGS(); const Frame Fb = make_frame(lds); bg_convert(Fb, apb, (unsigned*)(apb->ws + WS_CTL) + CW_BGQ + 64 * (1 + 6), false); } SEAM(pb + 3); }
        if (IN(pb + 4)) {
            KA* ap = PH_ARGS(); unsigned char* ws = ap->ws;
            pg8::Gemm g{(const bf16_t*)(ws + WS_Y), (const bf16_t*)(ws + WS_WOUT + l * SZ_WOUT), M, DM, DM, DM}; pg8::StaticOrder S; S.init(M, DM, gridDim.x, (int)blockIdx.x);
            EpiResidBf E{(bf16_t*)(ws + WS_XB), (float*)(ws + WS_SSQP)};
            pg8::gemm_phase<EpiResidBf, pg8::StaticOrder>(lds, g, S, E);
            if (l == 0) { KA* apb = PH_ARGS(); const Frame Fb = make_frame(lds); bg_convert(Fb, apb, (unsigned*)(apb->ws + WS_CTL) + CW_BGQ + 64 * (1 + 1), false); }
            SEAM(pb + 4);
        }
#ifndef REP_RN
#define REP_RN 1
#endif
        if (IN(pb + 6)) {
            KA* ap = PH_ARGS(); unsigned char* ws = ap->ws;
            pg8::Gemm g{(const bf16_t*)(ws + WS_XB), (const bf16_t*)(ws + WS_W1 + l * SZ_W1), M, FF, DM, DM}; pg8::StaticOrder S; S.init(M, FF, gridDim.x, (int)blockIdx.x);
            EpiRelu2 E{(bf16_t*)(ws + WS_PROJ), (const float*)(ws + WS_SSQP), (LAS float*)(lds + 139264), (volatile LAS int*)(MISC + 28)};
            if (my_tid() == 0) MISC[28] = 0xFFFFFFFFu;
#ifndef REP_G3
#define REP_G3 1
#endif
            for (int rep = 0; rep < REP_G3; ++rep) pg8::gemm_phase<EpiRelu2, pg8::StaticOrder>(lds, g, S, E);
            if (l == 0) { KA* apb = PH_ARGS(); const Frame Fb = make_frame(lds); bg_convert(Fb, apb, (unsigned*)(apb->ws + WS_CTL) + CW_BGQ + 64 * (1 + 2), false); }
            SEAM(pb + 6);
        }
        if (IN(pb + 7)) {
            KA* ap = PH_ARGS(); unsigned char* ws = ap->ws;
            pg8::Gemm g{(const bf16_t*)(ws + WS_PROJ), (const bf16_t*)(ws + WS_W2 + l * SZ_W2), M, DM, FF, FF}; pg8::StaticOrder S; S.init(M, DM, gridDim.x, (int)blockIdx.x);
            if (l + 1 < DEPTH) { EpiResidBf E{(bf16_t*)(ws + WS_XB), (float*)(ws + WS_SSQP)}; pg8::gemm_phase<EpiResidBf, pg8::StaticOrder>(lds, g, S, E); }
            else { EpiFinal E{(const bf16_t*)(ws + WS_XB), ap->out}; pg8::gemm_phase<EpiFinal, pg8::StaticOrder>(lds, g, S, E); }
            if (l == 0) { KA* apb = PH_ARGS(); const Frame Fb = make_frame(lds); bg_convert(Fb, apb, nullptr, true); }
            SEAM(pb + 7);
        }
    }
#undef IN
#undef SEAM
}

extern "C" void kernel_launch(void* const* d_in, const int* in_sizes, int n_in, void* d_out, int out_size, void* d_ws, size_t ws_size, hipStream_t stream) {
    static int grid = 0;
    if (grid == 0) {
        if (n_in != 17 || in_sizes[0] != M * DM || out_size != M * DM || ws_size < WS_END) { fprintf(stderr, "kernel_launch: unexpected shapes (n_in %d in0 %d out %d ws %zu need %zu)\n", n_in, in_sizes[0], out_size, ws_size, (size_t)WS_END); grid = -1; return; }
        int dev = 0, cus = 0;
        if (hipGetDevice(&dev) != hipSuccess || hipDeviceGetAttribute(&cus, hipDeviceAttributeMultiprocessorCount, dev) != hipSuccess) { grid = -1; return; }
        if (hipFuncSetAttribute((const void*)mk_fwd, hipFuncAttributeMaxDynamicSharedMemorySize, LDS_BYTES) != hipSuccess) { fprintf(stderr, "kernel_launch: hipFuncSetAttribute failed\n"); grid = -1; return; }
        int per_cu = 0;
        if (hipOccupancyMaxActiveBlocksPerMultiprocessor(&per_cu, (const void*)mk_fwd, 512, LDS_BYTES) != hipSuccess || per_cu < 1) fprintf(stderr, "kernel_launch: occupancy query reports %d\n", per_cu);
        (void)hipGetLastError();
        grid = cus < 256 ? cus : 256;
    }
    if (grid < 0) return;
    if (hipMemsetAsync((char*)d_ws + WS_CTL, 0, CTL_BYTES, stream) != hipSuccess) return;
    Args a{};
    for (int i = 0; i < 17; ++i) a.in[i] = (const float*)d_in[i];
    a.out = (float*)d_out; a.ws = (unsigned char*)d_ws;
#if ONE_LAUNCH
    a.ph_lo = 0; a.ph_hi = NPHASE;
    hipLaunchKernelGGL(mk_fwd, dim3(grid), dim3(512), LDS_BYTES, stream, a);
#else
    for (int p = 0; p < NPHASE; ++p) { a.ph_lo = p; a.ph_hi = p + 1; hipLaunchKernelGGL(mk_fwd, dim3(grid), dim3(512), LDS_BYTES, stream, a); }
#endif
}
```

```cpp
#include <hip/hip_runtime.h>
#include <cstdio>
#include <cstdint>

#ifndef ONE_LAUNCH
#define ONE_LAUNCH 1
#endif

#define LAS __attribute__((address_space(3)))
typedef unsigned short bf16_t;
typedef short bf16x8 __attribute__((ext_vector_type(8)));
typedef short s16x4 __attribute__((ext_vector_type(4)));
typedef float f32x2 __attribute__((ext_vector_type(2)));
typedef float f32x4 __attribute__((ext_vector_type(4)));
typedef float f32x16 __attribute__((ext_vector_type(16)));
typedef unsigned u32x2 __attribute__((ext_vector_type(2)));
typedef unsigned u32x4 __attribute__((ext_vector_type(4)));

constexpr int T = 8192, NB = 2, M = NB * T, DM = 4096, FF = 16384, DEPTH = 2;
constexpr int NIN = 14432, NINP = 14592;
constexpr int LDP = 14336;
constexpr int C_AQ = 0, C_AF = 1024, C_AI = 2048, C_AG = 3072, C_BQK = 4096, C_BV = 5120, C_BO = 6144;
constexpr int C_CQ = 7168, C_CK = 8192, C_CV = 9216, C_DQ = 10240, C_DK = 11264, C_DV = 12288, C_DQI = 13312;
constexpr int LDO = 128;
constexpr float EPS = 1e-6f;

constexpr size_t MiB = 1u << 20;
constexpr size_t WS_CTL = 0, CTL_BYTES = 2 * MiB;
constexpr size_t SZ_WIN = (size_t)NINP * DM * 2, SZ_WOUT = (size_t)DM * DM * 2, SZ_W1 = (size_t)FF * DM * 2, SZ_W2 = (size_t)DM * FF * 2;
constexpr size_t WS_WIN = WS_CTL + CTL_BYTES;
constexpr size_t WS_WOUT = WS_WIN + 2 * SZ_WIN;
constexpr size_t WS_W1 = WS_WOUT + 2 * SZ_WOUT;
constexpr size_t WS_W2 = WS_W1 + 2 * SZ_W1;
constexpr size_t WS_XB = WS_W2 + 2 * SZ_W2;
constexpr size_t WS_PROJ = WS_XB + (size_t)M * DM * 2;
constexpr size_t WS_GLOG = WS_PROJ + (size_t)M * LDP * 2;
constexpr size_t WS_ODD = WS_GLOG + (size_t)M * 1024 * 4;
constexpr size_t WS_Y = WS_ODD + (size_t)M * LDO * 4;
constexpr size_t WS_MASK = WS_Y + (size_t)M * DM * 2;
constexpr size_t WS_BQK = WS_MASK + (size_t)NB * 256 * T * 4;
constexpr size_t WS_KI = WS_BQK + (size_t)M * 1024 * 2;
constexpr size_t WS_LB = WS_KI + (size_t)M * 64 * 2;
constexpr size_t WS_SCB = WS_LB + 65536;
constexpr size_t WS_CATT = WS_SCB + (size_t)256 * 8 * 4 * T * 4;
constexpr size_t WS_SSQP = WS_CATT + (size_t)M * 2048 * 4;
constexpr size_t WS_RS = WS_SSQP + (size_t)64 * M * 4;
constexpr size_t WS_END = WS_RS + (size_t)M * 4;
static_assert((size_t)M * LDP * 2 + (size_t)M * 1024 * 4 == (size_t)M * FF * 2, "HID overlay");

constexpr int CW_BAR = 1024;
constexpr int CW_BGQ = 12288;
constexpr int CW_Q = 8192;

constexpr int LDS_BYTES = 147456;
constexpr int LDS_MISC = LDS_BYTES - 512;
constexpr int LDS_WTAB = LDS_BYTES - 256;
constexpr int NPHASE = 1 + 9 * DEPTH;

__host__ __device__ __forceinline__ size_t tiled_off(size_t row, int col, int K) { return ((((row >> 8) * (size_t)(K >> 6)) + (size_t)(col >> 6)) * 256 + (row & 255)) * 64 + (col & 63); }
__device__ __forceinline__ unsigned cvt_pk_bf16(float lo, float hi) { unsigned r; asm volatile("v_cvt_pk_bf16_f32 %0, %1, %2" : "=v"(r) : "v"(lo), "v"(hi)); return r; }
__device__ __forceinline__ float bf_lo(unsigned u) { return __uint_as_float(u << 16); }
__device__ __forceinline__ float bf_hi(unsigned u) { return __uint_as_float(u & 0xffff0000u); }
__device__ __forceinline__ float bf2f(bf16_t b) { return __uint_as_float(((unsigned)b) << 16); }
__device__ __forceinline__ float fast_sigmoid(float v) { return __builtin_amdgcn_rcpf(1.f + __expf(-v)); }
__device__ __forceinline__ float fast_silu(float v) { return v * fast_sigmoid(v); }
__device__ __forceinline__ int my_tid() {
    unsigned lane; asm volatile("v_mbcnt_lo_u32_b32 %0, -1, 0\n\tv_mbcnt_hi_u32_b32 %0, -1, %0" : "=v"(lane));
    const unsigned slot = (unsigned)__builtin_amdgcn_s_getreg((5 << 11) | 4) & 63u;
    const unsigned wv = *(volatile LAS unsigned*)(uintptr_t)(LDS_WTAB + slot * 4);
    return __builtin_amdgcn_readfirstlane((int)wv) * 64 + (int)lane;
}
__device__ __forceinline__ float sx(float v, int o, int lane) { return __int_as_float(__builtin_amdgcn_ds_bpermute((lane ^ o) << 2, __float_as_int(v))); }
#define DPPF(v, ctrl) __int_as_float(__builtin_amdgcn_update_dpp(0, __float_as_int(v), (ctrl), 0xf, 0xf, true))
__device__ __forceinline__ float xrow16_sum(float x) {
    auto s = __builtin_amdgcn_permlane16_swap(__float_as_uint(x), __float_as_uint(x), false, false);
    x = __uint_as_float(s[0]) + __uint_as_float(s[1]);
    auto t = __builtin_amdgcn_permlane32_swap(__float_as_uint(x), __float_as_uint(x), false, false);
    return __uint_as_float(t[0]) + __uint_as_float(t[1]);
}
__device__ __forceinline__ float sum8(float v) { v += DPPF(v, 0xB1); v += DPPF(v, 0x4E); v += DPPF(v, 0x141); return v; }
__device__ __forceinline__ float sum16(float v) { v = sum8(v); v += DPPF(v, 0x140); return v; }
__device__ __forceinline__ float sidx(float v, int src) { return __int_as_float(__builtin_amdgcn_ds_bpermute(src << 2, __float_as_int(v))); }
__device__ __forceinline__ unsigned sidxu(unsigned v, int src) { return (unsigned)__builtin_amdgcn_ds_bpermute(src << 2, (int)v); }
__device__ __forceinline__ u32x4 zero4() { unsigned z = 0u; asm volatile("" : "+v"(z)); return (u32x4){z, z, z, z}; }

namespace pg8 {
constexpr int BM = 256, BK = 64, HALF = 128, HTB = HALF * BK * 2, STAGE_BYTES = 8 * HTB, NXCD = 8, WGM = 8;
__host__ __device__ __forceinline__ int lds_byte(int r, int c) { const int st = (r >> 4) * 2 + (c >> 5), rr = r & 15, cc = c & 31, ob = rr * 64 + cc * 2; return st * 1024 + (ob ^ (((ob >> 9) & 1) << 5)); }
__host__ __device__ __forceinline__ void stage_rc(int b, int& R, int& C) { const int st = b / 1024, sb = b % 1024, swz = sb ^ (((sb >> 9) & 1) << 5); R = (st >> 1) * 16 + swz / 64; C = (st & 1) * 32 + (swz % 64) / 2; }
__host__ __device__ __forceinline__ int perm32(int rho) { const int n = rho >> 4, i = rho & 15; return 8 * (i >> 2) + 4 * n + (i & 3); }
struct Unit { int pm, pn; };
struct Gemm { const bf16_t* A; const bf16_t* Bt; int M, N, K, Kld; };
struct StaticOrder {
    int nM, nN, nwg, G, c;
    __host__ __device__ void init(int M_, int N_, int G_, int c_) { nM = M_ / BM; nN = N_ / BM; nwg = nM * nN; G = G_; c = c_; }
    __host__ __device__ bool next(int i, Unit& u) const {
        const long L = (long)i * G + c; if (L >= nwg) return false;
        int wgid = (int)L; { const int q = nwg / NXCD, r = nwg % NXCD, xcd = wgid % NXCD, off = wgid / NXCD; wgid = (xcd < r ? xcd * (q + 1) : r * (q + 1) + (xcd - r) * q) + off; }
        const int nig = WGM * nN, gid = wgid / nig, fm = gid * WGM, gsz = (nM - fm) < WGM ? (nM - fm) : WGM;
        u.pm = fm + ((wgid % nig) % gsz); u.pn = (wgid % nig) / gsz; return true;
    }
    __device__ __forceinline__ void a_ready(const Unit&) const {}
    __device__ __forceinline__ void done(const Unit&) const {}
    __device__ __forceinline__ size_t aoff(const Unit& u, size_t tstep, size_t) const { return (size_t)u.pm * tstep; }
    __device__ __forceinline__ size_t boff(const Unit& u, size_t tstep, size_t) const { return (size_t)u.pn * tstep; }
};
struct SplitKOrder {
    int G, c, nunits, nsplit;
    __device__ void init(int M_, int nsplit_, int G_, int c_) { nsplit = nsplit_; nunits = (M_ / BM) * nsplit_; G = G_; c = c_; }
    __device__ bool next(int i, Unit& u) const { const int L = i * G + c; if (L >= nunits) return false; u.pm = L / nsplit; u.pn = L % nsplit; return true; }
    __device__ __forceinline__ void a_ready(const Unit&) const {}
    __device__ __forceinline__ size_t aoff(const Unit& u, size_t tstep, size_t kspan) const { return (size_t)u.pm * tstep + (size_t)u.pn * kspan; }
    __device__ __forceinline__ size_t boff(const Unit& u, size_t, size_t kspan) const { return (size_t)u.pn * kspan; }
};

template <class Epi, class Sched>
__device__ __forceinline__ void gemm_phase(LAS unsigned char* lds, const Gemm g, const Sched& S, const Epi& E) {
    const int tid_ = my_tid();
    const int tid = tid_, wid = __builtin_amdgcn_readfirstlane(tid >> 6), lane = tid & 63, wr = wid >> 2, wc = wid & 3, fr = lane & 15, fq = lane >> 4;
    const int K = g.K, nt = K / BK;
    unsigned voffA[2], voffB[2];
#pragma unroll
    for (int i = 0; i < 2; ++i) { int R, C; stage_rc(tid * 16 + i * 8192, R, C); const int Rb = Epi::PERM ? ((R & ~31) + perm32(R & 31)) : R;
        voffA[i] = (unsigned)(R * 64 + C) * 2u; voffB[i] = (unsigned)(Rb * 64 + C) * 2u; }
    const size_t kstep = (size_t)(BM * BK * 2);
    const size_t hstep = (size_t)HALF * BK * 2;
    const size_t tstep = (size_t)BM * g.Kld * 2, kspan = (size_t)nt * kstep;
    const unsigned ldsw = (unsigned)wid * 1024u;
    const int aoff = lds_byte(wr * 64 + fr, fq * 8), boff = lds_byte(wc * 32 + fr, fq * 8);
#define PG8_SA(b, h) (((b) * 2 + (h)) * HTB)
#define PG8_SB(b, h) ((4 + (b) * 2 + (h)) * HTB)
#define PG8_STAGE(bufoff, gbase, voff) do { _Pragma("unroll") for (int _i = 0; _i < 2; ++_i) \
        __builtin_amdgcn_global_load_lds((const unsigned*)((const char*)(gbase) + (voff)[_i]), (LAS unsigned*)(lds + (bufoff) + ldsw + _i * 8192), 16, 0, 0); } while (0)
#define PG8_LDA(dst, b, h) do { _Pragma("unroll") for (int m = 0; m < 4; ++m) _Pragma("unroll") for (int k = 0; k < 2; ++k) dst[m][k] = *(const LAS bf16x8*)(lds + PG8_SA(b, h) + aoff + m * 2048 + k * 1024); } while (0)
#define PG8_LDB(dst, b, h) do { _Pragma("unroll") for (int n = 0; n < 2; ++n) _Pragma("unroll") for (int k = 0; k < 2; ++k) dst[n][k] = *(const LAS bf16x8*)(lds + PG8_SB(b, h) + boff + n * 2048 + k * 1024); } while (0)
#define PG8_MMA(ai, bj, At, Bt) do { __builtin_amdgcn_s_setprio(1); _Pragma("unroll") for (int m = 0; m < 4; ++m) _Pragma("unroll") for (int n = 0; n < 2; ++n) _Pragma("unroll") for (int k = 0; k < 2; ++k) \
        acc[ai][bj][m][n] = __builtin_amdgcn_mfma_f32_16x16x32_bf16(Bt[n][k], At[m][k], acc[ai][bj][m][n], 0, 0, 0); __builtin_amdgcn_s_setprio(0); } while (0)
#define PG8_WAIT_V(n) asm volatile("s_waitcnt vmcnt(" #n ")" ::: "memory")
#define PG8_WAIT_L(n) asm volatile("s_waitcnt lgkmcnt(" #n ")" ::: "memory")
#define PG8_BAR __builtin_amdgcn_s_barrier()
#define PG8_SCHED __builtin_amdgcn_sched_barrier(0)
    Unit cur, nxt; int ui = 0;
    if (!S.next(0, cur)) return;
    f32x4 acc[2][2][4][2];
#pragma unroll
    for (int a = 0; a < 2; ++a)
#pragma unroll
        for (int b = 0; b < 2; ++b)
#pragma unroll
            for (int m = 0; m < 4; ++m)
#pragma unroll
                for (int n = 0; n < 2; ++n) acc[a][b][m][n] = (f32x4){0.f, 0.f, 0.f, 0.f};
    bf16x8 At[4][2], B0[2][2], B1[2][2];
    const char* cA = (const char*)g.A + S.aoff(cur, tstep, kspan); const char* cB = (const char*)g.Bt + S.boff(cur, tstep, kspan);
    S.a_ready(cur);
    PG8_STAGE(PG8_SB(0, 0), cB, voffB); PG8_STAGE(PG8_SB(0, 1), cB + hstep, voffB); PG8_STAGE(PG8_SA(0, 0), cA, voffA); PG8_STAGE(PG8_SA(0, 1), cA + hstep, voffA);
    if (wr == 1) PG8_BAR;
    PG8_WAIT_V(2); PG8_BAR;
    PG8_STAGE(PG8_SB(1, 0), cB + kstep, voffB); PG8_STAGE(PG8_SA(1, 0), cA + kstep, voffA); PG8_STAGE(PG8_SB(1, 1), cB + hstep + kstep, voffB);
    PG8_WAIT_V(6); PG8_BAR;
    for (;;) {
        const bool has_next = S.next(ui + 1, nxt);
        const char* nA = has_next ? (const char*)g.A + S.aoff(nxt, tstep, kspan) : cA; const char* nB = has_next ? (const char*)g.Bt + S.boff(nxt, tstep, kspan) : cB;
        for (int t = 0; t < nt; t += 2) {
            const bool last = (t == nt - 2);
            const char* a1 = cA + (size_t)(t + 1) * kstep;
            const char* a2 = last ? nA : cA + (size_t)(t + 2) * kstep; const char* b2 = last ? nB : cB + (size_t)(t + 2) * kstep;
            const char* a3 = a2 + kstep; const char* b3 = b2 + kstep;
            if (last && has_next) S.a_ready(nxt);
            PG8_LDB(B0, 0, 0); PG8_LDB(B1, 0, 1); PG8_SCHED; PG8_LDA(At, 0, 0); PG8_STAGE(PG8_SA(1, 1), a1 + hstep, voffA);
            PG8_WAIT_V(8); PG8_WAIT_L(0); PG8_BAR; PG8_MMA(0, 0, At, B0); if constexpr (!Epi::HALF_ALL) PG8_MMA(0, 1, At, B1); PG8_BAR; PG8_SCHED;
            PG8_LDA(At, 0, 1); PG8_STAGE(PG8_SB(0, 0), b2, voffB); PG8_STAGE(PG8_SB(0, 1), b2 + hstep, voffB); PG8_STAGE(PG8_SA(0, 0), a2, voffA);
            PG8_WAIT_V(8); PG8_WAIT_L(0); PG8_BAR; PG8_MMA(1, 0, At, B0); if constexpr (!Epi::HALF_ALL) PG8_MMA(1, 1, At, B1); PG8_BAR; PG8_SCHED;
            PG8_LDB(B0, 1, 0); PG8_LDB(B1, 1, 1); PG8_SCHED; PG8_LDA(At, 1, 0); PG8_STAGE(PG8_SA(0, 1), a2 + hstep, voffA);
            PG8_WAIT_V(8); PG8_WAIT_L(0); PG8_BAR; PG8_MMA(0, 0, At, B0); if constexpr (!Epi::HALF_ALL) PG8_MMA(0, 1, At, B1); PG8_BAR; PG8_SCHED;
            PG8_LDA(At, 1, 1); PG8_STAGE(PG8_SB(1, 0), b3, voffB); PG8_STAGE(PG8_SB(1, 1), b3 + hstep, voffB); PG8_STAGE(PG8_SA(1, 0), a3, voffA);
            PG8_WAIT_V(8); PG8_WAIT_L(0); PG8_BAR; PG8_MMA(1, 0, At, B0); if constexpr (!Epi::HALF_ALL) PG8_MMA(1, 1, At, B1); PG8_BAR; PG8_SCHED;
        }
        if (wr == 0) PG8_BAR;
        E(acc, cur, wr, wc, fr, fq);
        if (!has_next) break;
#pragma unroll
        for (int a = 0; a < 2; ++a)
#pragma unroll
            for (int b = 0; b < 2; ++b)
#pragma unroll
                for (int m = 0; m < 4; ++m)
#pragma unroll
                    for (int n = 0; n < 2; ++n) acc[a][b][m][n] = (f32x4){0.f, 0.f, 0.f, 0.f};
        cur = nxt; cA = nA; cB = nB; ++ui;
        if (wr == 1) PG8_BAR;
    }
    PG8_WAIT_V(0);
    PG8_BAR;
#undef PG8_SA
#undef PG8_SB
#undef PG8_STAGE
#undef PG8_LDA
#undef PG8_LDB
#undef PG8_MMA
#undef PG8_WAIT_V
#undef PG8_WAIT_L
#undef PG8_BAR
#undef PG8_SCHED
}
}

__device__ __forceinline__ void rs_panel(const float* SSQP, int pm, LAS float* rsl, volatile LAS int* tag, int tid, float* rsg = nullptr) {
    if (*tag == pm) return;
    const int row = tid >> 1, h = tid & 1; const float* p = SSQP + (size_t)(h * 32) * M + pm * 256 + row; float s = 0.f;
#pragma unroll 8
    for (int j = 0; j < 32; ++j) s += p[(size_t)j * M];
    s += DPPF(s, 0xB1);
    __syncthreads();
    if (h == 0) { const float rv = 1.f / sqrtf(s * (1.f / DM) + EPS); rsl[row] = rv; if (rsg) rsg[pm * 256 + row] = rv; }
    if (tid == 0) *tag = pm;
    __syncthreads();
}
struct EpiResidBf {
    static constexpr bool PERM = true; static constexpr bool HALF_ALL = false;
    bf16_t* XR; float* SSQP;
    __device__ __forceinline__ void operator()(const f32x4 (&acc)[2][2][4][2], const pg8::Unit& u, int wr, int wc, int fr, int fq) const {
        const int row0 = u.pm * 256 + wr * 64 + fr, col0 = u.pn * 256 + wc * 32 + 8 * fq;
        u32x4 xr[2][4][2];
#pragma unroll
        for (int ai = 0; ai < 2; ++ai)
#pragma unroll
            for (int m = 0; m < 4; ++m)
#pragma unroll
                for (int bj = 0; bj < 2; ++bj) xr[ai][m][bj] = *(const u32x4*)(XR + tiled_off((size_t)(row0 + ai * 128 + m * 16), col0, DM) + (size_t)bj * 2 * 256 * 64);
#pragma unroll
        for (int ai = 0; ai < 2; ++ai) {
            float ssv[4];
#pragma unroll
            for (int m = 0; m < 4; ++m) { bf16_t* rowp = XR + tiled_off((size_t)(row0 + ai * 128 + m * 16), col0, DM); float ss = 0.f;
#pragma unroll
                for (int bj = 0; bj < 2; ++bj) { const u32x4 x = xr[ai][m][bj];
                    const f32x4 a0 = acc[ai][bj][m][0], a1 = acc[ai][bj][m][1];
                    u32x4 o; o.x = cvt_pk_bf16(bf_lo(x.x) + a0[0], bf_hi(x.x) + a0[1]); o.y = cvt_pk_bf16(bf_lo(x.y) + a0[2], bf_hi(x.y) + a0[3]);
                    o.z = cvt_pk_bf16(bf_lo(x.z) + a1[0], bf_hi(x.z) + a1[1]); o.w = cvt_pk_bf16(bf_lo(x.w) + a1[2], bf_hi(x.w) + a1[3]);
                    *(u32x4*)(rowp + (size_t)bj * 2 * 256 * 64) = o;
                    ss += bf_lo(o.x) * bf_lo(o.x) + bf_hi(o.x) * bf_hi(o.x) + bf_lo(o.y) * bf_lo(o.y) + bf_hi(o.y) * bf_hi(o.y)
                        + bf_lo(o.z) * bf_lo(o.z) + bf_hi(o.z) * bf_hi(o.z) + bf_lo(o.w) * bf_lo(o.w) + bf_hi(o.w) * bf_hi(o.w); }
                ssv[m] = xrow16_sum(ss); }
            if (fq == 0) {
#pragma unroll
                for (int m = 0; m < 4; ++m) SSQP[(size_t)(u.pn * 4 + wc) * M + row0 + ai * 128 + m * 16] = ssv[m]; }
        }
    }
};
struct EpiFinal {
    static constexpr bool PERM = true; static constexpr bool HALF_ALL = false;
    const bf16_t* XR; float* out;
    __device__ __forceinline__ void operator()(const f32x4 (&acc)[2][2][4][2], const pg8::Unit& u, int wr, int wc, int fr, int fq) const {
        const int row0 = u.pm * 256 + wr * 64 + fr, col0 = u.pn * 256 + wc * 32 + 8 * fq;
        u32x4 xr[2][4][2];
#pragma unroll
        for (int ai = 0; ai < 2; ++ai)
#pragma unroll
          for (int m = 0; m < 4; ++m)
#pragma unroll
              for (int bj = 0; bj < 2; ++bj) xr[ai][m][bj] = *(const u32x4*)(XR + tiled_off((size_t)(row0 + ai * 128 + m * 16), col0, DM) + (size_t)bj * 2 * 256 * 64);
#pragma unroll
        for (int ai = 0; ai < 2; ++ai) {
#pragma unroll
            for (int m = 0; m < 4; ++m) { const int row = row0 + ai * 128 + m * 16; float* op = out + (size_t)row * DM + col0;
#pragma unroll
                for (int bj = 0; bj < 2; ++bj) { const u32x4 x = xr[ai][m][bj];
                    const f32x4 a0 = acc[ai][bj][m][0], a1 = acc[ai][bj][m][1];
                    *(f32x4*)(op + bj * 128) = (f32x4){bf_lo(x.x) + a0[0], bf_hi(x.x) + a0[1], bf_lo(x.y) + a0[2], bf_hi(x.y) + a0[3]};
                    *(f32x4*)(op + bj * 128 + 4) = (f32x4){bf_lo(x.z) + a1[0], bf_hi(x.z) + a1[1], bf_lo(x.w) + a1[2], bf_hi(x.w) + a1[3]}; } }
        }
    }
};
struct EpiRelu2 {
    static constexpr bool PERM = true; static constexpr bool HALF_ALL = false;
    bf16_t* O; const float* SSQP; LAS float* rsl; volatile LAS int* tag;
    __device__ __forceinline__ void operator()(const f32x4 (&acc)[2][2][4][2], const pg8::Unit& u, int wr, int wc, int fr, int fq) const {
        const int row0 = u.pm * 256 + wr * 64 + fr, col0 = u.pn * 256 + wc * 32 + 8 * fq;
        rs_panel(SSQP, u.pm, rsl, tag, (wr * 4 + wc) * 64 + fq * 16 + fr);
        float rsv[8];
#pragma unroll
        for (int q = 0; q < 8; ++q) rsv[q] = rsl[wr * 64 + fr + (q >> 2) * 128 + (q & 3) * 16];
#pragma unroll
        for (int ai = 0; ai < 2; ++ai)
#pragma unroll
            for (int m = 0; m < 4; ++m) { bf16_t* rowp = O + tiled_off((size_t)(row0 + ai * 128 + m * 16), col0, FF);
#pragma unroll
                for (int bj = 0; bj < 2; ++bj) { const float rs = rsv[ai * 4 + m]; f32x4 v0 = acc[ai][bj][m][0] * rs, v1 = acc[ai][bj][m][1] * rs;
#pragma unroll
                    for (int j = 0; j < 4; ++j) { const float a = fmaxf(v0[j], 0.f), b = fmaxf(v1[j], 0.f); v0[j] = a * a; v1[j] = b * b; }
                    u32x4 o; o.x = cvt_pk_bf16(v0[0], v0[1]); o.y = cvt_pk_bf16(v0[2], v0[3]); o.z = cvt_pk_bf16(v1[0], v1[1]); o.w = cvt_pk_bf16(v1[2], v1[3]);
                    *(u32x4*)(rowp + (size_t)bj * 2 * 256 * 64) = o; } }
    }
};
struct EpiOddPart {
    static constexpr bool PERM = true; static constexpr bool HALF_ALL = true;
    float* ODDP;
    __device__ __forceinline__ void operator()(const f32x4 (&acc)[2][2][4][2], const pg8::Unit& u, int wr, int wc, int fr, int fq) const {
        const int row0 = u.pm * 256 + wr * 64 + fr, c0 = wc * 32 + 8 * fq;
        if (c0 >= 96) return;
#pragma unroll
        for (int ai = 0; ai < 2; ++ai)
#pragma unroll
            for (int m = 0; m < 4; ++m) { float* p = ODDP + ((size_t)u.pn * M + row0 + ai * 128 + m * 16) * 128 + c0; *(f32x4*)p = acc[ai][0][m][0]; *(f32x4*)(p + 4) = acc[ai][0][m][1]; }
    }
};
struct EpiInProj {
    static constexpr bool PERM = true; static constexpr bool HALF_ALL = false;
    bf16_t* PROJ; float* GLOG; float* ODD; const float* lb; const float* gbias; const float* SSQP;
    const float* gcqk; const float* gdqk; LAS float* xch; LAS float* rsl; volatile LAS int* tag; float* RSG;
    __device__ __forceinline__ void operator()(const f32x4 (&acc)[2][2][4][2], const pg8::Unit& u, int wr, int wc, int fr, int fq) const {
        const int row0 = u.pm * 256 + wr * 64 + fr; const int pn = u.pn;
        const int seg = pn >> 2;
        rs_panel(SSQP, u.pm, rsl, tag, (wr * 4 + wc) * 64 + fq * 16 + fr, RSG);
        float rsv[8];
#pragma unroll
        for (int q = 0; q < 8; ++q) rsv[q] = rsl[wr * 64 + fr + (q >> 2) * 128 + (q & 3) * 16];
        int kind = 0;
        if (pn >= 56) kind = 6; else if (seg == 0) kind = 1; else if (seg == 1) kind = 5; else if (seg == 3) kind = 2; else if (seg == 6) kind = 3; else if (seg == 13) kind = 4; else if (seg == 7 || seg == 8 || seg == 10 || seg == 11) kind = 7;
        if (kind == 6) {
            const int c0 = wc * 32 + 8 * fq;
            if (c0 >= 96) return;
#pragma unroll
            for (int ai = 0; ai < 2; ++ai)
#pragma unroll
                for (int m = 0; m < 4; ++m) { float* rowp = ODD + (size_t)(row0 + ai * 128 + m * 16) * LDO + c0;
                    const float rs = rsv[ai * 4 + m]; f32x4 v0 = acc[ai][0][m][0] * rs, v1 = acc[ai][0][m][1] * rs;
                    if (c0 >= 64 && c0 < 80) { v0 = v0 * 0.25f; v1 = v1 * 0.25f; }
                    else if (c0 == 80) {
#pragma unroll
                        for (int j = 0; j < 4; ++j) { v0[j] += gbias[j]; v1[j] += gbias[4 + j]; } }
                    else if (c0 == 88) {
#pragma unroll
                        for (int j = 0; j < 4; ++j) { const float a = v0[j] + gbias[8 + j], b = v1[j] + gbias[12 + j];
                            v0[j] = fminf(a, 0.f) - __logf(1.f + __expf(-fabsf(a))); v1[j] = fminf(b, 0.f) - __logf(1.f + __expf(-fabsf(b))); } }
                    *(f32x4*)rowp = v0; *(f32x4*)(rowp + 4) = v1; }
            return;
        }
        const int col0 = pn * 256 + wc * 32 + 8 * fq;
        if (kind == 7) {
            const float* gp = ((seg < 9) ? gcqk : gdqk) + ((seg == 8 || seg == 11) ? 128 : 0) + wc * 32 + 8 * fq;
            const f32x4 g0 = *(const f32x4*)gp, g1 = *(const f32x4*)(gp + 4);
            float ssv[16];
#pragma unroll
            for (int ai = 0; ai < 2; ++ai)
#pragma unroll
                for (int m = 0; m < 4; ++m)
#pragma unroll
                    for (int bj = 0; bj < 2; ++bj) { const f32x4 a0 = acc[ai][bj][m][0], a1 = acc[ai][bj][m][1];
                        const float ss = (a0[0] * a0[0] + a0[1] * a0[1]) + (a0[2] * a0[2] + a0[3] * a0[3]) + (a1[0] * a1[0] + a1[1] * a1[1]) + (a1[2] * a1[2] + a1[3] * a1[3]);
                        ssv[(ai * 4 + m) * 2 + bj] = xrow16_sum(ss); }
            if (fq == 0) {
#pragma unroll
                for (int q = 0; q < 16; ++q) xch[((((q >> 3) * 128 + wr * 64 + ((q >> 1) & 3) * 16 + fr) * 2 + (q & 1)) * 4) + wc] = ssv[q];
            }
            __syncthreads();
#pragma unroll
            for (int ai = 0; ai < 2; ++ai)
#pragma unroll
                for (int m = 0; m < 4; ++m) { bf16_t* rowp = PROJ + (size_t)(row0 + ai * 128 + m * 16) * LDP + col0; const float rs = rsv[ai * 4 + m];
#pragma unroll
                    for (int bj = 0; bj < 2; ++bj) { const f32x4 pq = *(const LAS f32x4*)(xch + ((ai * 128 + wr * 64 + m * 16 + fr) * 2 + bj) * 4);
                        const float rn = rs * __builtin_amdgcn_rsqf(rs * rs * ((pq[0] + pq[1]) + (pq[2] + pq[3])) * (1.f / 128.f) + EPS);
                        const f32x4 v0 = acc[ai][bj][m][0] * rn * g0, v1 = acc[ai][bj][m][1] * rn * g1;
                        u32x4 o; o.x = cvt_pk_bf16(v0[0], v0[1]); o.y = cvt_pk_bf16(v0[2], v0[3]); o.z = cvt_pk_bf16(v1[0], v1[1]); o.w = cvt_pk_bf16(v1[2], v1[3]);
                        *(u32x4*)(rowp + bj * 128) = o; } }
            return;
        }
        if (kind == 5) {
            const int lc = col0 - C_AF;
            f32x4 l0[2], l1[2];
#pragma unroll
            for (int bj = 0; bj < 2; ++bj) { l0[bj] = *(const f32x4*)(lb + lc + bj * 128); l1[bj] = *(const f32x4*)(lb + lc + bj * 128 + 4); }
#pragma unroll
            for (int ai = 0; ai < 2; ++ai)
#pragma unroll
                for (int m = 0; m < 4; ++m) { float* rowp = GLOG + (size_t)(row0 + ai * 128 + m * 16) * 1024 + lc;
#pragma unroll
                    for (int bj = 0; bj < 2; ++bj) { const float rs = rsv[ai * 4 + m]; f32x4 v0 = acc[ai][bj][m][0] * rs, v1 = acc[ai][bj][m][1] * rs;
#pragma unroll
                        for (int j = 0; j < 4; ++j) { const float fa = l0[bj][j] + (1.f - l0[bj][j]) * fast_sigmoid(v0[j]), fb = l1[bj][j] + (1.f - l1[bj][j]) * fast_sigmoid(v1[j]);
                            v0[j] = __logf(fmaxf(fa, 1e-20f)); v1[j] = __logf(fmaxf(fb, 1e-20f)); }
                        *(f32x4*)(rowp + bj * 128) = v0; *(f32x4*)(rowp + bj * 128 + 4) = v1; } }
            return;
        }
#pragma unroll
        for (int ai = 0; ai < 2; ++ai)
#pragma unroll
            for (int m = 0; m < 4; ++m) { bf16_t* rowp = PROJ + (size_t)(row0 + ai * 128 + m * 16) * LDP + col0;
#pragma unroll
                for (int bj = 0; bj < 2; ++bj) { const float rs = rsv[ai * 4 + m]; f32x4 v0 = acc[ai][bj][m][0] * rs, v1 = acc[ai][bj][m][1] * rs;
                    if (kind == 1) {
#pragma unroll
                        for (int j = 0; j < 4; ++j) { v0[j] = fast_silu(v0[j]) * 0.08838834764831845f; v1[j] = fast_silu(v1[j]) * 0.08838834764831845f; } }
                    else if (kind == 2) {
#pragma unroll
                        for (int j = 0; j < 4; ++j) { v0[j] = fast_silu(v0[j]); v1[j] = fast_silu(v1[j]); } }
                    else if (kind == 3) {
#pragma unroll
                        for (int j = 0; j < 4; ++j) { v0[j] = fast_sigmoid(v0[j]); v1[j] = fast_sigmoid(v1[j]); } }
                    else if (kind == 4) { v0 = v0 * 0.015625f; v1 = v1 * 0.015625f; }
                    u32x4 o; o.x = cvt_pk_bf16(v0[0], v0[1]); o.y = cvt_pk_bf16(v0[2], v0[3]); o.z = cvt_pk_bf16(v1[0], v1[1]); o.w = cvt_pk_bf16(v1[2], v1[3]);
                    *(u32x4*)(rowp + bj * 128) = o; } }
    }
};


namespace att {
constexpr int D = 128, NW = 8, QBLK = 32, KVBLK = 64, QB = NW * QBLK;
constexpr int SHM_V = KVBLK * D * 2, SHM_K = KVBLK * D * 2;
constexpr int ATT_LDS = 2 * SHM_V + 2 * SHM_K + NW * 64 * 4;
constexpr float SCALE = 0.08838834764831845f, THR = 8.f;
#define KSWZ(row, colB) ((row) * 256 + ((colB) ^ (((row) & 7) << 4)))
#define SBAR() __builtin_amdgcn_sched_barrier(0)
__device__ __forceinline__ int v_st(int k, int c) { const int kk = (k & ~0xC) | ((k & 4) << 1) | ((k & 8) >> 1); return ((kk >> 3) * 4 + (c >> 5)) * 512 + ((kk & 7) * 32 + (c & 31)) * 2; }
__device__ __forceinline__ int v_rd_base(int lane) { return ((lane & 3) << 3) | (((lane >> 2) & 3) << 6) | (((lane >> 4) & 1) << 5) | (((lane >> 5) & 1) << 8); }
constexpr int v_rd_off(int d0, int ks, int half) { return d0 * 512 + ks * 4096 + half * 2048; }
__device__ __forceinline__ int crow(int r, int hi) { return (r & 3) + 8 * (r >> 2) + 4 * hi; }
__device__ __forceinline__ bf16x8 ld8(const bf16_t* p) { return *reinterpret_cast<const bf16x8*>(p); }
__device__ __forceinline__ void partialSM(f32x16& p0, f32x16& p1, float& m_reg, float& mn, float& alpha) {
    float pmax = p0[0];
#pragma unroll
    for (int r = 1; r < 16; ++r) pmax = fmaxf(pmax, p0[r]);
#pragma unroll
    for (int r = 0; r < 16; ++r) pmax = fmaxf(pmax, p1[r]);
    { auto rr = __builtin_amdgcn_permlane32_swap(__float_as_uint(pmax), __float_as_uint(pmax), false, false);
      pmax = fmaxf(__uint_as_float(rr[0]), __uint_as_float(rr[1])); }
    constexpr float C2 = 1.4426950408889634f * SCALE;
    if (__builtin_expect(__all((pmax - m_reg) * SCALE <= THR), 1)) { mn = m_reg; alpha = 1.f; }
    else { mn = fmaxf(m_reg, pmax); alpha = __builtin_amdgcn_exp2f((m_reg - mn) * C2); m_reg = mn; }
    const float mnL = -mn * C2;
#pragma unroll
    for (int r = 0; r < 16; ++r) p0[r] = fmaf(p0[r], C2, mnL);
#pragma unroll
    for (int r = 0; r < 16; ++r) p1[r] = fmaf(p1[r], C2, mnL);
#pragma unroll
    for (int r = 0; r < 16; ++r) p0[r] = __builtin_amdgcn_exp2f(p0[r]);
}
__device__ __forceinline__ void finishSM(f32x16& p0, f32x16& p1, float alpha, float& l_reg, bf16x8& pa0, bf16x8& pa1, bf16x8& pa2, bf16x8& pa3) {
#pragma unroll
    for (int r = 0; r < 16; ++r) p1[r] = __builtin_amdgcn_exp2f(p1[r]);
    float ps = 0;
#pragma unroll
    for (int r = 0; r < 16; ++r) ps += p0[r];
#pragma unroll
    for (int r = 0; r < 16; ++r) ps += p1[r];
    { auto rr = __builtin_amdgcn_permlane32_swap(__float_as_uint(ps), __float_as_uint(ps), false, false);
      ps = __uint_as_float(rr[0]) + __uint_as_float(rr[1]); }
    l_reg = l_reg * alpha + ps;
#define PK4(P, B_, OUT) do { unsigned a0 = cvt_pk_bf16(P[B_+0], P[B_+1]), a1 = cvt_pk_bf16(P[B_+2], P[B_+3]);                          \
        unsigned b0 = cvt_pk_bf16(P[B_+4], P[B_+5]), b1 = cvt_pk_bf16(P[B_+6], P[B_+7]);                                             \
        auto r0 = __builtin_amdgcn_permlane32_swap(a0, b0, false, false); auto r1 = __builtin_amdgcn_permlane32_swap(a1, b1, false, false); \
        u32x4 w = {r0[0], r1[0], r0[1], r1[1]}; OUT = *reinterpret_cast<bf16x8*>(&w); } while (0)
    PK4(p0, 0, pa0); PK4(p0, 8, pa1); PK4(p1, 0, pa2); PK4(p1, 8, pa3);
#undef PK4
}
template <int KB>
__device__ __forceinline__ void qkt(f32x16& p0, f32x16& p1, const char* K_lds, int r32, int hi, const bf16x8* qr) {
    p0 = f32x16{}; p1 = f32x16{};
    const char* kb[4];
#pragma unroll
    for (int dd = 0; dd < 4; ++dd) kb[dd] = K_lds + KB * SHM_K + KSWZ(r32, (dd * 16 + hi * 8) * 2);
#pragma unroll
    for (int d0 = 0; d0 < 8; ++d0) { const char* a = kb[d0 & 3] + (d0 >> 2) * 128;
        bf16x8 b0 = *reinterpret_cast<const bf16x8*>(a);
        bf16x8 b1 = *reinterpret_cast<const bf16x8*>(a + 32 * 256);
        p0 = __builtin_amdgcn_mfma_f32_32x32x16_bf16(b0, qr[d0], p0, 0, 0, 0);
        p1 = __builtin_amdgcn_mfma_f32_32x32x16_bf16(b1, qr[d0], p1, 0, 0, 0); }
}
template <int VB>
__device__ __forceinline__ void pv_tile(f32x16* o, int vb0, bf16x8 pa0, bf16x8 pa1, bf16x8 pa2, bf16x8 pa3) {
#define TRRD(dst, off) asm volatile("ds_read_b64_tr_b16 %0, %1 offset:%2" : "=&v"(dst) : "v"(vb0), "i"(off) : "memory")
#define PV_D0(d0) do { s16x4 l0, l1, l2, l3, h0, h1, h2, h3; constexpr int b_ = VB * SHM_V + v_rd_off(d0, 0, 0); \
        TRRD(l0, b_); TRRD(h0, b_ + 2048); TRRD(l1, b_ + 4096); TRRD(h1, b_ + 6144); TRRD(l2, b_ + 8192); TRRD(h2, b_ + 10240); TRRD(l3, b_ + 12288); TRRD(h3, b_ + 14336); \
        asm volatile("s_waitcnt lgkmcnt(0)" ::: "memory"); SBAR();   \
        o[d0] = __builtin_amdgcn_mfma_f32_32x32x16_bf16(pa0, (bf16x8){l0[0], l0[1], l0[2], l0[3], h0[0], h0[1], h0[2], h0[3]}, o[d0], 0, 0, 0);   \
        o[d0] = __builtin_amdgcn_mfma_f32_32x32x16_bf16(pa1, (bf16x8){l1[0], l1[1], l1[2], l1[3], h1[0], h1[1], h1[2], h1[3]}, o[d0], 0, 0, 0);   \
        o[d0] = __builtin_amdgcn_mfma_f32_32x32x16_bf16(pa2, (bf16x8){l2[0], l2[1], l2[2], l2[3], h2[0], h2[1], h2[2], h2[3]}, o[d0], 0, 0, 0);   \
        o[d0] = __builtin_amdgcn_mfma_f32_32x32x16_bf16(pa3, (bf16x8){l3[0], l3[1], l3[2], l3[3], h3[0], h3[1], h3[2], h3[3]}, o[d0], 0, 0, 0); } while (0)
    PV_D0(0); PV_D0(1); PV_D0(2); PV_D0(3);
#undef PV_D0
#undef TRRD
}
template <class TOut> struct BlockRef { const bf16_t* Q; const bf16_t* K; const bf16_t* V; TOut* O; const unsigned* MK; int P0; int orow, ocol; };
struct Seam { bf16x8 qr[8]; bf16x8 st_v0, st_v1, st_k0, st_k1; };
#define ROW(p, k0, rr) ((p) + (size_t)((k0) + (rr)) * LDP + sc)
#define VMW() asm volatile("s_waitcnt vmcnt(0)" ::: "memory")
#define VMWN(n) asm volatile("s_waitcnt vmcnt(%0)" :: "i"(n) : "memory")
#define SLOAD_H(Kp, Vp, k0) do { S.st_v0 = ld8(ROW(Vp, k0, sr)); S.st_v1 = ld8(ROW(Vp, k0, 32 + sr)); S.st_k0 = ld8(ROW(Kp, k0, sr)); S.st_k1 = ld8(ROW(Kp, k0, 32 + sr)); } while (0)
#define SWRITE_HK(bf) do { *(bf16x8*)(K_lds + (bf) * SHM_K + kws) = S.st_k0; *(bf16x8*)(K_lds + (bf) * SHM_K + kws + 32 * 256) = S.st_k1; } while (0)
#define SWRITE_HV(bf) do { *(bf16x8*)(V_lds + (bf) * SHM_V + vst0) = S.st_v0; *(bf16x8*)(V_lds + (bf) * SHM_V + vst1) = S.st_v1; } while (0)
#define SWRITE_H(bf) do { SWRITE_HV(bf); SWRITE_HK(bf); } while (0)
template <class TOut>
__device__ __forceinline__ void attn_prime(const BlockRef<TOut>& cur, char* lds, Seam& S) {
    const int tid_ = my_tid();
    const int tid = tid_, wid = __builtin_amdgcn_readfirstlane(tid >> 6), lane = tid & 63, r32 = lane & 31, hi = lane >> 5;
    const int sr = tid >> 4, sc = (tid & 15) * 8, kws = KSWZ(sr, sc * 2); char* K_lds = lds + 2 * SHM_V;
#pragma unroll
    for (int d0 = 0; d0 < 8; ++d0) S.qr[d0] = ld8(cur.Q + (size_t)(wid * QBLK + r32) * LDP + d0 * 16 + hi * 8);
    SLOAD_H(cur.K, cur.V, 0); VMW(); SWRITE_HK(0);
    __syncthreads();
}
template <class TOut, bool BM, int OS>
__device__ __forceinline__ void attn_block(const BlockRef<TOut>& cur, const BlockRef<TOut>& nxt, char* lds, Seam& S) {
    const int tid_ = my_tid();
    const int tid = tid_, wid = __builtin_amdgcn_readfirstlane(tid >> 6), lane = tid & 63, r32 = lane & 31, hi = lane >> 5;
    const int NT = (cur.P0 + QB - 1) / KVBLK + 1;
    const int qlo = cur.P0 + wid * QBLK;
    const int klim = (qlo & ~63) + 64;
    char* V_lds = lds; char* K_lds = lds + 2 * SHM_V;
    float* wsl = (float*)(lds + 2 * SHM_V + 2 * SHM_K) + wid * 64; float* li_l = wsl, * al_l = wsl + 32;
    float m_reg = -1e30f, l_reg = 0; f32x16 o[4] = {};
    const int sr = tid >> 4, sc = (tid & 15) * 8, vst0 = v_st(sr, sc), vst1 = v_st(32 + sr, sc), kws = KSWZ(sr, sc * 2);
    const int vb0 = (int)(uintptr_t)V_lds + v_rd_base(lane);
    const bf16_t* Kh = cur.K; const bf16_t* Vh = cur.V;
    const unsigned moff = (unsigned)(qlo + r32) * 4u;
    unsigned mw0 = 0, mw1 = 0;
#define RESC(a) do { if (__any((a) < 1.f)) { if (hi == 0) al_l[r32] = (a); asm volatile("s_waitcnt lgkmcnt(0)" ::: "memory");              \
                     _Pragma("unroll") for (int d_ = 0; d_ < 4; ++d_) _Pragma("unroll") for (int r = 0; r < 16; ++r) o[d_][r] *= al_l[crow(r, hi)]; } } while (0)
#define KBASE(t) ((t) * KVBLK)
#define MLOAD(t) do { if (BM) { const char* mb_ = (const char*)cur.MK + (size_t)(2 * (t)) * (T * 4); mw0 = *(const unsigned*)(mb_ + (size_t)moff); mw1 = *(const unsigned*)(mb_ + (size_t)(T * 4) + (size_t)moff); } } while (0)
#define MASKT(P0_, P1_, t) do { const float NEGI = -__builtin_inff(); \
        if (KBASE(t) >= klim) { _Pragma("unroll") for (int r = 0; r < 16; ++r) { P0_[r] = NEGI; P1_[r] = NEGI; } } \
        else if (BM) { const unsigned a_ = mw0 >> (4 * hi), b_ = mw1 >> (4 * hi); \
            _Pragma("unroll") for (int r = 0; r < 16; ++r) { const int cb = (r & 3) + 8 * (r >> 2); \
                const unsigned ma_ = (unsigned)__builtin_amdgcn_sbfe((int)a_, cb, 1), mb_ = (unsigned)__builtin_amdgcn_sbfe((int)b_, cb, 1);     \
                P0_[r] = __uint_as_float((__float_as_uint(P0_[r]) & ma_) | (0xFF800000u & ~ma_)); P1_[r] = __uint_as_float((__float_as_uint(P1_[r]) & mb_) | (0xFF800000u & ~mb_)); } } } while (0)
#define SEAM_K0() do { VMWN(8); SWRITE_HK(0); SBAR(); } while (0)
    f32x16 pA0, pA1, pB0, pB1; float mnA, mnB, alA, alB; bf16x8 pa0, pa1, pa2, pa3;
    SWRITE_HV(0); SBAR();
    MLOAD(0);
    if (NT > 1) { SLOAD_H(Kh, Vh, KBASE(1)); }
    SBAR(); qkt<0>(pA0, pA1, K_lds, r32, hi, S.qr);
    if (BM) VMW();
    MASKT(pA0, pA1, 0); partialSM(pA0, pA1, m_reg, mnA, alA);
    if (NT > 1) { VMW(); SWRITE_H(1); }
    __syncthreads();
#define HALF_STEP(PX0, PX1, mnX, alX, PY0, PY1, alY, t, KB, VB, SB) do {                                                      \
        MLOAD(t);                                                                                                             \
        SBAR(); qkt<KB>(PX0, PX1, K_lds, r32, hi, S.qr);                                                                      \
        finishSM(PY0, PY1, alY, l_reg, pa0, pa1, pa2, pa3); SBAR();                                                           \
        if ((t) + 1 < NT) { SLOAD_H(Kh, Vh, KBASE((t) + 1)); SBAR(); }                                                        \
        pv_tile<VB>(o, vb0, pa0, pa1, pa2, pa3);                                                                              \
        if (BM) { if ((t) + 1 < NT) VMWN(4); else VMW(); }                                                                    \
        MASKT(PX0, PX1, (t)); partialSM(PX0, PX1, m_reg, mnX, alX);                                                           \
        __syncthreads();                                                                                                      \
        if ((t) + 1 < NT) { VMW(); SWRITE_H(SB); }                                                                            \
        RESC(alX); __syncthreads(); } while (0)
    for (int t = 1; t + 1 < NT; t += 2) {
        HALF_STEP(pB0, pB1, mnB, alB, pA0, pA1, alA, t, 1, 0, 0);
        HALF_STEP(pA0, pA1, mnA, alA, pB0, pB1, alB, t + 1, 0, 1, 1);
    }
    const bool even = (NT & 1) == 0;
    if (even) { MLOAD(NT - 1); SBAR(); qkt<1>(pB0, pB1, K_lds, r32, hi, S.qr); SBAR(); }
    SLOAD_H(nxt.K, nxt.V, 0); SBAR();
#pragma unroll
    for (int d0 = 0; d0 < 8; ++d0) S.qr[d0] = ld8(nxt.Q + (size_t)(wid * QBLK + r32) * LDP + d0 * 16 + hi * 8);
    SBAR();
    finishSM(pA0, pA1, alA, l_reg, pa0, pa1, pa2, pa3); SBAR();
    pv_tile<0>(o, vb0, pa0, pa1, pa2, pa3);
    if (even) { if (BM) VMWN(12); MASKT(pB0, pB1, NT - 1); partialSM(pB0, pB1, m_reg, mnB, alB); __syncthreads(); RESC(alB);
        finishSM(pB0, pB1, alB, l_reg, pa0, pa1, pa2, pa3); SBAR(); pv_tile<1>(o, vb0, pa0, pa1, pa2, pa3); }
    SBAR(); SEAM_K0();
    if (hi == 0) li_l[r32] = l_reg; asm volatile("s_waitcnt lgkmcnt(0)" ::: "memory");
    float rli[16];
#pragma unroll
    for (int r = 0; r < 16; ++r) rli[r] = __builtin_amdgcn_rcpf(li_l[crow(r, hi)]);
    TOut* obase_ = cur.O; asm volatile("" : "+s"(obase_));
    TOut* Ow = obase_ + (size_t)(wid * QBLK) * OS;
#pragma unroll
    for (int r = 0; r < 16; ++r) { const int orow = crow(r, hi);
#pragma unroll
        for (int d0 = 0; d0 < 4; ++d0) { const float v = o[d0][r] * rli[r];
            if constexpr (sizeof(TOut) == 4) { Ow[(size_t)orow * OS + d0 * 32 + r32] = v; }
            else { const float vn = sx(v, 1, lane);
                   if ((r32 & 1) == 0) *(unsigned*)(obase_ + tiled_off((size_t)(cur.orow + wid * QBLK + orow), cur.ocol + d0 * 32 + r32, OS)) = cvt_pk_bf16(v, vn); } } }
    __syncthreads();
#undef RESC
#undef KBASE
#undef MLOAD
#undef MASKT
#undef SEAM_K0
#undef HALF_STEP
}
#undef ROW
#undef VMW
#undef VMWN
#undef SLOAD_H
#undef SWRITE_HK
#undef SWRITE_HV
#undef SWRITE_H
}

#define XB_TMO      128
#define XB_XCNT(j)  (256  + 64 * (j))
#define XB_XSUB(j)  (1280 + 64 * (j))
#define XB_XGEN(j)  (2304 + 64 * (j))
#define XB_TOP      3328
#define XB_TOPGEN   3392
#define XCD_BAR_WORDS 3456
#define XB_SPIN_CAP (1u << 22)
__device__ __forceinline__ unsigned xb_ld(unsigned* p)              { return __hip_atomic_load(p, __ATOMIC_RELAXED, __HIP_MEMORY_SCOPE_AGENT); }
__device__ __forceinline__ unsigned xb_add(unsigned* p, unsigned v) { return __hip_atomic_fetch_add(p, v, __ATOMIC_RELAXED, __HIP_MEMORY_SCOPE_AGENT); }
__device__ __forceinline__ unsigned xb_xcc_id() { return (unsigned)__builtin_amdgcn_s_getreg((3 << 11) | 20) & 0xFu; }
#define XB_SPIN(cond, bar) do { unsigned _sp = 0; while (cond) { __builtin_amdgcn_s_sleep(1); \
    if ((++_sp & 255u) == 0u) { if (xb_ld(&(bar)[XB_TMO])) break; if (_sp > XB_SPIN_CAP) { atomicAdd(&(bar)[XB_TMO], 1u); break; } } } } while (0)
struct XcdBarrier { unsigned* bar; unsigned x; volatile LAS unsigned* st; };
__device__ __forceinline__ XcdBarrier xcd_barrier_post(unsigned* bar, volatile LAS unsigned* st) {
    XcdBarrier b; b.bar = bar; b.x = xb_xcc_id(); b.st = st;
    if (my_tid() == 0) (void)xb_add(&bar[XB_XCNT(b.x)], 1u);
    return b;
}
__device__ __forceinline__ void xcd_barrier_complete(unsigned* bar, unsigned x, unsigned& nloc, unsigned& nx) {
    const unsigned G = gridDim.x * gridDim.y * gridDim.z;
    unsigned sum, cnt, mine, sp = 0u;
    for (;;) {
        sum = 0u; cnt = 0u; mine = 0u;
#pragma unroll
        for (unsigned j = 0; j < 16; ++j) { const unsigned c = xb_ld(&bar[XB_XCNT(j)]); sum += c; cnt += (c > 0u) ? 1u : 0u; mine = (j == x) ? c : mine; }
        if (sum == G) break;
        __builtin_amdgcn_s_sleep(1);
        if ((++sp & 255u) == 0u) { if (xb_ld(&bar[XB_TMO])) break; if (sp > XB_SPIN_CAP) { atomicAdd(&bar[XB_TMO], 1u); break; } }
    }
    nloc = mine > 0u ? mine : 1u; nx = cnt > 0u ? cnt : 1u;
}
__device__ __forceinline__ void xcd_barrier(const XcdBarrier& b) {
    asm volatile("s_waitcnt vmcnt(0)" ::: "memory");
    __syncthreads();
    if (my_tid() == 0) {
        unsigned* bar = b.bar;
        __builtin_amdgcn_s_waitcnt(0);
        unsigned nloc = b.st[0], nx = b.st[1];
        if (nloc == 0u) { xcd_barrier_complete(bar, b.x, nloc, nx); b.st[0] = nloc; b.st[1] = nx; }
        const unsigned old = xb_add(&bar[XB_XSUB(b.x)], 1u);
        const unsigned gen = old / nloc;
        if (old + 1u == (gen + 1u) * nloc) {
            __builtin_amdgcn_fence(__ATOMIC_RELEASE, "agent");
            asm volatile("s_waitcnt vmcnt(0)" ::: "memory");
            const unsigned og = xb_add(&bar[XB_TOP], 1u);
            const unsigned tg = og / nx;
            if (og + 1u == (tg + 1u) * nx) xb_add(&bar[XB_TOPGEN], 1u);
            else XB_SPIN(xb_ld(&bar[XB_TOPGEN]) == tg, bar);
            __builtin_amdgcn_fence(__ATOMIC_ACQUIRE, "agent");
            xb_add(&bar[XB_XGEN(b.x)], 1u);
            asm volatile("s_waitcnt vmcnt(0)" ::: "memory");
        } else {
            XB_SPIN(xb_ld(&bar[XB_XGEN(b.x)]) == gen, bar);
            __builtin_amdgcn_fence(__ATOMIC_ACQUIRE, "agent");
            asm volatile("s_waitcnt vmcnt(0)" ::: "memory");
        }
    }
    __syncthreads();
}

struct Args {
    const float* in[17]; float* out; unsigned char* ws; int ph_lo, ph_hi;
};
typedef const __attribute__((address_space(4))) Args KA;
#define PH_ARGS() ({ KA* p_ = (KA*)__builtin_amdgcn_kernarg_segment_ptr(); asm volatile("" : "+s"(p_)); p_; })
struct Frame {
    LAS unsigned char* lds; int tid, lane, wave, G, vcu;
};
__device__ __forceinline__ Frame make_frame(LAS unsigned char* lds) {
    Frame F; F.lds = lds; const int t = my_tid();
    F.tid = t; F.lane = t & 63; F.wave = __builtin_amdgcn_readfirstlane(t >> 6);
    F.G = gridDim.x; { const int bx = blockIdx.x; F.vcu = (F.G % 8 == 0) ? (bx % 8) * (F.G / 8) + bx / 8 : bx; }
    return F;
}
__device__ __forceinline__ float wave_sum(float v, int lane) {
    v = sum16(v); v += sx(v, 16, lane); v += sx(v, 32, lane);
    return v;
}
#define LDS_WAIT() asm volatile("s_waitcnt lgkmcnt(0)" ::: "memory")

__device__ __forceinline__ void p0_transpose_item(const float* W, int K, int N, bf16_t* WT, const float* gain, bool remap, LAS float* scr, int item, int lane) {
    const int nblk = N / 32, kb = item / nblk, nb = item % nblk, k0 = 128 * kb, n0 = 32 * nb;
    const int r = lane >> 3, c = lane & 7;
    f32x4 v[16];
#pragma unroll
    for (int i = 0; i < 16; ++i) v[i] = *(const f32x4*)(W + (size_t)(k0 + 8 * i + r) * N + n0 + 4 * c);
    if (gain) {
#pragma unroll
        for (int i = 0; i < 16; ++i) v[i] = v[i] * gain[k0 + 8 * i + r]; }
#pragma unroll
    for (int i = 0; i < 16; ++i) { const int k = 8 * i + r;
        scr[(4 * c + 0) * 132 + k] = v[i].x; scr[(4 * c + 1) * 132 + k] = v[i].y; scr[(4 * c + 2) * 132 + k] = v[i].z; scr[(4 * c + 3) * 132 + k] = v[i].w; }
    LDS_WAIT(); asm volatile("" ::: "memory");
    const int nl = lane >> 4, ck = lane & 15;
#pragma unroll
    for (int j = 0; j < 8; ++j) { const int n = 4 * j + nl; const f32x4 a = *(const LAS f32x4*)(scr + n * 132 + 8 * ck), b = *(const LAS f32x4*)(scr + n * 132 + 8 * ck + 4);
        u32x4 o; o.x = cvt_pk_bf16(a.x, a.y); o.y = cvt_pk_bf16(a.z, a.w); o.z = cvt_pk_bf16(b.x, b.y); o.w = cvt_pk_bf16(b.z, b.w);
        int nd = n0 + n;
        if (remap) { if (nd >= 7168) nd = (nd < 7184) ? nd + 7248 : nd - 16; }
        *(u32x4*)(WT + tiled_off((size_t)nd, k0 + 8 * ck, K)) = o; }
    LDS_WAIT(); asm volatile("" ::: "memory");
}
__device__ __forceinline__ void rownorm_row(const float* xrow, bf16_t* xb, float* SSQP, int m, int lane) {
    const f32x4* xr = (const f32x4*)xrow + lane;
    f32x4 v[16]; float s = 0.f;
#pragma unroll
    for (int j = 0; j < 16; ++j) { v[j] = xr[64 * j]; s += (v[j].x * v[j].x + v[j].y * v[j].y) + (v[j].z * v[j].z + v[j].w * v[j].w); }
    const float st = wave_sum(s, lane);
    SSQP[(size_t)lane * M + m] = lane == 0 ? st : 0.f;
#pragma unroll
    for (int j = 0; j < 16; ++j) { u32x2 o; o.x = cvt_pk_bf16(v[j].x, v[j].y); o.y = cvt_pk_bf16(v[j].z, v[j].w); *(u32x2*)(xb + tiled_off((size_t)m, 256 * j + 4 * lane, DM)) = o; }
}
__device__ __forceinline__ void rownorm_phase(const Frame& F, const float* x, bf16_t* xb, float* SSQP) {
    const int gw = F.vcu * 8 + F.wave, NGW = F.G * 8;
    for (int m = gw; m < M; m += NGW) rownorm_row(x + (size_t)m * DM, xb, SSQP, m, F.lane);
}
__device__ __forceinline__ void rs_reduce_phase(const Frame& F, const float* SSQP, float* RS) {
    const int gt = (F.vcu * 8 + F.wave) * 64 + F.lane, NGT = F.G * 512;
    for (int m = gt; m < M; m += NGT) { float s = 0.f;
#pragma unroll 8
        for (int j = 0; j < 64; ++j) s += SSQP[(size_t)j * M + m];
        RS[m] = 1.f / sqrtf(s * (1.f / DM) + EPS); }
}

constexpr int CONV_I_IN = (DM / 128) * (NIN / 32), CONV_I_O = (DM / 128) * (DM / 32), CONV_I_1 = (DM / 128) * (FF / 32), CONV_I_2 = (FF / 128) * (DM / 32);
constexpr int CONV_PER_L = CONV_I_IN + CONV_I_O + CONV_I_1 + CONV_I_2;
__device__ __forceinline__ void conv_item(KA* ap, int l, int r, LAS float* scr, int lane) {
    unsigned char* ws = ap->ws;
    if (r < CONV_I_IN) { p0_transpose_item(ap->in[2] + (size_t)l * DM * NIN, DM, NIN, (bf16_t*)(ws + WS_WIN + l * SZ_WIN), ap->in[1] + l * DM, true, scr, r, lane); return; } r -= CONV_I_IN;
    if (r < CONV_I_O) { p0_transpose_item(ap->in[13] + (size_t)l * DM * DM, DM, DM, (bf16_t*)(ws + WS_WOUT + l * SZ_WOUT), nullptr, false, scr, r, lane); return; } r -= CONV_I_O;
    if (r < CONV_I_1) { p0_transpose_item(ap->in[15] + (size_t)l * DM * FF, DM, FF, (bf16_t*)(ws + WS_W1 + l * SZ_W1), ap->in[14] + l * DM, false, scr, r, lane); return; } r -= CONV_I_1;
    p0_transpose_item(ap->in[16] + (size_t)l * FF * DM, FF, DM, (bf16_t*)(ws + WS_W2 + l * SZ_W2), nullptr, false, scr, r, lane);
}
__device__ __forceinline__ void bg_convert(const Frame& F, KA* ap, unsigned* arrive, bool drain) {
    unsigned* ctl = (unsigned*)(ap->ws + WS_CTL); unsigned* head = ctl + CW_BGQ;
    volatile LAS unsigned* slot = (volatile LAS unsigned*)(F.lds + LDS_MISC) + 24;
    LAS float* scr = (LAS float*)(F.lds + F.wave * 16896);
    if (!drain && F.tid == 0) (void)__hip_atomic_fetch_add(arrive, 1u, __ATOMIC_RELAXED, __HIP_MEMORY_SCOPE_AGENT);
    for (;;) {
        __syncthreads();
        if (F.tid == 0) { unsigned done = 0u; if (!drain) done = (__hip_atomic_load(arrive, __ATOMIC_RELAXED, __HIP_MEMORY_SCOPE_AGENT) >= (unsigned)F.G) ? 1u : 0u;
            unsigned ch = 0xFFFFFFFFu; if (!done) ch = __hip_atomic_fetch_add(head, 1u, __ATOMIC_RELAXED, __HIP_MEMORY_SCOPE_AGENT);
            slot[0] = ch; }
        __syncthreads();
        const unsigned ch = (unsigned)__builtin_amdgcn_readfirstlane((int)slot[0]);
        if (ch == 0xFFFFFFFFu || ch * 8u >= (unsigned)CONV_PER_L) break;
        const int it = (int)ch * 8 + F.wave;
        if (it < CONV_PER_L) conv_item(ap, 1, it, scr, F.lane);
    }
    __syncthreads();
}
constexpr int NCVW = 32;
__device__ __forceinline__ void conv_side(const Frame& F, KA* ap) {
    LAS float* scr = (LAS float*)(F.lds + F.wave * 16896);
    const int ncv = F.G < NCVW ? F.G : NCVW;
    for (int it = CONV_I_IN + (int)blockIdx.x * 8 + F.wave; it < CONV_PER_L; it += ncv * 8) conv_item(ap, 0, it, scr, F.lane);
    __syncthreads();
}
__device__ __forceinline__ void p0_prologue(const Frame& F, KA* ap) {
    unsigned char* ws = ap->ws;
    LAS float* scr = (LAS float*)(F.lds + F.wave * 16896);
    const int gw = F.vcu * 8 + F.wave, NGW = F.G * 8;
    for (int it = gw; it < CONV_I_IN; it += NGW) conv_item(ap, 0, it, scr, F.lane);
    { const int gt = (F.vcu * 8 + F.wave) * 64 + F.lane, NGT = F.G * 512; constexpr int PADV = (NINP - NIN) * DM / 8;
      for (int i = gt; i < DEPTH * PADV; i += NGT) { const int l = i / PADV, r = i % PADV; const int n = NIN + r / (DM / 8), k = (r % (DM / 8)) * 8;
          *(u32x4*)((bf16_t*)(ws + WS_WIN + l * SZ_WIN) + tiled_off((size_t)n, k, DM)) = zero4(); } }
    { const int gt = (F.vcu * 8 + F.wave) * 64 + F.lane; float* lb = (float*)(ws + WS_LB);
      if (gt < 1024) { const float g0 = ap->in[3][gt], g1 = ap->in[3][1024 + gt]; lb[gt] = 0.f; lb[1024 + gt] = 1.f / (1.f + expf(g0 - g1)); } }
    rownorm_phase(F, ap->in[0], (bf16_t*)(ws + WS_XB), (float*)(ws + WS_SSQP));
}


__device__ __forceinline__ int q_next(unsigned* ctr, volatile LAS unsigned* slot) {
    __syncthreads();
    if (my_tid() == 0) *slot = atomicAdd(ctr, 1u);
    __syncthreads();
    return __builtin_amdgcn_readfirstlane((int)*slot);
}

template <bool DRY>
__device__ __forceinline__ void norm128_inplace(bf16_t* p, const float (&g)[16], int lane) {
    u32x4 a = *(const u32x4*)(p + lane * 16), b = *(const u32x4*)(p + lane * 16 + 8);
    float v[16];
    v[0] = bf_lo(a.x); v[1] = bf_hi(a.x); v[2] = bf_lo(a.y); v[3] = bf_hi(a.y); v[4] = bf_lo(a.z); v[5] = bf_hi(a.z); v[6] = bf_lo(a.w); v[7] = bf_hi(a.w);
    v[8] = bf_lo(b.x); v[9] = bf_hi(b.x); v[10] = bf_lo(b.y); v[11] = bf_hi(b.y); v[12] = bf_lo(b.z); v[13] = bf_hi(b.z); v[14] = bf_lo(b.w); v[15] = bf_hi(b.w);
    float ss = 0.f;
#pragma unroll
    for (int i = 0; i < 16; ++i) ss += v[i] * v[i];
    ss = sum8(ss);
    const float rs = 1.f / sqrtf(ss * (1.f / 128.f) + EPS);
#pragma unroll
    for (int i = 0; i < 16; ++i) v[i] = v[i] * rs * g[i];
    a.x = cvt_pk_bf16(v[0], v[1]); a.y = cvt_pk_bf16(v[2], v[3]); a.z = cvt_pk_bf16(v[4], v[5]); a.w = cvt_pk_bf16(v[6], v[7]);
    b.x = cvt_pk_bf16(v[8], v[9]); b.y = cvt_pk_bf16(v[10], v[11]); b.z = cvt_pk_bf16(v[12], v[13]); b.w = cvt_pk_bf16(v[14], v[15]);
    if (!DRY || rs == 1234.5f) { *(u32x4*)(p + lane * 16) = a; *(u32x4*)(p + lane * 16 + 8) = b; }
}
template <bool DRY>
__device__ __forceinline__ void fixup_phase(const Frame& F, KA* ap, int l) {
    unsigned char* ws = ap->ws;
    bf16_t* PROJ = (bf16_t*)(ws + WS_PROJ); float* ODDW = (float*)(ws + WS_ODD); const float* ODDP = (const float*)(ws + WS_Y); const float* RS = (const float*)(ws + WS_RS); const float* gbias = ap->in[6] + l * 16;
    bf16_t* BQK = (bf16_t*)(ws + WS_BQK); bf16_t* KI = (bf16_t*)(ws + WS_KI);
    const float* kin = ap->in[12] + l * 64; const float* cw = ap->in[5] + l * 4096;
    const int gw = F.vcu * 8 + F.wave, NGW = F.G * 8, lane = F.lane;
    float wcv[4][16];
#pragma unroll
    for (int j = 0; j < 4; ++j)
#pragma unroll
        for (int i = 0; i < 16; ++i) wcv[j][i] = cw[j * 1024 + lane * 16 + i];
    for (int m = gw; m < M; m += NGW) {
        {
          const float* op = ODDP + (size_t)m * 128; const float rs = RS[m];
          const float x = rs * ((op[lane] + op[(size_t)M * 128 + lane]) + (op[(size_t)2 * M * 128 + lane] + op[(size_t)3 * M * 128 + lane]));
          if (lane < 32) { const int c2 = 64 + lane; float v = rs * ((op[c2] + op[(size_t)M * 128 + c2]) + (op[(size_t)2 * M * 128 + c2] + op[(size_t)3 * M * 128 + c2]));
              if (c2 < 80) v *= 2.0f;   else { v += gbias[c2 - 80]; if (c2 >= 88) v = fminf(v, 0.f) - __logf(1.f + __expf(-fabsf(v))); }
              if (!DRY || v == 1234.5f) ODDW[(size_t)m * LDO + c2] = v; }
          const float ss = wave_sum(x * x, lane); const float y = x * (1.f / sqrtf(ss * (1.f / 64.f) + EPS)) * kin[lane];
          if (!DRY || y == 1234.5f) KI[(((size_t)(m >> 5) * 4 + (lane >> 4)) * 64 + ((lane >> 3) & 1) * 32 + (m & 31)) * 8 + (lane & 7)] = (bf16_t)(cvt_pk_bf16(y, y) & 0xffffu); }
        { const int tt = m & (T - 1); float acc[16];
#pragma unroll
          for (int i = 0; i < 16; ++i) acc[i] = 0.f;
#pragma unroll
          for (int j = 0; j < 4; ++j) { if (tt - 3 + j >= 0) { const bf16_t* rp = PROJ + (size_t)(m - 3 + j) * LDP + C_BQK + lane * 16;
                const u32x4 x0 = *(const u32x4*)rp, x1 = *(const u32x4*)(rp + 8); const float (&wj)[16] = wcv[j];
                acc[0] += bf_lo(x0.x) * wj[0]; acc[1] += bf_hi(x0.x) * wj[1]; acc[2] += bf_lo(x0.y) * wj[2]; acc[3] += bf_hi(x0.y) * wj[3];
                acc[4] += bf_lo(x0.z) * wj[4]; acc[5] += bf_hi(x0.z) * wj[5]; acc[6] += bf_lo(x0.w) * wj[6]; acc[7] += bf_hi(x0.w) * wj[7];
                acc[8] += bf_lo(x1.x) * wj[8]; acc[9] += bf_hi(x1.x) * wj[9]; acc[10] += bf_lo(x1.y) * wj[10]; acc[11] += bf_hi(x1.y) * wj[11];
                acc[12] += bf_lo(x1.z) * wj[12]; acc[13] += bf_hi(x1.z) * wj[13]; acc[14] += bf_lo(x1.w) * wj[14]; acc[15] += bf_hi(x1.w) * wj[15]; } }
          const float sc = (lane >= 32) ? 0.125f : 1.f;
#pragma unroll
          for (int i = 0; i < 16; ++i) acc[i] = fast_silu(acc[i]) * sc;
          u32x4 o0, o1; o0.x = cvt_pk_bf16(acc[0], acc[1]); o0.y = cvt_pk_bf16(acc[2], acc[3]); o0.z = cvt_pk_bf16(acc[4], acc[5]); o0.w = cvt_pk_bf16(acc[6], acc[7]);
          o1.x = cvt_pk_bf16(acc[8], acc[9]); o1.y = cvt_pk_bf16(acc[10], acc[11]); o1.z = cvt_pk_bf16(acc[12], acc[13]); o1.w = cvt_pk_bf16(acc[14], acc[15]);
          if (!DRY || acc[0] == 1234.5f) { *(u32x4*)(BQK + (size_t)m * 1024 + lane * 16) = o0; *(u32x4*)(BQK + (size_t)m * 1024 + lane * 16 + 8) = o1; } }
    }
}
__device__ __forceinline__ void ccombine_phase(const Frame& F, KA* ap, int l) {
    unsigned char* ws = ap->ws; const float* CATT = (const float*)(ws + WS_CATT); bf16_t* Y = (bf16_t*)(ws + WS_Y);
    const float* lam = ap->in[9] + l * 512; const float* sub = ap->in[10] + l * 256; const int lane = F.lane;
    const float linit = (l == 0) ? 0.2f : 0.35550906759f;
    const float s1 = wave_sum(lam[lane] * lam[128 + lane] + lam[64 + lane] * lam[192 + lane], lane);
    const float s2 = wave_sum(lam[256 + lane] * lam[384 + lane] + lam[320 + lane] * lam[448 + lane], lane);
    const float lamf = expf(s1) - expf(s2) + linit;
    const int gw = F.vcu * 8 + F.wave, NGW = F.G * 8;
    float g[16];
#pragma unroll
    for (int i = 0; i < 16; ++i) g[i] = sub[(lane & 15) * 16 + i] * (1.f - linit);
    for (int m = gw; m < M; m += NGW) {
        const float* r1 = CATT + (size_t)m * 2048 + lane * 16; const float* r2 = r1 + 1024;
        float v[16]; float ss = 0.f;
#pragma unroll
        for (int q = 0; q < 4; ++q) { const f32x4 x = *(const f32x4*)(r1 + 4 * q), y = *(const f32x4*)(r2 + 4 * q);
#pragma unroll
            for (int j = 0; j < 4; ++j) { const float d = x[j] - lamf * y[j]; v[4 * q + j] = d; ss += d * d; } }
        ss = sum16(ss);
        const float rs = 1.f / sqrtf(ss * (1.f / 256.f) + EPS);
        u32x4 o0, o1;
        o0.x = cvt_pk_bf16(v[0] * rs * g[0], v[1] * rs * g[1]); o0.y = cvt_pk_bf16(v[2] * rs * g[2], v[3] * rs * g[3]); o0.z = cvt_pk_bf16(v[4] * rs * g[4], v[5] * rs * g[5]); o0.w = cvt_pk_bf16(v[6] * rs * g[6], v[7] * rs * g[7]);
        o1.x = cvt_pk_bf16(v[8] * rs * g[8], v[9] * rs * g[9]); o1.y = cvt_pk_bf16(v[10] * rs * g[10], v[11] * rs * g[11]); o1.z = cvt_pk_bf16(v[12] * rs * g[12], v[13] * rs * g[13]); o1.w = cvt_pk_bf16(v[14] * rs * g[14], v[15] * rs * g[15]);
        bf16_t* yo = Y + tiled_off((size_t)m, 2048 + lane * 16, DM);
        *(u32x4*)yo = o0; *(u32x4*)(yo + 8) = o1;
    }
}

template <int KS>
__device__ __forceinline__ void mma_nt(f32x16& acc, const LAS unsigned char* A, int sa, const LAS unsigned char* B, int sb, int lane) {
    const LAS unsigned char* ap = A + (lane & 31) * sa + (lane >> 5) * 16;
    const LAS unsigned char* bp = B + (lane & 31) * sb + (lane >> 5) * 16;
#pragma unroll
    for (int ks = 0; ks < KS; ++ks) { const bf16x8 x = *(const LAS bf16x8*)(ap + ks * 32), y = *(const LAS bf16x8*)(bp + ks * 32);
        acc = __builtin_amdgcn_mfma_f32_32x32x16_bf16(x, y, acc, 0, 0, 0); }
}
__device__ __forceinline__ unsigned short bf1(float v) { return (unsigned short)(cvt_pk_bf16(v, v) & 0xffffu); }

__device__ __forceinline__ void hgrn_scan(const Frame& F, KA* ap, int l, int bh) {
    const int tid_ = my_tid();
    const int tid = tid_, lane = tid & 63, w = __builtin_amdgcn_readfirstlane(tid >> 6), hi = lane >> 5, c32 = lane & 31;
    unsigned char* ws = ap->ws; LAS unsigned char* lds = F.lds;
    const int b = bh >> 3, h = bh & 7; const size_t m0 = (size_t)b * T;
    const bf16_t* PROJ = (const bf16_t*)(ws + WS_PROJ); const float* GL = (const float*)(ws + WS_GLOG) + h * 128;
    bf16_t* Y = (bf16_t*)(ws + WS_Y); const float* gn = ap->in[4] + l * 128;
    constexpr int QT = 0, KT = 17408, QH = 34816, KHT = 52224, VT = 70656, ST = 89088, PP = 123904, TOT = 133120, DEC = 137216, OO = 0;
    constexpr int SQ = 272, SK = 144;
    { const u32x4 z4 = zero4(); for (int i = tid; i < 34816 / 16; i += 512) *(LAS u32x4*)(lds + ST + i * 16) = z4; }
    f32x16 sacc[2] = {};
    f32x2 gv[8]; unsigned qv[8], vv[8];
    const int k0 = 2 * lane;
#define HG_LOAD(c) do { _Pragma("unroll") for (int i = 0; i < 8; ++i) { const size_t row = m0 + (size_t)(c) * 64 + 8 * w + i; \
        gv[i] = *(const f32x2*)(GL + row * 1024 + k0); qv[i] = *(const unsigned*)(PROJ + row * LDP + C_AQ + h * 128 + k0); vv[i] = *(const unsigned*)(PROJ + row * LDP + C_AI + h * 128 + k0); } } while (0)
    float ggv[16];
#pragma unroll
    for (int i = 0; i < 16; ++i) ggv[i] = gn[(tid & 7) * 16 + i];
    HG_LOAD(0);
    for (int c = 0; c < T / 64; ++c) {
        const bf16_t* gp_ = PROJ + (m0 + (size_t)c * 64 + (tid >> 3)) * LDP + C_AG + h * 128 + (tid & 7) * 16; const u32x4 g0 = *(const u32x4*)gp_, g1 = *(const u32x4*)(gp_ + 8);
        f32x2 cs[8]; { f32x2 run = {0.f, 0.f};
#pragma unroll
            for (int i = 0; i < 8; ++i) { run += gv[i]; cs[i] = run; }
            *(LAS f32x2*)(lds + TOT + (w * 128 + k0) * 4) = run; }
        __syncthreads();
        { f32x2 off = {0.f, 0.f}, b31 = {0.f, 0.f}, b63 = {0.f, 0.f};
#pragma unroll
          for (int j = 0; j < 8; ++j) { const f32x2 tj = *(const LAS f32x2*)(lds + TOT + (j * 128 + k0) * 4); if (j < w) off += tj; if (j < 4) b31 += tj; b63 += tj; }
          float kh0[8], kh1[8];
#pragma unroll
          for (int i = 0; i < 8; ++i) { const int t = 8 * w + i; const f32x2 bt = off + cs[i];
              const float q0 = bf_lo(qv[i]), q1 = bf_hi(qv[i]);
              const float ki0 = 1.f - __expf(gv[i].x), ki1 = 1.f - __expf(gv[i].y);
              *(LAS unsigned*)(lds + QT + t * SQ + k0 * 2) = cvt_pk_bf16(q0 * __expf(fminf(bt.x - b31.x, 80.f)), q1 * __expf(fminf(bt.y - b31.y, 80.f)));
              *(LAS unsigned*)(lds + KT + t * SQ + k0 * 2) = cvt_pk_bf16(ki0 * __expf(fminf(b31.x - bt.x, 80.f)), ki1 * __expf(fminf(b31.y - bt.y, 80.f)));
              *(LAS unsigned*)(lds + QH + t * SQ + k0 * 2) = cvt_pk_bf16(q0 * __expf(bt.x), q1 * __expf(bt.y));
              kh0[i] = ki0 * __expf(b63.x - bt.x); kh1[i] = ki1 * __expf(b63.y - bt.y); }
          u32x4 o; o.x = cvt_pk_bf16(kh0[0], kh0[1]); o.y = cvt_pk_bf16(kh0[2], kh0[3]); o.z = cvt_pk_bf16(kh0[4], kh0[5]); o.w = cvt_pk_bf16(kh0[6], kh0[7]);
          *(LAS u32x4*)(lds + KHT + k0 * SK + w * 16) = o;
          o.x = cvt_pk_bf16(kh1[0], kh1[1]); o.y = cvt_pk_bf16(kh1[2], kh1[3]); o.z = cvt_pk_bf16(kh1[4], kh1[5]); o.w = cvt_pk_bf16(kh1[6], kh1[7]);
          *(LAS u32x4*)(lds + KHT + (k0 + 1) * SK + w * 16) = o;
          o.x = (vv[0] & 0xffffu) | (vv[1] << 16); o.y = (vv[2] & 0xffffu) | (vv[3] << 16); o.z = (vv[4] & 0xffffu) | (vv[5] << 16); o.w = (vv[6] & 0xffffu) | (vv[7] << 16);
          *(LAS u32x4*)(lds + VT + k0 * SK + w * 16) = o;
          o.x = (vv[0] >> 16) | (vv[1] & 0xffff0000u); o.y = (vv[2] >> 16) | (vv[3] & 0xffff0000u); o.z = (vv[4] >> 16) | (vv[5] & 0xffff0000u); o.w = (vv[6] >> 16) | (vv[7] & 0xffff0000u);
          *(LAS u32x4*)(lds + VT + (k0 + 1) * SK + w * 16) = o;
          if (w == 7) { f32x2 d; d.x = __expf(b63.x); d.y = __expf(b63.y); *(LAS f32x2*)(lds + DEC + k0 * 4) = d; } }
        if (c + 1 < T / 64) HG_LOAD(c + 1);
        __syncthreads();
        f32x16 pacc = {}, oacc = {};
        const int ti = w >> 1, sj = w & 1;
        if (w < 4 && !(ti == 0 && sj == 1)) mma_nt<8>(pacc, lds + QT + ti * 32 * SQ, SQ, lds + KT + sj * 32 * SQ, SQ, lane);
        mma_nt<8>(oacc, lds + QH + (w & 1) * 32 * SQ, SQ, lds + ST + (w >> 1) * 32 * SQ, SQ, lane);
#pragma unroll
        for (int j = 0; j < 2; ++j) { const int kj = 2 * (w & 1) + j; const float dec = *(const LAS float*)(lds + DEC + (32 * kj + c32) * 4);
#pragma unroll
            for (int r = 0; r < 16; ++r) sacc[j][r] *= dec;
            mma_nt<4>(sacc[j], lds + VT + (w >> 1) * 32 * SK, SK, lds + KHT + kj * 32 * SK, SK, lane); }
        __syncthreads();
        if (w < 4) {
#pragma unroll
            for (int r = 0; r < 16; ++r) { const int t = 32 * ti + att::crow(r, hi), s_ = 32 * sj + c32; const float v = (s_ <= t) ? pacc[r] : 0.f;
                *(LAS unsigned short*)(lds + PP + t * SK + s_ * 2) = bf1(v); } }
#pragma unroll
        for (int j = 0; j < 2; ++j) { const int kj = 2 * (w & 1) + j;
#pragma unroll
            for (int r = 0; r < 16; ++r) { const int v_ = 32 * (w >> 1) + att::crow(r, hi), k_ = 32 * kj + c32;
                *(LAS unsigned short*)(lds + ST + v_ * SQ + k_ * 2) = bf1(sacc[j][r]); } }
        __syncthreads();
        mma_nt<4>(oacc, lds + PP + (w & 1) * 32 * SK, SK, lds + VT + (w >> 1) * 32 * SK, SK, lane);
#pragma unroll
        for (int r = 0; r < 16; ++r) { const int t = 32 * (w & 1) + att::crow(r, hi), v_ = 32 * (w >> 1) + c32; *(LAS float*)(lds + OO + (t * 132 + v_) * 4) = oacc[r]; }
        __syncthreads();
        { const int t = tid >> 3, sg = tid & 7; const size_t row = m0 + (size_t)c * 64 + t;
          float v[16]; float ss = 0.f;
#pragma unroll
          for (int q = 0; q < 4; ++q) { const f32x4 x = *(const LAS f32x4*)(lds + OO + (t * 132 + sg * 16 + 4 * q) * 4);
#pragma unroll
              for (int j = 0; j < 4; ++j) { v[4 * q + j] = x[j]; ss += x[j] * x[j]; } }
          ss = sum8(ss);
          const float rs = 1.f / sqrtf(ss * (1.f / 128.f) + EPS);
          const float (&gg)[16] = ggv;
          u32x4 o0, o1;
          o0.x = cvt_pk_bf16(v[0] * rs * gg[0] * bf_lo(g0.x), v[1] * rs * gg[1] * bf_hi(g0.x)); o0.y = cvt_pk_bf16(v[2] * rs * gg[2] * bf_lo(g0.y), v[3] * rs * gg[3] * bf_hi(g0.y));
          o0.z = cvt_pk_bf16(v[4] * rs * gg[4] * bf_lo(g0.z), v[5] * rs * gg[5] * bf_hi(g0.z)); o0.w = cvt_pk_bf16(v[6] * rs * gg[6] * bf_lo(g0.w), v[7] * rs * gg[7] * bf_hi(g0.w));
          o1.x = cvt_pk_bf16(v[8] * rs * gg[8] * bf_lo(g1.x), v[9] * rs * gg[9] * bf_hi(g1.x)); o1.y = cvt_pk_bf16(v[10] * rs * gg[10] * bf_lo(g1.y), v[11] * rs * gg[11] * bf_hi(g1.y));
          o1.z = cvt_pk_bf16(v[12] * rs * gg[12] * bf_lo(g1.z), v[13] * rs * gg[13] * bf_hi(g1.z)); o1.w = cvt_pk_bf16(v[14] * rs * gg[14] * bf_lo(g1.w), v[15] * rs * gg[15] * bf_hi(g1.w));
          bf16_t* yo = Y + tiled_off(row, h * 128 + sg * 16, DM); *(u32x4*)yo = o0; *(u32x4*)(yo + 8) = o1; }
    }
#undef HG_LOAD
    __syncthreads();
}

__device__ __forceinline__ void mlstm_scan(const Frame& F, KA* ap, int l, int bh) {
    const int tid_ = my_tid();
    const int tid = tid_, lane = tid & 63, w = __builtin_amdgcn_readfirstlane(tid >> 6), hi = lane >> 5, c32 = lane & 31;
    unsigned char* ws = ap->ws; LAS unsigned char* lds = F.lds;
    const int b = bh >> 3, h = bh & 7; const size_t m0 = (size_t)b * T;
    const bf16_t* PROJ = (const bf16_t*)(ws + WS_PROJ); const bf16_t* BQK = (const bf16_t*)(ws + WS_BQK); const float* ODD = (const float*)(ws + WS_ODD);
    bf16_t* Y = (bf16_t*)(ws + WS_Y); const float* hn = ap->in[7] + l * 128;
    constexpr int QA = 0, QI = 9216, KB = 18432, KHT = 27648, VT = 36864, CT = 59904, PP = 82944, SCAL = 92160, NUM = 94208;
    constexpr int SK = 144, SN = 164;
    { const u32x4 z4 = zero4(); for (int i = tid; i < 23040 / 16; i += 512) *(LAS u32x4*)(lds + CT + i * 16) = z4; }
    for (int i = tid; i < 32 * SK / 16; i += 512) { const int off = i * 16; const unsigned vone = (off < SK) ? 0x3F803F80u : 0u;
        *(LAS u32x4*)(lds + VT + 128 * SK + off) = (u32x4){vone, vone, vone, vone}; }
    f32x16 cacc[2] = {};
    float m_prev = 0.f;
    const int te = tid >> 3, d0 = (tid & 7) * 8, k0 = 2 * lane;
    bf16x8 qreg, kreg; unsigned vv[8]; float igr = 0.f, lfr = 0.f;
#define ML_LOAD(c) do { const size_t rb = m0 + (size_t)(c) * 64; \
        qreg = *(const bf16x8*)(BQK + (rb + te) * 1024 + h * 64 + d0); kreg = *(const bf16x8*)(BQK + (rb + te) * 1024 + 512 + h * 64 + d0); \
        _Pragma("unroll") for (int i = 0; i < 8; ++i) vv[i] = *(const unsigned*)(PROJ + (rb + 8 * w + i) * LDP + C_BV + h * 128 + k0); \
        if (w == 0) { igr = ODD[(rb + lane) * LDO + 80 + h]; lfr = ODD[(rb + lane) * LDO + 88 + h]; } } while (0)
    float ggv[16];
#pragma unroll
    for (int i = 0; i < 16; ++i) ggv[i] = hn[(tid & 7) * 16 + i];
    ML_LOAD(0);
    for (int c = 0; c < T / 64; ++c) {
        const bf16_t* gp_ = PROJ + (m0 + (size_t)c * 64 + (tid >> 3)) * LDP + C_BO + h * 128 + (tid & 7) * 16; const u32x4 g0 = *(const u32x4*)gp_, g1 = *(const u32x4*)(gp_ + 8);
        if (w == 0) {
            float bc = lfr;
#pragma unroll
            for (int o = 1; o < 64; o <<= 1) { const float x = sidx(bc, lane - o); if (lane >= o) bc += x; }
            const float c1 = igr - bc; float pm = c1;
#pragma unroll
            for (int o = 1; o < 64; o <<= 1) { const float x = sidx(pm, lane - o); if (lane >= o) pm = fmaxf(pm, x); }
            const float mt = fmaxf(bc + pm, bc + m_prev);
            const float wi = __expf(bc + m_prev - mt);
            const float m_new = sidx(mt, 63), b63 = sidx(bc, 63);
            const float wst = __expf(b63 + c1 - m_new), decay = __expf(b63 + m_prev - m_new);
            LAS float* sc = (LAS float*)(lds + SCAL);
            sc[lane] = c1; sc[64 + lane] = bc - mt; sc[128 + lane] = wi; sc[192 + lane] = wst; sc[256 + lane] = __expf(-mt); if (lane == 0) sc[320] = decay;
            m_prev = m_new;
        }
        *(LAS bf16x8*)(lds + QA + te * SK + d0 * 2) = qreg; *(LAS bf16x8*)(lds + KB + te * SK + d0 * 2) = kreg;
        { u32x4 o; o.x = (vv[0] & 0xffffu) | (vv[1] << 16); o.y = (vv[2] & 0xffffu) | (vv[3] << 16); o.z = (vv[4] & 0xffffu) | (vv[5] << 16); o.w = (vv[6] & 0xffffu) | (vv[7] << 16);
          *(LAS u32x4*)(lds + VT + k0 * SK + w * 16) = o;
          o.x = (vv[0] >> 16) | (vv[1] & 0xffff0000u); o.y = (vv[2] >> 16) | (vv[3] & 0xffff0000u); o.z = (vv[4] >> 16) | (vv[5] & 0xffff0000u); o.w = (vv[6] >> 16) | (vv[7] & 0xffff0000u);
          *(LAS u32x4*)(lds + VT + (k0 + 1) * SK + w * 16) = o; }
        __syncthreads();
        { const LAS float* sc = (const LAS float*)(lds + SCAL); const float wi = sc[128 + te], wst = sc[192 + te];
          float qf[8], kf[8];
#pragma unroll
          for (int i = 0; i < 8; ++i) { qf[i] = bf2f((bf16_t)qreg[i]) * wi; kf[i] = bf2f((bf16_t)kreg[i]) * wst; }
          u32x4 o; o.x = cvt_pk_bf16(qf[0], qf[1]); o.y = cvt_pk_bf16(qf[2], qf[3]); o.z = cvt_pk_bf16(qf[4], qf[5]); o.w = cvt_pk_bf16(qf[6], qf[7]);
          *(LAS u32x4*)(lds + QI + te * SK + d0 * 2) = o;
#pragma unroll
          for (int i = 0; i < 8; ++i) *(LAS unsigned short*)(lds + KHT + (d0 + i) * SK + te * 2) = bf1(kf[i]); }
        if (c + 1 < T / 64) ML_LOAD(c + 1);
        __syncthreads();
        f32x16 pacc = {}, nacc0 = {}, nacc1 = {};
        const int ti = w >> 1, sj = w & 1;
        const float decay = ((const LAS float*)(lds + SCAL))[320];
        if (w < 4 && !(ti == 0 && sj == 1)) mma_nt<4>(pacc, lds + QA + ti * 32 * SK, SK, lds + KB + sj * 32 * SK, SK, lane);
        mma_nt<4>(nacc0, lds + QI + (w & 1) * 32 * SK, SK, lds + CT + (w >> 1) * 32 * SK, SK, lane);
        if (w < 2) mma_nt<4>(nacc1, lds + QI + w * 32 * SK, SK, lds + CT + 4 * 32 * SK, SK, lane);
#pragma unroll
        for (int r = 0; r < 16; ++r) cacc[0][r] *= decay;
        mma_nt<4>(cacc[0], lds + VT + (w >> 1) * 32 * SK, SK, lds + KHT + (w & 1) * 32 * SK, SK, lane);
        if (w < 2) {
#pragma unroll
            for (int r = 0; r < 16; ++r) cacc[1][r] *= decay;
            mma_nt<4>(cacc[1], lds + VT + 4 * 32 * SK, SK, lds + KHT + w * 32 * SK, SK, lane); }
        __syncthreads();
        if (w < 4) { const LAS float* sc = (const LAS float*)(lds + SCAL); const int s_ = 32 * sj + c32; const float c1s = sc[s_];
#pragma unroll
            for (int r = 0; r < 16; ++r) { const int t = 32 * ti + att::crow(r, hi); const float v = (s_ <= t) ? pacc[r] * __expf(c1s + sc[64 + t]) : 0.f;
                *(LAS unsigned short*)(lds + PP + t * SK + s_ * 2) = bf1(v); } }
#pragma unroll
        for (int r = 0; r < 16; ++r) { const int v_ = 32 * (w >> 1) + att::crow(r, hi), d_ = 32 * (w & 1) + c32; *(LAS unsigned short*)(lds + CT + v_ * SK + d_ * 2) = bf1(cacc[0][r]); }
        if (w < 2) {
#pragma unroll
            for (int r = 0; r < 16; ++r) { const int v_ = 128 + att::crow(r, hi), d_ = 32 * w + c32; *(LAS unsigned short*)(lds + CT + v_ * SK + d_ * 2) = bf1(cacc[1][r]); } }
        __syncthreads();
        mma_nt<4>(nacc0, lds + PP + (w & 1) * 32 * SK, SK, lds + VT + (w >> 1) * 32 * SK, SK, lane);
        if (w < 2) mma_nt<4>(nacc1, lds + PP + w * 32 * SK, SK, lds + VT + 4 * 32 * SK, SK, lane);
#pragma unroll
        for (int r = 0; r < 16; ++r) { const int t = 32 * (w & 1) + att::crow(r, hi), v_ = 32 * (w >> 1) + c32; *(LAS float*)(lds + NUM + (t * SN + v_) * 4) = nacc0[r]; }
        if (w < 2) {
#pragma unroll
            for (int r = 0; r < 16; ++r) { const int t = 32 * w + att::crow(r, hi), v_ = 128 + c32; *(LAS float*)(lds + NUM + (t * SN + v_) * 4) = nacc1[r]; } }
        __syncthreads();
        { const int t = tid >> 3, sg = tid & 7; const size_t row = m0 + (size_t)c * 64 + t;
          const float den = *(const LAS float*)(lds + NUM + (t * SN + 128) * 4); const float emt = ((const LAS float*)(lds + SCAL))[256 + t];
          const float inv = 1.f / fmaxf(fabsf(den), emt);
          float v[16]; float ss = 0.f;
#pragma unroll
          for (int q = 0; q < 4; ++q) { const f32x4 x = *(const LAS f32x4*)(lds + NUM + (t * SN + sg * 16 + 4 * q) * 4);
#pragma unroll
              for (int j = 0; j < 4; ++j) { const float y = x[j] * inv; v[4 * q + j] = y; ss += y * y; } }
          ss = sum8(ss);
          const float rs = 1.f / sqrtf(ss * (1.f / 128.f) + EPS);
          const float (&gg)[16] = ggv;
          u32x4 o0, o1;
          o0.x = cvt_pk_bf16(v[0] * rs * gg[0] * bf_lo(g0.x), v[1] * rs * gg[1] * bf_hi(g0.x)); o0.y = cvt_pk_bf16(v[2] * rs * gg[2] * bf_lo(g0.y), v[3] * rs * gg[3] * bf_hi(g0.y));
          o0.z = cvt_pk_bf16(v[4] * rs * gg[4] * bf_lo(g0.z), v[5] * rs * gg[5] * bf_hi(g0.z)); o0.w = cvt_pk_bf16(v[6] * rs * gg[6] * bf_lo(g0.w), v[7] * rs * gg[7] * bf_hi(g0.w));
          o1.x = cvt_pk_bf16(v[8] * rs * gg[8] * bf_lo(g1.x), v[9] * rs * gg[9] * bf_hi(g1.x)); o1.y = cvt_pk_bf16(v[10] * rs * gg[10] * bf_lo(g1.y), v[11] * rs * gg[11] * bf_hi(g1.y));
          o1.z = cvt_pk_bf16(v[12] * rs * gg[12] * bf_lo(g1.z), v[13] * rs * gg[13] * bf_hi(g1.z)); o1.w = cvt_pk_bf16(v[14] * rs * gg[14] * bf_lo(g1.w), v[15] * rs * gg[15] * bf_hi(g1.w));
          bf16_t* yo = Y + tiled_off(row, 1024 + h * 128 + sg * 16, DM); *(u32x4*)yo = o0; *(u32x4*)(yo + 8) = o1; }
    }
#undef ML_LOAD
    __syncthreads();
}

template <int STG2>
__device__ __forceinline__ void dsa_index_item2(const Frame& F, KA* ap, int item) {
    const int tid_ = my_tid();
    const int tid = tid_, lane = tid & 63, w = __builtin_amdgcn_readfirstlane(tid >> 6), hi = lane >> 5, c32 = lane & 31;
    unsigned char* ws = ap->ws; LAS unsigned char* lds = F.lds;
    const int b = item % NB, tb = (T / 32 - 1) - item / NB;
    const int t0 = tb * 32 + 4 * w; const size_t m0 = (size_t)b * T;
    const int n = 64 * (t0 / 64 + 1), nkb = n / 32, nj = n / 64;
    unsigned* MK = (unsigned*)(ws + WS_MASK) + (size_t)b * 256 * T;
    if (n <= 256) { for (int i = lane; i < nkb * 4; i += 64) MK[(size_t)(i >> 2) * T + t0 + (i & 3)] = 0xFFFFFFFFu; return; }
    const bf16_t* PROJ = (const bf16_t*)(ws + WS_PROJ); const bf16_t* KI = (const bf16_t*)(ws + WS_KI) + m0 * 64; const float* ODD = (const float*)(ws + WS_ODD);
    unsigned* SCB = (unsigned*)(ws + WS_SCB) + ((size_t)blockIdx.x * 8 + w) * 4 * T;
    LAS unsigned* hist = (LAS unsigned*)(lds + w * 8192);
    LAS unsigned* wb = hist + 1024;
    {
        bf16x8 af[2][4]; float wv[2][16];
#pragma unroll
        for (int rt = 0; rt < 2; ++rt) {
#pragma unroll
            for (int ks = 0; ks < 4; ++ks) af[rt][ks] = *(const bf16x8*)(PROJ + (m0 + t0 + 2 * rt + (c32 >> 4)) * LDP + C_DQI + (c32 & 15) * 64 + ks * 16 + hi * 8);
#pragma unroll
            for (int r = 0; r < 16; ++r) { const int tok = 2 * rt + (r >> 3), head = (r & 3) + 8 * ((r >> 2) & 1) + 4 * hi; wv[rt][r] = ODD[(m0 + t0 + tok) * LDO + 64 + head]; } }
        f32x2 wv2[2][8]; const f32x2 one2 = {1.f, 1.f};
#pragma unroll
        for (int rt = 0; rt < 2; ++rt)
#pragma unroll
            for (int i = 0; i < 8; ++i) wv2[rt][i] = (f32x2){wv[rt][2 * i], wv[rt][2 * i + 1]};
        LAS unsigned char* kbuf = lds + 65536;
#define IDX_LOADB(dst, base_, t_) do { _Pragma("unroll") for (int ks = 0; ks < 4; ++ks) dst[ks] = *(const LAS bf16x8*)((base_) + (((t_) * 4 + ks) * 64 + lane) * 16); } while (0)
#define IDX_MMA(src, A0, A1) do { A0 = f32x16{}; A1 = f32x16{}; _Pragma("unroll") for (int ks = 0; ks < 4; ++ks) { \
            A0 = __builtin_amdgcn_mfma_f32_32x32x16_bf16(af[0][ks], src[ks], A0, 0, 0, 0); A1 = __builtin_amdgcn_mfma_f32_32x32x16_bf16(af[1][ks], src[ks], A1, 0, 0, 0); } } while (0)
#define IDX_PKACC(SP, ACC, i_, W2) do { f32x2 x2_ = {ACC[2 * (i_)], ACC[2 * (i_) + 1]}, r2_; \
            asm("v_pk_mul_f32 %0, %1, %2 clamp" : "=v"(r2_) : "v"(x2_), "v"(one2));     \
            asm("v_pk_fma_f32 %0, %1, %2, %0" : "+v"(SP) : "v"(r2_), "v"(W2)); } while (0)
#define IDX_RED1(ACC, rt, kb_) do { f32x2 sp0 = {0.f, 0.f}, sp1 = {0.f, 0.f}; \
            _Pragma("unroll") for (int i = 0; i < 4; ++i) { IDX_PKACC(sp0, ACC, i, wv2[rt][i]); IDX_PKACC(sp1, ACC, 4 + i, wv2[rt][4 + i]); } \
            const float s0 = sp0.x + sp0.y, s1 = sp1.x + sp1.y; \
            const auto pr_ = __builtin_amdgcn_permlane32_swap(__float_as_uint(s0), __float_as_uint(s1), false, false); \
            const float sv = fminf(fmaxf(__uint_as_float(pr_[0]) + __uint_as_float(pr_[1]), -15.99f), 15.99f); \
            const unsigned key_ = ((unsigned)(int)(sv * 134217728.f) + 0x80000000u) >> 8; SCB[(size_t)(2 * rt + hi) * T + 32 * (kb_) + c32] = key_; \
            { const unsigned bin_ = key_ >> 15; __hip_atomic_fetch_add(&hist[(2 * rt + hi) * 256 + (bin_ >> 1)], 1u << (16 * (bin_ & 1u)), __ATOMIC_RELAXED, __HIP_MEMORY_SCOPE_WORKGROUP); } } while (0)
#define IDX_RED(A0, A1, kb_) do { IDX_RED1(A0, 0, kb_); IDX_RED1(A1, 1, kb_); } while (0)
        const int ngrp = (nkb + 7) >> 3;
        u32x4 stg[4];
#pragma unroll
        for (int i = 0; i < 16; ++i) hist[64 * i + lane] = 0u;
        asm volatile("s_waitcnt lgkmcnt(0)" ::: "memory");
#pragma unroll
        for (int i = 0; i < 4; ++i) { const int ch = tid + 512 * i; if ((ch >> 8) < nkb) stg[i] = *(const u32x4*)((const char*)KI + (size_t)ch * 16); }
#pragma unroll
        for (int i = 0; i < 4; ++i) { const int ch = tid + 512 * i; if ((ch >> 8) < nkb) *(LAS u32x4*)(kbuf + ch * 16) = stg[i]; }
        __syncthreads();
        for (int g = 0; g < ngrp; ++g) {
            const int kb0 = 8 * g, nt_ = (nkb - kb0) < 8 ? (nkb - kb0) : 8;
            if (g + 1 < ngrp) {
#pragma unroll
                for (int i = 0; i < 4; ++i) { const int ch = tid + 512 * i; if (kb0 + 8 + (ch >> 8) < nkb) stg[i] = *(const u32x4*)((const char*)KI + ((size_t)(kb0 + 8) * 256 + ch) * 16); } }
            const LAS unsigned char* cb = kbuf + (g & 1) * 32768;
            bf16x8 ra[4], rb[4]; f32x16 P0, P1, Q0, Q1;
            IDX_LOADB(ra, cb, 0); IDX_MMA(ra, P0, P1);
            for (int t = 0; t < nt_; t += 2) {
                IDX_LOADB(rb, cb, t + 1); IDX_MMA(rb, Q0, Q1);
                IDX_RED(P0, P1, kb0 + t);
                if (t + 2 < nt_) { IDX_LOADB(ra, cb, t + 2); IDX_MMA(ra, P0, P1); }
                IDX_RED(Q0, Q1, kb0 + t + 1);
            }
            if (g + 1 < ngrp) {
#pragma unroll
                for (int i = 0; i < 4; ++i) { const int ch = tid + 512 * i; if (kb0 + 8 + (ch >> 8) < nkb) *(LAS u32x4*)(kbuf + ((g + 1) & 1) * 32768 + ch * 16) = stg[i]; } }
            __syncthreads();
        }
#undef IDX_MMA
#undef IDX_PKACC
#undef IDX_RED1
#undef IDX_RED
#undef IDX_LOADB
    }
    asm volatile("s_waitcnt vmcnt(0)" ::: "memory");
    if (STG2 == 1) return;
#define WSYNC() asm volatile("s_waitcnt lgkmcnt(0)" ::: "memory")
    for (int row = 0; row < 4; ++row) {
        const unsigned* sc = SCB + (size_t)row * T;
        unsigned kv[128];
#pragma unroll
        for (int j = 0; j < 128; ++j) kv[j] = 0u;
        { int njl = nj; asm volatile("" : "+s"(njl));
#pragma unroll
        for (int j = 0; j < 128; ++j) { if (j < njl) kv[j] = sc[64 * j + lane]; } }
        unsigned prefix, kth = 256u;
        LAS unsigned* hrow = hist + row * 256;
        {   unsigned hw[4]; unsigned tot = 0u;
#pragma unroll
            for (int i = 0; i < 4; ++i) { hw[i] = hrow[4 * lane + i]; tot += (hw[i] & 0xffffu) + (hw[i] >> 16); }
            unsigned suf = tot;
#pragma unroll
            for (int o = 1; o < 64; o <<= 1) { const unsigned x = sidxu(suf, lane + o); if (lane + o < 64) suf += x; }
            const unsigned above = suf - tot;
            unsigned selv = 0u, selk = 0u; const bool mine = (suf >= kth && above < kth);
            if (mine) { unsigned cnt = above; int bin = 0; bool found = false;
#pragma unroll
                for (int i = 7; i >= 0; --i) { const unsigned c = (i & 1) ? (hw[i >> 1] >> 16) : (hw[i >> 1] & 0xffffu);
                    if (!found) { if (cnt + c >= kth) { bin = i; found = true; } else cnt += c; } }
                selv = (unsigned)(8 * lane + bin); selk = kth - cnt; }
            const unsigned long long bm = __ballot(mine); const int src = (int)__builtin_ctzll(bm ? bm : 1ull);
            prefix = sidxu(selv, src); kth = sidxu(selk, src);
            WSYNC();
        }
#pragma unroll
        for (int pass = 1; pass < 3; ++pass) {
            const int shift = (pass == 1) ? 7 : 0, hshift = (pass == 1) ? 15 : 7; const unsigned dmask = (pass == 1) ? 255u : 127u;
#pragma unroll
            for (int i = 0; i < 4; ++i) hrow[64 * i + lane] = 0u;
            WSYNC();
            { int njl = nj; asm volatile("" : "+s"(njl));
#pragma unroll
            for (int j = 0; j < 128; ++j) { if (j < njl) { const unsigned key = kv[j];
                if ((key >> hshift) == prefix) __hip_atomic_fetch_add(&hrow[(key >> shift) & dmask], 1u, __ATOMIC_RELAXED, __HIP_MEMORY_SCOPE_WORKGROUP); } } }
            WSYNC();
            const unsigned h0 = hrow[4 * lane], h1 = hrow[4 * lane + 1], h2 = hrow[4 * lane + 2], h3 = hrow[4 * lane + 3];
            unsigned suf = h0 + h1 + h2 + h3;
#pragma unroll
            for (int o = 1; o < 64; o <<= 1) { const unsigned x = sidxu(suf, lane + o); if (lane + o < 64) suf += x; }
            const unsigned above = suf - (h0 + h1 + h2 + h3);
            unsigned selv = 0u, selk = 0u; const bool mine = (suf >= kth && above < kth);
            if (mine) { unsigned cnt = above; int bin;
                if (cnt + h3 >= kth) { bin = 3; } else { cnt += h3; if (cnt + h2 >= kth) { bin = 2; } else { cnt += h2; if (cnt + h1 >= kth) { bin = 1; } else { cnt += h1; bin = 0; } } }
                selv = (unsigned)(4 * lane + bin); selk = kth - cnt; }
            const unsigned long long bm = __ballot(mine); const int src = (int)__builtin_ctzll(bm ? bm : 1ull);
            prefix = (prefix << ((pass == 1) ? 8 : 7)) | sidxu(selv, src); kth = sidxu(selk, src);
            WSYNC();
        }
        if (STG2 == 2) { if (prefix == 0xdeadbeefu) MK[0] = kth; continue; }
        { int njl = nj; asm volatile("" : "+s"(njl));
#pragma unroll
        for (int j = 0; j < 128; ++j) { if (j < njl) { const unsigned long long bal = __ballot(kv[j] >= prefix);
            if (lane == 0) { wb[(2 * j) * 4 + row] = (unsigned)bal; wb[(2 * j + 1) * 4 + row] = (unsigned)(bal >> 32); } } } }
    }
    WSYNC();
    for (int kb = lane; kb < nkb; kb += 64) { const u32x4 v = *(const LAS u32x4*)(wb + kb * 4); *(u32x4*)(MK + (size_t)kb * T + t0) = v; }
    WSYNC();
#undef WSYNC
}

__device__ __forceinline__ int qn(unsigned* ctr, volatile LAS unsigned* slot, int lo, int hi) { const int v = q_next(ctr, slot) + lo; return v < hi ? v : 0x7fffffff; }
constexpr int IT_A = 16, IT_B = 32, IT_C = 32 + 1024, IT_D = IT_C + NB * (T / 32);
template <int ISTG>
__device__ __forceinline__ void mixer_a_phase(const Frame& F, KA* ap, int l, unsigned* qctr, int it_lo, int it_hi) {
    volatile LAS unsigned* slot = (volatile LAS unsigned*)(F.lds + LDS_MISC) + 16;
    unsigned char* ws = ap->ws;
    int it = qn(qctr, slot, it_lo, it_hi);
#ifndef NO_A
    while (it < IT_A) { hgrn_scan(F, ap, l, it); it = qn(qctr, slot, it_lo, it_hi); }
#endif
#ifndef NO_B
    while (it < IT_B) { mlstm_scan(F, ap, l, it - IT_A); it = qn(qctr, slot, it_lo, it_hi); }
#endif
    {
        const bf16_t* PROJ = (const bf16_t*)(ws + WS_PROJ); float* CATT = (float*)(ws + WS_CATT);
        att::Seam S;
        while (it < IT_C) {
            const int i = it - IT_B, y = 31 - (i >> 5), r = i & 31, b = r >> 4, vh = r & 15, h = vh >> 2, mm = (vh >> 1) & 1, vhalf = vh & 1;
            const bf16_t* base = PROJ + (size_t)b * T * LDP;
            att::BlockRef<float> r0;
            r0.Q = base + (size_t)(y * 256) * LDP + C_CQ + (h * 2 + mm) * 128; r0.K = base + C_CK + (h * 2 + mm) * 128; r0.V = base + C_CV + h * 256 + vhalf * 128;
            r0.O = CATT + ((size_t)b * T + y * 256) * 2048 + mm * 1024 + h * 256 + vhalf * 128; r0.MK = nullptr; r0.P0 = y * 256; r0.orow = 0; r0.ocol = 0;
#ifndef NO_C
            att::attn_prime<float>(r0, (char*)F.lds, S);
            att::attn_block<float, false, 2048>(r0, r0, (char*)F.lds, S);
#endif
            it = qn(qctr, slot, it_lo, it_hi);
        }
    }
#ifndef NO_D
    while (it < IT_D) { dsa_index_item2<4>(F, ap, it - IT_C); it = qn(qctr, slot, it_lo, it_hi); }
#endif
}
__device__ __forceinline__ void mixer_b_phase(const Frame& F, KA* ap, int l, unsigned* qctr) {
    volatile LAS unsigned* slot = (volatile LAS unsigned*)(F.lds + LDS_MISC) + 16;
    unsigned char* ws = ap->ws;
    const bf16_t* PROJ = (const bf16_t*)(ws + WS_PROJ); bf16_t* Y = (bf16_t*)(ws + WS_Y); const unsigned* MASK = (const unsigned*)(ws + WS_MASK);
    att::Seam S;
    int it = q_next(qctr, slot);
    while (it < 512) {
        const int y = 31 - (it >> 4), r = it & 15, b = r >> 3, h = r & 7;
        const bf16_t* base = PROJ + (size_t)b * T * LDP;
        att::BlockRef<bf16_t> r0;
        r0.Q = base + (size_t)(y * 256) * LDP + C_DQ + h * 128; r0.K = base + C_DK + h * 128; r0.V = base + C_DV + h * 128;
        r0.O = Y; r0.orow = b * T + y * 256; r0.ocol = 3072 + h * 128; r0.MK = MASK + (size_t)b * 256 * T; r0.P0 = y * 256;
#ifndef NO_E
        att::attn_prime<bf16_t>(r0, (char*)F.lds, S);
        att::attn_block<bf16_t, true, DM>(r0, r0, (char*)F.lds, S);
#endif
        it = q_next(qctr, slot);
    }
#ifndef NO_G
    { const Frame F2 = make_frame(F.lds); ccombine_phase(F2, ap, l); }
#endif
}

__global__ void __launch_bounds__(512, 2) mk_fwd(Args args) {
    extern __shared__ __attribute__((aligned(16))) unsigned char lds_raw[];
    LAS unsigned char* lds = (LAS unsigned char*)lds_raw;
    volatile LAS unsigned* MISC = (volatile LAS unsigned*)(lds + LDS_MISC);
    if (threadIdx.x < 64) MISC[threadIdx.x] = 0u;
    if ((threadIdx.x & 63) == 0) *(volatile LAS unsigned*)(lds + LDS_WTAB + ((unsigned)__builtin_amdgcn_s_getreg((5 << 11) | 4) & 63u) * 4) = threadIdx.x >> 6;
    __syncthreads();
    if (my_tid() != (int)threadIdx.x) __builtin_trap();
    const int lo = args.ph_lo, hi = args.ph_hi;
    XcdBarrier bar; bar.bar = (unsigned*)(args.ws + WS_CTL) + CW_BAR; bar.x = 0; bar.st = nullptr;
    if (hi - lo > 1) bar = xcd_barrier_post((unsigned*)(args.ws + WS_CTL) + CW_BAR, MISC + 8);
#define IN(k) (lo <= (k) && (k) < hi)
#define SEAM(k) do { if (IN(k) && IN((k) + 1)) { XcdBarrier b_; b_.bar = (unsigned*)(PH_ARGS()->ws + WS_CTL) + CW_BAR; b_.x = xb_xcc_id(); b_.st = MISC + 8; xcd_barrier(b_); } } while (0)

#ifndef REP_P0
#define REP_P0 1
#endif
    if (IN(0)) { for (int rep = 0; rep < REP_P0; ++rep) { KA* ap = PH_ARGS(); const Frame F = make_frame(lds); p0_prologue(F, ap); } SEAM(0); }

#pragma unroll
    for (int l = 0; l < DEPTH; ++l) {
        const int pb = 1 + 9 * l;
        if (IN(pb + 0)) {
            KA* ap = PH_ARGS(); unsigned char* ws = ap->ws;
            pg8::Gemm g{(const bf16_t*)(ws + WS_XB), (const bf16_t*)(ws + WS_WIN + l * SZ_WIN), M, LDP, DM, DM}; pg8::StaticOrder S; S.init(M, LDP, gridDim.x, (int)blockIdx.x);
            EpiInProj E{(bf16_t*)(ws + WS_PROJ), (float*)(ws + WS_GLOG), (float*)(ws + WS_ODD), (const float*)(ws + WS_LB) + l * 1024, ap->in[6] + l * 16, (const float*)(ws + WS_SSQP), ap->in[8] + l * 256, ap->in[11] + l * 256, (LAS float*)(lds + 131072), (LAS float*)(lds + 139264), (volatile LAS int*)(MISC + 28), (float*)(ws + WS_RS)};
            if (my_tid() == 0) MISC[28] = 0xFFFFFFFFu;
#ifndef REP_G1
#define REP_G1 1
#endif
            for (int rep = 0; rep < REP_G1; ++rep) pg8::gemm_phase<EpiInProj, pg8::StaticOrder>(lds, g, S, E);
            { pg8::Gemm g2{(const bf16_t*)(ws + WS_XB), (const bf16_t*)(ws + WS_WIN + l * SZ_WIN) + (size_t)56 * 256 * DM, M, 256, DM / 4, DM}; pg8::SplitKOrder S2; S2.init(M, 4, gridDim.x, (int)blockIdx.x);
              EpiOddPart E2{(float*)(ws + WS_Y)};
              pg8::gemm_phase<EpiOddPart, pg8::SplitKOrder>(lds, g2, S2, E2); }
            if (l == 0) { KA* apb = PH_ARGS(); const Frame Fb = make_frame(lds); bg_convert(Fb, apb, (unsigned*)(apb->ws + WS_CTL) + CW_BGQ + 64 * (1 + 0), false); }
            SEAM(pb + 0);
        }
#ifndef NO_F
        if (IN(pb + 1)) { { KA* ap = PH_ARGS(); const Frame F = make_frame(lds); fixup_phase<false>(F, ap, l); }
#ifdef REP_FX
            for (int rep = 0; rep < REP_FX; ++rep) { KA* ap = PH_ARGS(); const Frame F = make_frame(lds); fixup_phase<true>(F, ap, l); }
#endif
            if (l == 0) { KA* apb = PH_ARGS(); const Frame Fb = make_frame(lds); bg_convert(Fb, apb, (unsigned*)(apb->ws + WS_CTL) + CW_BGQ + 64 * (1 + 4), false); } SEAM(pb + 1); }
#endif
        if (IN(pb + 2)) {
#ifndef REP_A
#define REP_A 1
#endif
#ifdef PROBE_LO
            for (int rep = 0; rep < 2; ++rep)
            { KA* ap = PH_ARGS(); const Frame F = make_frame(lds); mixer_a_phase<4>(F, ap, l, (unsigned*)(ap->ws + WS_CTL) + CW_Q + 64 * (2 * l) + 16 * rep, rep ? PROBE_LO : 0, rep ? PROBE_HI : IT_D); }
#else
            if (l == 0 && blockIdx.x < NCVW) { KA* apc = PH_ARGS(); const Frame Fc = make_frame(lds); conv_side(Fc, apc); }
            { KA* ap = PH_ARGS(); const Frame F = make_frame(lds); mixer_a_phase<4>(F, ap, l, (unsigned*)(ap->ws + WS_CTL) + CW_Q + 64 * (2 * l), 0, IT_D); }
#endif
            if (l == 0) { KA* apb = PH_ARGS(); const Frame Fb = make_frame(lds); bg_convert(Fb, apb, (unsigned*)(apb->ws + WS_CTL) + CW_BGQ + 64 * (1 + 5), false); } SEAM(pb + 2); }
        if (IN(pb + 3)) {
#ifndef REP_B
#define REP_B 1
#endif
            for (int rep = 0; rep < REP_B; ++rep) { KA* ap = PH_ARGS(); const Frame F = make_frame(lds); mixer_b_phase(F, ap, l, (unsigned*)(ap->ws + WS_CTL) + CW_Q + 64 * (2 * l + 1) + 16 * rep); }
            if (l == 0) { KA* apb = PH_ARGS(); const Frame Fb = make_frame(lds); bg_convert(Fb, apb, (unsigned*)(apb->ws + WS_CTL) + CW_BGQ + 64 * (1 + 6), false); } SEAM(pb + 3); }
        if (IN(pb + 4)) {
            KA* ap = PH_ARGS(); unsigned char* ws = ap->ws;
            pg8::Gemm g{(const bf16_t*)(ws + WS_Y), (const bf16_t*)(ws + WS_WOUT + l * SZ_WOUT), M, DM, DM, DM}; pg8::StaticOrder S; S.init(M, DM, gridDim.x, (int)blockIdx.x);
            EpiResidBf E{(bf16_t*)(ws + WS_XB), (float*)(ws + WS_SSQP)};
            pg8::gemm_phase<EpiResidBf, pg8::StaticOrder>(lds, g, S, E);
            if (l == 0) { KA* apb = PH_ARGS(); const Frame Fb = make_frame(lds); bg_convert(Fb, apb, (unsigned*)(apb->ws + WS_CTL) + CW_BGQ + 64 * (1 + 1), false); }
            SEAM(pb + 4);
        }
#ifndef REP_RN
#define REP_RN 1
#endif
        if (IN(pb + 6)) {
            KA* ap = PH_ARGS(); unsigned char* ws = ap->ws;
            pg8::Gemm g{(const bf16_t*)(ws + WS_XB), (const bf16_t*)(ws + WS_W1 + l * SZ_W1), M, FF, DM, DM}; pg8::StaticOrder S; S.init(M, FF, gridDim.x, (int)blockIdx.x);
            EpiRelu2 E{(bf16_t*)(ws + WS_PROJ), (const float*)(ws + WS_SSQP), (LAS float*)(lds + 139264), (volatile LAS int*)(MISC + 28)};
            if (my_tid() == 0) MISC[28] = 0xFFFFFFFFu;
#ifndef REP_G3
#define REP_G3 1
#endif
            for (int rep = 0; rep < REP_G3; ++rep) pg8::gemm_phase<EpiRelu2, pg8::StaticOrder>(lds, g, S, E);
            if (l == 0) { KA* apb = PH_ARGS(); const Frame Fb = make_frame(lds); bg_convert(Fb, apb, (unsigned*)(apb->ws + WS_CTL) + CW_BGQ + 64 * (1 + 2), false); }
            SEAM(pb + 6);
        }
        if (IN(pb + 7)) {
            KA* ap = PH_ARGS(); unsigned char* ws = ap->ws;
            pg8::Gemm g{(const bf16_t*)(ws + WS_PROJ), (const bf16_t*)(ws + WS_W2 + l * SZ_W2), M, DM, FF, FF}; pg8::StaticOrder S; S.init(M, DM, gridDim.x, (int)blockIdx.x);
            if (l + 1 < DEPTH) { EpiResidBf E{(bf16_t*)(ws + WS_XB), (float*)(ws + WS_SSQP)}; pg8::gemm_phase<EpiResidBf, pg8::StaticOrder>(lds, g, S, E); }
            else { EpiFinal E{(const bf16_t*)(ws + WS_XB), ap->out}; pg8::gemm_phase<EpiFinal, pg8::StaticOrder>(lds, g, S, E); }
            if (l == 0) { KA* apb = PH_ARGS(); const Frame Fb = make_frame(lds); bg_convert(Fb, apb, nullptr, true); }
            SEAM(pb + 7);
        }
    }
#undef IN
#undef SEAM
}

extern "C" void kernel_launch(void* const* d_in, const int* in_sizes, int n_in, void* d_out, int out_size, void* d_ws, size_t ws_size, hipStream_t stream) {
    static int grid = 0;
    if (grid == 0) {
        if (n_in != 17 || in_sizes[0] != M * DM || out_size != M * DM || ws_size < WS_END) { fprintf(stderr, "kernel_launch: unexpected shapes (n_in %d in0 %d out %d ws %zu need %zu)\n", n_in, in_sizes[0], out_size, ws_size, (size_t)WS_END); grid = -1; return; }
        int dev = 0, cus = 0;
        if (hipGetDevice(&dev) != hipSuccess || hipDeviceGetAttribute(&cus, hipDeviceAttributeMultiprocessorCount, dev) != hipSuccess) { grid = -1; return; }
        if (hipFuncSetAttribute((const void*)mk_fwd, hipFuncAttributeMaxDynamicSharedMemorySize, LDS_BYTES) != hipSuccess) { fprintf(stderr, "kernel_launch: hipFuncSetAttribute failed\n"); grid = -1; return; }
        int per_cu = 0;
        if (hipOccupancyMaxActiveBlocksPerMultiprocessor(&per_cu, (const void*)mk_fwd, 512, LDS_BYTES) != hipSuccess || per_cu < 1) fprintf(stderr, "kernel_launch: occupancy query reports %d\n", per_cu);
        (void)hipGetLastError();
        grid = cus < 256 ? cus : 256;
    }
    if (grid < 0) return;
    if (hipMemsetAsync((char*)d_ws + WS_CTL, 0, CTL_BYTES, stream) != hipSuccess) return;
    Args a{};
    for (int i = 0; i < 17; ++i) a.in[i] = (const float*)d_in[i];
    a.out = (float*)d_out; a.ws = (unsigned char*)d_ws;
#if ONE_LAUNCH
    a.ph_lo = 0; a.ph_hi = NPHASE;
    hipLaunchKernelGGL(mk_fwd, dim3(grid), dim3(512), LDS_BYTES, stream, a);
#else
    for (int p = 0; p < NPHASE; ++p) { a.ph_lo = p; a.ph_hi = p + 1; hipLaunchKernelGGL(mk_fwd, dim3(grid), dim3(512), LDS_BYTES, stream, a); }
#endif
}
```

```cpp
#include <hip/hip_runtime.h>
#include <cstdio>
#include <cstdint>

#ifndef ONE_LAUNCH
#define ONE_LAUNCH 1
#endif

#define LAS __attribute__((address_space(3)))
typedef unsigned short bf16_t;
typedef short bf16x8 __attribute__((ext_vector_type(8)));
typedef short s16x4 __attribute__((ext_vector_type(4)));
typedef float f32x2 __attribute__((ext_vector_type(2)));
typedef float f32x4 __attribute__((ext_vector_type(4)));
typedef float f32x16 __attribute__((ext_vector_type(16)));
typedef unsigned u32x2 __attribute__((ext_vector_type(2)));
typedef unsigned u32x4 __attribute__((ext_vector_type(4)));

constexpr int T = 8192, NB = 2, M = NB * T, DM = 4096, FF = 16384, DEPTH = 2;
constexpr int NIN = 14432, NINP = 14592;
constexpr int LDP = 14336;
constexpr int C_AQ = 0, C_AF = 1024, C_AI = 2048, C_AG = 3072, C_BQK = 4096, C_BV = 5120, C_BO = 6144;
constexpr int C_CQ = 7168, C_CK = 8192, C_CV = 9216, C_DQ = 10240, C_DK = 11264, C_DV = 12288, C_DQI = 13312;
constexpr int LDO = 128;
constexpr float EPS = 1e-6f;

constexpr size_t MiB = 1u << 20;
constexpr size_t WS_CTL = 0, CTL_BYTES = 2 * MiB;
constexpr size_t SZ_WIN = (size_t)NINP * DM * 2, SZ_WOUT = (size_t)DM * DM * 2, SZ_W1 = (size_t)FF * DM * 2, SZ_W2 = (size_t)DM * FF * 2;
constexpr size_t WS_WIN = WS_CTL + CTL_BYTES;
constexpr size_t WS_WOUT = WS_WIN + 2 * SZ_WIN;
constexpr size_t WS_W1 = WS_WOUT + 2 * SZ_WOUT;
constexpr size_t WS_W2 = WS_W1 + 2 * SZ_W1;
constexpr size_t WS_XB = WS_W2 + 2 * SZ_W2;
constexpr size_t WS_PROJ = WS_XB + (size_t)M * DM * 2;
constexpr size_t WS_GLOG = WS_PROJ + (size_t)M * LDP * 2;
constexpr size_t WS_ODD = WS_GLOG + (size_t)M * 1024 * 4;
constexpr size_t WS_Y = WS_ODD + (size_t)M * LDO * 4;
constexpr size_t WS_MASK = WS_Y + (size_t)M * DM * 2;
constexpr size_t WS_BQK = WS_MASK + (size_t)NB * 256 * T * 4;
constexpr size_t WS_KI = WS_BQK + (size_t)M * 1024 * 2;
constexpr size_t WS_LB = WS_KI + (size_t)M * 64 * 2;
constexpr size_t WS_SCB = WS_LB + 65536;
constexpr size_t WS_CATT = WS_SCB + (size_t)256 * 8 * 4 * T * 4;
constexpr size_t WS_SSQP = WS_CATT + (size_t)M * 2048 * 4;
constexpr size_t WS_RS = WS_SSQP + (size_t)64 * M * 4;
constexpr size_t WS_END = WS_RS + (size_t)M * 4;
static_assert((size_t)M * LDP * 2 + (size_t)M * 1024 * 4 == (size_t)M * FF * 2, "HID overlay");

constexpr int CW_BAR = 1024;
constexpr int CW_BGQ = 12288;
constexpr int CW_Q = 8192;

constexpr int LDS_BYTES = 147456;
constexpr int LDS_MISC = LDS_BYTES - 512;
constexpr int LDS_WTAB = LDS_BYTES - 256;
constexpr int NPHASE = 1 + 9 * DEPTH;

__host__ __device__ __forceinline__ size_t tiled_off(size_t row, int col, int K) { return ((((row >> 8) * (size_t)(K >> 6)) + (size_t)(col >> 6)) * 256 + (row & 255)) * 64 + (col & 63); }
__device__ __forceinline__ unsigned cvt_pk_bf16(float lo, float hi) { unsigned r; asm volatile("v_cvt_pk_bf16_f32 %0, %1, %2" : "=v"(r) : "v"(lo), "v"(hi)); return r; }
__device__ __forceinline__ float bf_lo(unsigned u) { return __uint_as_float(u << 16); }
__device__ __forceinline__ float bf_hi(unsigned u) { return __uint_as_float(u & 0xffff0000u); }
__device__ __forceinline__ float bf2f(bf16_t b) { return __uint_as_float(((unsigned)b) << 16); }
__device__ __forceinline__ float fast_sigmoid(float v) { return __builtin_amdgcn_rcpf(1.f + __expf(-v)); }
__device__ __forceinline__ float fast_silu(float v) { return v * fast_sigmoid(v); }
__device__ __forceinline__ int my_tid() {
    unsigned lane; asm volatile("v_mbcnt_lo_u32_b32 %0, -1, 0\n\tv_mbcnt_hi_u32_b32 %0, -1, %0" : "=v"(lane));
    const unsigned slot = (unsigned)__builtin_amdgcn_s_getreg((5 << 11) | 4) & 63u;
    const unsigned wv = *(volatile LAS unsigned*)(uintptr_t)(LDS_WTAB + slot * 4);
    return __builtin_amdgcn_readfirstlane((int)wv) * 64 + (int)lane;
}
__device__ __forceinline__ float sx(float v, int o, int lane) { return __int_as_float(__builtin_amdgcn_ds_bpermute((lane ^ o) << 2, __float_as_int(v))); }
#define DPPF(v, ctrl) __int_as_float(__builtin_amdgcn_update_dpp(0, __float_as_int(v), (ctrl), 0xf, 0xf, true))
__device__ __forceinline__ float xrow16_sum(float x) {
    auto s = __builtin_amdgcn_permlane16_swap(__float_as_uint(x), __float_as_uint(x), false, false);
    x = __uint_as_float(s[0]) + __uint_as_float(s[1]);
    auto t = __builtin_amdgcn_permlane32_swap(__float_as_uint(x), __float_as_uint(x), false, false);
    return __uint_as_float(t[0]) + __uint_as_float(t[1]);
}
__device__ __forceinline__ float sum8(float v) { v += DPPF(v, 0xB1); v += DPPF(v, 0x4E); v += DPPF(v, 0x141); return v; }
__device__ __forceinline__ float sum16(float v) { v = sum8(v); v += DPPF(v, 0x140); return v; }
__device__ __forceinline__ float sidx(float v, int src) { return __int_as_float(__builtin_amdgcn_ds_bpermute(src << 2, __float_as_int(v))); }
__device__ __forceinline__ unsigned sidxu(unsigned v, int src) { return (unsigned)__builtin_amdgcn_ds_bpermute(src << 2, (int)v); }
__device__ __forceinline__ u32x4 zero4() { unsigned z = 0u; asm volatile("" : "+v"(z)); return (u32x4){z, z, z, z}; }

namespace pg8 {
constexpr int BM = 256, BK = 64, HALF = 128, HTB = HALF * BK * 2, STAGE_BYTES = 8 * HTB, NXCD = 8, WGM = 8;
__host__ __device__ __forceinline__ int lds_byte(int r, int c) { const int st = (r >> 4) * 2 + (c >> 5), rr = r & 15, cc = c & 31, ob = rr * 64 + cc * 2; return st * 1024 + (ob ^ (((ob >> 9) & 1) << 5)); }
__host__ __device__ __forceinline__ void stage_rc(int b, int& R, int& C) { const int st = b / 1024, sb = b % 1024, swz = sb ^ (((sb >> 9) & 1) << 5); R = (st >> 1) * 16 + swz / 64; C = (st & 1) * 32 + (swz % 64) / 2; }
__host__ __device__ __forceinline__ int perm32(int rho) { const int n = rho >> 4, i = rho & 15; return 8 * (i >> 2) + 4 * n + (i & 3); }
struct Unit { int pm, pn; };
struct Gemm { const bf16_t* A; const bf16_t* Bt; int M, N, K, Kld; };
struct StaticOrder {
    int nM, nN, nwg, G, c;
    __host__ __device__ void init(int M_, int N_, int G_, int c_) { nM = M_ / BM; nN = N_ / BM; nwg = nM * nN; G = G_; c = c_; }
    __host__ __device__ bool next(int i, Unit& u) const {
        const long L = (long)i * G + c; if (L >= nwg) return false;
        int wgid = (int)L; { const int q = nwg / NXCD, r = nwg % NXCD, xcd = wgid % NXCD, off = wgid / NXCD; wgid = (xcd < r ? xcd * (q + 1) : r * (q + 1) + (xcd - r) * q) + off; }
        const int nig = WGM * nN, gid = wgid / nig, fm = gid * WGM, gsz = (nM - fm) < WGM ? (nM - fm) : WGM;
        u.pm = fm + ((wgid % nig) % gsz); u.pn = (wgid % nig) / gsz; return true;
    }
    __device__ __forceinline__ void a_ready(const Unit&) const {}
    __device__ __forceinline__ void done(const Unit&) const {}
    __device__ __forceinline__ size_t aoff(const Unit& u, size_t tstep, size_t) const { return (size_t)u.pm * tstep; }
    __device__ __forceinline__ size_t boff(const Unit& u, size_t tstep, size_t) const { return (size_t)u.pn * tstep; }
};
struct SplitKOrder {
    int G, c, nunits, nsplit;
    __device__ void init(int M_, int nsplit_, int G_, int c_) { nsplit = nsplit_; nunits = (M_ / BM) * nsplit_; G = G_; c = c_; }
    __device__ bool next(int i, Unit& u) const { const int L = i * G + c; if (L >= nunits) return false; u.pm = L / nsplit; u.pn = L % nsplit; return true; }
    __device__ __forceinline__ void a_ready(const Unit&) const {}
    __device__ __forceinline__ size_t aoff(const Unit& u, size_t tstep, size_t kspan) const { return (size_t)u.pm * tstep + (size_t)u.pn * kspan; }
    __device__ __forceinline__ size_t boff(const Unit& u, size_t, size_t kspan) const { return (size_t)u.pn * kspan; }
};

template <class Epi, class Sched>
__device__ __forceinline__ void gemm_phase(LAS unsigned char* lds, const Gemm g, const Sched& S, const Epi& E) {
    const int tid_ = my_tid();
    const int tid = tid_, wid = __builtin_amdgcn_readfirstlane(tid >> 6), lane = tid & 63, wr = wid >> 2, wc = wid & 3, fr = lane & 15, fq = lane >> 4;
    const int K = g.K, nt = K / BK;
    unsigned voffA[2], voffB[2];
#pragma unroll
    for (int i = 0; i < 2; ++i) { int R, C; stage_rc(tid * 16 + i * 8192, R, C); const int Rb = Epi::PERM ? ((R & ~31) + perm32(R & 31)) : R;
        voffA[i] = (unsigned)(R * 64 + C) * 2u; voffB[i] = (unsigned)(Rb * 64 + C) * 2u; }
    const size_t kstep = (size_t)(BM * BK * 2);
    const size_t hstep = (size_t)HALF * BK * 2;
    const size_t tstep = (size_t)BM * g.Kld * 2, kspan = (size_t)nt * kstep;
    const unsigned ldsw = (unsigned)wid * 1024u;
    const int aoff = lds_byte(wr * 64 + fr, fq * 8), boff = lds_byte(wc * 32 + fr, fq * 8);
#define PG8_SA(b, h) (((b) * 2 + (h)) * HTB)
#define PG8_SB(b, h) ((4 + (b) * 2 + (h)) * HTB)
#define PG8_STAGE(bufoff, gbase, voff) do { _Pragma("unroll") for (int _i = 0; _i < 2; ++_i) \
        __builtin_amdgcn_global_load_lds((const unsigned*)((const char*)(gbase) + (voff)[_i]), (LAS unsigned*)(lds + (bufoff) + ldsw + _i * 8192), 16, 0, 0); } while (0)
#define PG8_LDA(dst, b, h) do { _Pragma("unroll") for (int m = 0; m < 4; ++m) _Pragma("unroll") for (int k = 0; k < 2; ++k) dst[m][k] = *(const LAS bf16x8*)(lds + PG8_SA(b, h) + aoff + m * 2048 + k * 1024); } while (0)
#define PG8_LDB(dst, b, h) do { _Pragma("unroll") for (int n = 0; n < 2; ++n) _Pragma("unroll") for (int k = 0; k < 2; ++k) dst[n][k] = *(const LAS bf16x8*)(lds + PG8_SB(b, h) + boff + n * 2048 + k * 1024); } while (0)
#define PG8_MMA(ai, bj, At, Bt) do { __builtin_amdgcn_s_setprio(1); _Pragma("unroll") for (int m = 0; m < 4; ++m) _Pragma("unroll") for (int n = 0; n < 2; ++n) _Pragma("unroll") for (int k = 0; k < 2; ++k) \
        acc[ai][bj][m][n] = __builtin_amdgcn_mfma_f32_16x16x32_bf16(Bt[n][k], At[m][k], acc[ai][bj][m][n], 0, 0, 0); __builtin_amdgcn_s_setprio(0); } while (0)
#define PG8_WAIT_V(n) asm volatile("s_waitcnt vmcnt(" #n ")" ::: "memory")
#define PG8_WAIT_L(n) asm volatile("s_waitcnt lgkmcnt(" #n ")" ::: "memory")
#define PG8_BAR __builtin_amdgcn_s_barrier()
#define PG8_SCHED __builtin_amdgcn_sched_barrier(0)
    Unit cur, nxt; int ui = 0;
    if (!S.next(0, cur)) return;
    f32x4 acc[2][2][4][2];
#pragma unroll
    for (int a = 0; a < 2; ++a)
#pragma unroll
        for (int b = 0; b < 2; ++b)
#pragma unroll
            for (int m = 0; m < 4; ++m)
#pragma unroll
                for (int n = 0; n < 2; ++n) acc[a][b][m][n] = (f32x4){0.f, 0.f, 0.f, 0.f};
    bf16x8 At[4][2], B0[2][2], B1[2][2];
    const char* cA = (const char*)g.A + S.aoff(cur, tstep, kspan); const char* cB = (const char*)g.Bt + S.boff(cur, tstep, kspan);
    S.a_ready(cur);
    PG8_STAGE(PG8_SB(0, 0), cB, voffB); PG8_STAGE(PG8_SB(0, 1), cB + hstep, voffB); PG8_STAGE(PG8_SA(0, 0), cA, voffA); PG8_STAGE(PG8_SA(0, 1), cA + hstep, voffA);
    if (wr == 1) PG8_BAR;
    PG8_WAIT_V(2); PG8_BAR;
    PG8_STAGE(PG8_SB(1, 0), cB + kstep, voffB); PG8_STAGE(PG8_SA(1, 0), cA + kstep, voffA); PG8_STAGE(PG8_SB(1, 1), cB + hstep + kstep, voffB);
    PG8_WAIT_V(6); PG8_BAR;
    for (;;) {
        const bool has_next = S.next(ui + 1, nxt);
        const char* nA = has_next ? (const char*)g.A + S.aoff(nxt, tstep, kspan) : cA; const char* nB = has_next ? (const char*)g.Bt + S.boff(nxt, tstep, kspan) : cB;
        for (int t = 0; t < nt; t += 2) {
            const bool last = (t == nt - 2);
            const char* a1 = cA + (size_t)(t + 1) * kstep;
            const char* a2 = last ? nA : cA + (size_t)(t + 2) * kstep; const char* b2 = last ? nB : cB + (size_t)(t + 2) * kstep;
            const char* a3 = a2 + kstep; const char* b3 = b2 + kstep;
            if (last && has_next) S.a_ready(nxt);
            PG8_LDB(B0, 0, 0); PG8_LDB(B1, 0, 1); PG8_SCHED; PG8_LDA(At, 0, 0); PG8_STAGE(PG8_SA(1, 1), a1 + hstep, voffA);
            PG8_WAIT_V(8); PG8_WAIT_L(0); PG8_BAR; PG8_MMA(0, 0, At, B0); if constexpr (!Epi::HALF_ALL) PG8_MMA(0, 1, At, B1); PG8_BAR; PG8_SCHED;
            PG8_LDA(At, 0, 1); PG8_STAGE(PG8_SB(0, 0), b2, voffB); PG8_STAGE(PG8_SB(0, 1), b2 + hstep, voffB); PG8_STAGE(PG8_SA(0, 0), a2, voffA);
            PG8_WAIT_V(8); PG8_WAIT_L(0); PG8_BAR; PG8_MMA(1, 0, At, B0); if constexpr (!Epi::HALF_ALL) PG8_MMA(1, 1, At, B1); PG8_BAR; PG8_SCHED;
            PG8_LDB(B0, 1, 0); PG8_LDB(B1, 1, 1); PG8_SCHED; PG8_LDA(At, 1, 0); PG8_STAGE(PG8_SA(0, 1), a2 + hstep, voffA);
            PG8_WAIT_V(8); PG8_WAIT_L(0); PG8_BAR; PG8_MMA(0, 0, At, B0); if constexpr (!Epi::HALF_ALL) PG8_MMA(0, 1, At, B1); PG8_BAR; PG8_SCHED;
            PG8_LDA(At, 1, 1); PG8_STAGE(PG8_SB(1, 0), b3, voffB); PG8_STAGE(PG8_SB(1, 1), b3 + hstep, voffB); PG8_STAGE(PG8_SA(1, 0), a3, voffA);
            PG8_WAIT_V(8); PG8_WAIT_L(0); PG8_BAR; PG8_MMA(1, 0, At, B0); if constexpr (!Epi::HALF_ALL) PG8_MMA(1, 1, At, B1); PG8_BAR; PG8_SCHED;
        }
        if (wr == 0) PG8_BAR;
        E(acc, cur, wr, wc, fr, fq);
        if (!has_next) break;
#pragma unroll
        for (int a = 0; a < 2; ++a)
#pragma unroll
            for (int b = 0; b < 2; ++b)
#pragma unroll
                for (int m = 0; m < 4; ++m)
#pragma unroll
                    for (int n = 0; n < 2; ++n) acc[a][b][m][n] = (f32x4){0.f, 0.f, 0.f, 0.f};
        cur = nxt; cA = nA; cB = nB; ++ui;
        if (wr == 1) PG8_BAR;
    }
    PG8_WAIT_V(0);
    PG8_BAR;
#undef PG8_SA
#undef PG8_SB
#undef PG8_STAGE
#undef PG8_LDA
#undef PG8_LDB
#undef PG8_MMA
#undef PG8_WAIT_V
#undef PG8_WAIT_L
#undef PG8_BAR
#undef PG8_SCHED
}
}

__device__ __forceinline__ void rs_panel(const float* SSQP, int pm, LAS float* rsl, volatile LAS int* tag, int tid, float* rsg = nullptr) {
    if (*tag == pm) return;
    const int row = tid >> 1, h = tid & 1; const float* p = SSQP + (size_t)(h * 32) * M + pm * 256 + row; float s = 0.f;
#pragma unroll 8
    for (int j = 0; j < 32; ++j) s += p[(size_t)j * M];
    s += DPPF(s, 0xB1);
    __syncthreads();
    if (h == 0) { const float rv = 1.f / sqrtf(s * (1.f / DM) + EPS); rsl[row] = rv; if (rsg) rsg[pm * 256 + row] = rv; }
    if (tid == 0) *tag = pm;
    __syncthreads();
}
struct EpiResidBf {
    static constexpr bool PERM = true; static constexpr bool HALF_ALL = false;
    bf16_t* XR; float* SSQP;
    __device__ __forceinline__ void operator()(const f32x4 (&acc)[2][2][4][2], const pg8::Unit& u, int wr, int wc, int fr, int fq) const {
        const int row0 = u.pm * 256 + wr * 64 + fr, col0 = u.pn * 256 + wc * 32 + 8 * fq;
        u32x4 xr[2][4][2];
#pragma unroll
        for (int ai = 0; ai < 2; ++ai)
#pragma unroll
            for (int m = 0; m < 4; ++m)
#pragma unroll
                for (int bj = 0; bj < 2; ++bj) xr[ai][m][bj] = *(const u32x4*)(XR + tiled_off((size_t)(row0 + ai * 128 + m * 16), col0, DM) + (size_t)bj * 2 * 256 * 64);
#pragma unroll
        for (int ai = 0; ai < 2; ++ai) {
            float ssv[4];
#pragma unroll
            for (int m = 0; m < 4; ++m) { bf16_t* rowp = XR + tiled_off((size_t)(row0 + ai * 128 + m * 16), col0, DM); float ss = 0.f;
#pragma unroll
                for (int bj = 0; bj < 2; ++bj) { const u32x4 x = xr[ai][m][bj];
                    const f32x4 a0 = acc[ai][bj][m][0], a1 = acc[ai][bj][m][1];
                    u32x4 o; o.x = cvt_pk_bf16(bf_lo(x.x) + a0[0], bf_hi(x.x) + a0[1]); o.y = cvt_pk_bf16(bf_lo(x.y) + a0[2], bf_hi(x.y) + a0[3]);
                    o.z = cvt_pk_bf16(bf_lo(x.z) + a1[0], bf_hi(x.z) + a1[1]); o.w = cvt_pk_bf16(bf_lo(x.w) + a1[2], bf_hi(x.w) + a1[3]);
                    *(u32x4*)(rowp + (size_t)bj * 2 * 256 * 64) = o;
                    ss += bf_lo(o.x) * bf_lo(o.x) + bf_hi(o.x) * bf_hi(o.x) + bf_lo(o.y) * bf_lo(o.y) + bf_hi(o.y) * bf_hi(o.y)
                        + bf_lo(o.z) * bf_lo(o.z) + bf_hi(o.z) * bf_hi(o.z) + bf_lo(o.w) * bf_lo(o.w) + bf_hi(o.w) * bf_hi(o.w); }
                ssv[m] = xrow16_sum(ss); }
            if (fq == 0) {
#pragma unroll
                for (int m = 0; m < 4; ++m) SSQP[(size_t)(u.pn * 4 + wc) * M + row0 + ai * 128 + m * 16] = ssv[m]; }
        }
    }
};
struct EpiFinal {
    static constexpr bool PERM = true; static constexpr bool HALF_ALL = false;
    const bf16_t* XR; float* out;
    __device__ __forceinline__ void operator()(const f32x4 (&acc)[2][2][4][2], const pg8::Unit& u, int wr, int wc, int fr, int fq) const {
        const int row0 = u.pm * 256 + wr * 64 + fr, col0 = u.pn * 256 + wc * 32 + 8 * fq;
        u32x4 xr[2][4][2];
#pragma unroll
        for (int ai = 0; ai < 2; ++ai)
#pragma unroll
          for (int m = 0; m < 4; ++m)
#pragma unroll
              for (int bj = 0; bj < 2; ++bj) xr[ai][m][bj] = *(const u32x4*)(XR + tiled_off((size_t)(row0 + ai * 128 + m * 16), col0, DM) + (size_t)bj * 2 * 256 * 64);
#pragma unroll
        for (int ai = 0; ai < 2; ++ai) {
#pragma unroll
            for (int m = 0; m < 4; ++m) { const int row = row0 + ai * 128 + m * 16; float* op = out + (size_t)row * DM + col0;
#pragma unroll
                for (int bj = 0; bj < 2; ++bj) { const u32x4 x = xr[ai][m][bj];
                    const f32x4 a0 = acc[ai][bj][m][0], a1 = acc[ai][bj][m][1];
                    *(f32x4*)(op + bj * 128) = (f32x4){bf_lo(x.x) + a0[0], bf_hi(x.x) + a0[1], bf_lo(x.y) + a0[2], bf_hi(x.y) + a0[3]};
                    *(f32x4*)(op + bj * 128 + 4) = (f32x4){bf_lo(x.z) + a1[0], bf_hi(x.z) + a1[1], bf_lo(x.w) + a1[2], bf_hi(x.w) + a1[3]}; } }
        }
    }
};
struct EpiRelu2 {
    static constexpr bool PERM = true; static constexpr bool HALF_ALL = false;
    bf16_t* O; const float* SSQP; LAS float* rsl; volatile LAS int* tag;
    __device__ __forceinline__ void operator()(const f32x4 (&acc)[2][2][4][2], const pg8::Unit& u, int wr, int wc, int fr, int fq) const {
        const int row0 = u.pm * 256 + wr * 64 + fr, col0 = u.pn * 256 + wc * 32 + 8 * fq;
        rs_panel(SSQP, u.pm, rsl, tag, (wr * 4 + wc) * 64 + fq * 16 + fr);
        float rsv[8];
#pragma unroll
        for (int q = 0; q < 8; ++q) rsv[q] = rsl[wr * 64 + fr + (q >> 2) * 128 + (q & 3) * 16];
#pragma unroll
        for (int ai = 0; ai < 2; ++ai)
#pragma unroll
            for (int m = 0; m < 4; ++m) { bf16_t* rowp = O + tiled_off((size_t)(row0 + ai * 128 + m * 16), col0, FF);
#pragma unroll
                for (int bj = 0; bj < 2; ++bj) { const float rs = rsv[ai * 4 + m]; f32x4 v0 = acc[ai][bj][m][0] * rs, v1 = acc[ai][bj][m][1] * rs;
#pragma unroll
                    for (int j = 0; j < 4; ++j) { const float a = fmaxf(v0[j], 0.f), b = fmaxf(v1[j], 0.f); v0[j] = a * a; v1[j] = b * b; }
                    u32x4 o; o.x = cvt_pk_bf16(v0[0], v0[1]); o.y = cvt_pk_bf16(v0[2], v0[3]); o.z = cvt_pk_bf16(v1[0], v1[1]); o.w = cvt_pk_bf16(v1[2], v1[3]);
                    *(u32x4*)(rowp + (size_t)bj * 2 * 256 * 64) = o; } }
    }
};
struct EpiOddPart {
    static constexpr bool PERM = true; static constexpr bool HALF_ALL = true;
    float* ODDP;
    __device__ __forceinline__ void operator()(const f32x4 (&acc)[2][2][4][2], const pg8::Unit& u, int wr, int wc, int fr, int fq) const {
        const int row0 = u.pm * 256 + wr * 64 + fr, c0 = wc * 32 + 8 * fq;
        if (c0 >= 96) return;
#pragma unroll
        for (int ai = 0; ai < 2; ++ai)
#pragma unroll
            for (int m = 0; m < 4; ++m) { float* p = ODDP + ((size_t)u.pn * M + row0 + ai * 128 + m * 16) * 128 + c0; *(f32x4*)p = acc[ai][0][m][0]; *(f32x4*)(p + 4) = acc[ai][0][m][1]; }
    }
};
struct EpiInProj {
    static constexpr bool PERM = true; static constexpr bool HALF_ALL = false;
    bf16_t* PROJ; float* GLOG; float* ODD; const float* lb; const float* gbias; const float* SSQP;
    const float* gcqk; const float* gdqk; LAS float* xch; LAS float* rsl; volatile LAS int* tag; float* RSG;
    __device__ __forceinline__ void operator()(const f32x4 (&acc)[2][2][4][2], const pg8::Unit& u, int wr, int wc, int fr, int fq) const {
        const int row0 = u.pm * 256 + wr * 64 + fr; const int pn = u.pn;
        const int seg = pn >> 2;
        rs_panel(SSQP, u.pm, rsl, tag, (wr * 4 + wc) * 64 + fq * 16 + fr, RSG);
        float rsv[8];
#pragma unroll
        for (int q = 0; q < 8; ++q) rsv[q] = rsl[wr * 64 + fr + (q >> 2) * 128 + (q & 3) * 16];
        int kind = 0;
        if (pn >= 56) kind = 6; else if (seg == 0) kind = 1; else if (seg == 1) kind = 5; else if (seg == 3) kind = 2; else if (seg == 6) kind = 3; else if (seg == 13) kind = 4; else if (seg == 7 || seg == 8 || seg == 10 || seg == 11) kind = 7;
        if (kind == 6) {
            const int c0 = wc * 32 + 8 * fq;
            if (c0 >= 96) return;
#pragma unroll
            for (int ai = 0; ai < 2; ++ai)
#pragma unroll
                for (int m = 0; m < 4; ++m) { float* rowp = ODD + (size_t)(row0 + ai * 128 + m * 16) * LDO + c0;
                    const float rs = rsv[ai * 4 + m]; f32x4 v0 = acc[ai][0][m][0] * rs, v1 = acc[ai][0][m][1] * rs;
                    if (c0 >= 64 && c0 < 80) { v0 = v0 * 0.25f; v1 = v1 * 0.25f; }
                    else if (c0 == 80) {
#pragma unroll
                        for (int j = 0; j < 4; ++j) { v0[j] += gbias[j]; v1[j] += gbias[4 + j]; } }
                    else if (c0 == 88) {
#pragma unroll
                        for (int j = 0; j < 4; ++j) { const float a = v0[j] + gbias[8 + j], b = v1[j] + gbias[12 + j];
                            v0[j] = fminf(a, 0.f) - __logf(1.f + __expf(-fabsf(a))); v1[j] = fminf(b, 0.f) - __logf(1.f + __expf(-fabsf(b))); } }
                    *(f32x4*)rowp = v0; *(f32x4*)(rowp + 4) = v1; }
            return;
        }
        const int col0 = pn * 256 + wc * 32 + 8 * fq;
        if (kind == 7) {
            const float* gp = ((seg < 9) ? gcqk : gdqk) + ((seg == 8 || seg == 11) ? 128 : 0) + wc * 32 + 8 * fq;
            const f32x4 g0 = *(const f32x4*)gp, g1 = *(const f32x4*)(gp + 4);
            float ssv[16];
#pragma unroll
            for (int ai = 0; ai < 2; ++ai)
#pragma unroll
                for (int m = 0; m < 4; ++m)
#pragma unroll
                    for (int bj = 0; bj < 2; ++bj) { const f32x4 a0 = acc[ai][bj][m][0], a1 = acc[ai][bj][m][1];
                        const float ss = (a0[0] * a0[0] + a0[1] * a0[1]) + (a0[2] * a0[2] + a0[3] * a0[3]) + (a1[0] * a1[0] + a1[1] * a1[1]) + (a1[2] * a1[2] + a1[3] * a1[3]);
                        ssv[(ai * 4 + m) * 2 + bj] = xrow16_sum(ss); }
            if (fq == 0) {
#pragma unroll
                for (int q = 0; q < 16; ++q) xch[((((q >> 3) * 128 + wr * 64 + ((q >> 1) & 3) * 16 + fr) * 2 + (q & 1)) * 4) + wc] = ssv[q];
            }
            __syncthreads();
#pragma unroll
            for (int ai = 0; ai < 2; ++ai)
#pragma unroll
                for (int m = 0; m < 4; ++m) { bf16_t* rowp = PROJ + (size_t)(row0 + ai * 128 + m * 16) * LDP + col0; const float rs = rsv[ai * 4 + m];
#pragma unroll
                    for (int bj = 0; bj < 2; ++bj) { const f32x4 pq = *(const LAS f32x4*)(xch + ((ai * 128 + wr * 64 + m * 16 + fr) * 2 + bj) * 4);
                        const float rn = rs * __builtin_amdgcn_rsqf(rs * rs * ((pq[0] + pq[1]) + (pq[2] + pq[3])) * (1.f / 128.f) + EPS);
                        const f32x4 v0 = acc[ai][bj][m][0] * rn * g0, v1 = acc[ai][bj][m][1] * rn * g1;
                        u32x4 o; o.x = cvt_pk_bf16(v0[0], v0[1]); o.y = cvt_pk_bf16(v0[2], v0[3]); o.z = cvt_pk_bf16(v1[0], v1[1]); o.w = cvt_pk_bf16(v1[2], v1[3]);
                        *(u32x4*)(rowp + bj * 128) = o; } }
            return;
        }
        if (kind == 5) {
            const int lc = col0 - C_AF;
            f32x4 l0[2], l1[2];
#pragma unroll
            for (int bj = 0; bj < 2; ++bj) { l0[bj] = *(const f32x4*)(lb + lc + bj * 128); l1[bj] = *(const f32x4*)(lb + lc + bj * 128 + 4); }
#pragma unroll
            for (int ai = 0; ai < 2; ++ai)
#pragma unroll
                for (int m = 0; m < 4; ++m) { float* rowp = GLOG + (size_t)(row0 + ai * 128 + m * 16) * 1024 + lc;
#pragma unroll
                    for (int bj = 0; bj < 2; ++bj) { const float rs = rsv[ai * 4 + m]; f32x4 v0 = acc[ai][bj][m][0] * rs, v1 = acc[ai][bj][m][1] * rs;
#pragma unroll
                        for (int j = 0; j < 4; ++j) { const float fa = l0[bj][j] + (1.f - l0[bj][j]) * fast_sigmoid(v0[j]), fb = l1[bj][j] + (1.f - l1[bj][j]) * fast_sigmoid(v1[j]);
                            v0[j] = __logf(fmaxf(fa, 1e-20f)); v1[j] = __logf(fmaxf(fb, 1e-20f)); }
                        *(f32x4*)(rowp + bj * 128) = v0; *(f32x4*)(rowp + bj * 128 + 4) = v1; } }
            return;
        }
#pragma unroll
        for (int ai = 0; ai < 2; ++ai)
#pragma unroll
            for (int m = 0; m < 4; ++m) { bf16_t* rowp = PROJ + (size_t)(row0 + ai * 128 + m * 16) * LDP + col0;
#pragma unroll
                for (int bj = 0; bj < 2; ++bj) { const float rs = rsv[ai * 4 + m]; f32x4 v0 = acc[ai][bj][m][0] * rs, v1 = acc[ai][bj][m][1] * rs;
                    if (kind == 1) {
#pragma unroll
                        for (int j = 0; j < 4; ++j) { v0[j] = fast_silu(v0[j]) * 0.08838834764831845f; v1[j] = fast_silu(v1[j]) * 0.08838834764831845f; } }
                    else if (kind == 2) {
#pragma unroll
                        for (int j = 0; j < 4; ++j) { v0[j] = fast_silu(v0[j]); v1[j] = fast_silu(v1[j]); } }
                    else if (kind == 3) {
#pragma unroll
                        for (int j = 0; j < 4; ++j) { v0[j] = fast_sigmoid(v0[j]); v1[j] = fast_sigmoid(v1[j]); } }
                    else if (kind == 4) { v0 = v0 * 0.015625f; v1 = v1 * 0.015625f; }
                    u32x4 o; o.x = cvt_pk_bf16(v0[0], v0[1]); o.y = cvt_pk_bf16(v0[2], v0[3]); o.z = cvt_pk_bf16(v1[0], v1[1]); o.w = cvt_pk_bf16(v1[2], v1[3]);
                    *(u32x4*)(rowp + bj * 128) = o; } }
    }
};


namespace att {
constexpr int D = 128, NW = 8, QBLK = 32, KVBLK = 64, QB = NW * QBLK;
constexpr int SHM_V = KVBLK * D * 2, SHM_K = KVBLK * D * 2;
constexpr int ATT_LDS = 2 * SHM_V + 2 * SHM_K + NW * 64 * 4;
constexpr float SCALE = 0.08838834764831845f, THR = 8.f;
#define KSWZ(row, colB) ((row) * 256 + ((colB) ^ (((row) & 7) << 4)))
#define SBAR() __builtin_amdgcn_sched_barrier(0)
__device__ __forceinline__ int v_st(int k, int c) { const int kk = (k & ~0xC) | ((k & 4) << 1) | ((k & 8) >> 1); return ((kk >> 3) * 4 + (c >> 5)) * 512 + ((kk & 7) * 32 + (c & 31)) * 2; }
__device__ __forceinline__ int v_rd_base(int lane) { return ((lane & 3) << 3) | (((lane >> 2) & 3) << 6) | (((lane >> 4) & 1) << 5) | (((lane >> 5) & 1) << 8); }
constexpr int v_rd_off(int d0, int ks, int half) { return d0 * 512 + ks * 4096 + half * 2048; }
__device__ __forceinline__ int crow(int r, int hi) { return (r & 3) + 8 * (r >> 2) + 4 * hi; }
__device__ __forceinline__ bf16x8 ld8(const bf16_t* p) { return *reinterpret_cast<const bf16x8*>(p); }
__device__ __forceinline__ void partialSM(f32x16& p0, f32x16& p1, float& m_reg, float& mn, float& alpha) {
    float pmax = p0[0];
#pragma unroll
    for (int r = 1; r < 16; ++r) pmax = fmaxf(pmax, p0[r]);
#pragma unroll
    for (int r = 0; r < 16; ++r) pmax = fmaxf(pmax, p1[r]);
    { auto rr = __builtin_amdgcn_permlane32_swap(__float_as_uint(pmax), __float_as_uint(pmax), false, false);
      pmax = fmaxf(__uint_as_float(rr[0]), __uint_as_float(rr[1])); }
    constexpr float C2 = 1.4426950408889634f * SCALE;
    if (__builtin_expect(__all((pmax - m_reg) * SCALE <= THR), 1)) { mn = m_reg; alpha = 1.f; }
    else { mn = fmaxf(m_reg, pmax); alpha = __builtin_amdgcn_exp2f((m_reg - mn) * C2); m_reg = mn; }
    const float mnL = -mn * C2;
#pragma unroll
    for (int r = 0; r < 16; ++r) p0[r] = fmaf(p0[r], C2, mnL);
#pragma unroll
    for (int r = 0; r < 16; ++r) p1[r] = fmaf(p1[r], C2, mnL);
#pragma unroll
    for (int r = 0; r < 16; ++r) p0[r] = __builtin_amdgcn_exp2f(p0[r]);
}
__device__ __forceinline__ void finishSM(f32x16& p0, f32x16& p1, float alpha, float& l_reg, bf16x8& pa0, bf16x8& pa1, bf16x8& pa2, bf16x8& pa3) {
#pragma unroll
    for (int r = 0; r < 16; ++r) p1[r] = __builtin_amdgcn_exp2f(p1[r]);
    float ps = 0;
#pragma unroll
    for (int r = 0; r < 16; ++r) ps += p0[r];
#pragma unroll
    for (int r = 0; r < 16; ++r) ps += p1[r];
    { auto rr = __builtin_amdgcn_permlane32_swap(__float_as_uint(ps), __float_as_uint(ps), false, false);
      ps = __uint_as_float(rr[0]) + __uint_as_float(rr[1]); }
    l_reg = l_reg * alpha + ps;
#define PK4(P, B_, OUT) do { unsigned a0 = cvt_pk_bf16(P[B_+0], P[B_+1]), a1 = cvt_pk_bf16(P[B_+2], P[B_+3]);                          \
        unsigned b0 = cvt_pk_bf16(P[B_+4], P[B_+5]), b1 = cvt_pk_bf16(P[B_+6], P[B_+7]);                                             \
        auto r0 = __builtin_amdgcn_permlane32_swap(a0, b0, false, false); auto r1 = __builtin_amdgcn_permlane32_swap(a1, b1, false, false); \
        u32x4 w = {r0[0], r1[0], r0[1], r1[1]}; OUT = *reinterpret_cast<bf16x8*>(&w); } while (0)
    PK4(p0, 0, pa0); PK4(p0, 8, pa1); PK4(p1, 0, pa2); PK4(p1, 8, pa3);
#undef PK4
}
template <int KB>
__device__ __forceinline__ void qkt(f32x16& p0, f32x16& p1, const char* K_lds, int r32, int hi, const bf16x8* qr) {
    p0 = f32x16{}; p1 = f32x16{};
    const char* kb[4];
#pragma unroll
    for (int dd = 0; dd < 4; ++dd) kb[dd] = K_lds + KB * SHM_K + KSWZ(r32, (dd * 16 + hi * 8) * 2);
#pragma unroll
    for (int d0 = 0; d0 < 8; ++d0) { const char* a = kb[d0 & 3] + (d0 >> 2) * 128;
        bf16x8 b0 = *reinterpret_cast<const bf16x8*>(a);
        bf16x8 b1 = *reinterpret_cast<const bf16x8*>(a + 32 * 256);
        p0 = __builtin_amdgcn_mfma_f32_32x32x16_bf16(b0, qr[d0], p0, 0, 0, 0);
        p1 = __builtin_amdgcn_mfma_f32_32x32x16_bf16(b1, qr[d0], p1, 0, 0, 0); }
}
template <int VB>
__device__ __forceinline__ void pv_tile(f32x16* o, int vb0, bf16x8 pa0, bf16x8 pa1, bf16x8 pa2, bf16x8 pa3) {
#define TRRD(dst, off) asm volatile("ds_read_b64_tr_b16 %0, %1 offset:%2" : "=&v"(dst) : "v"(vb0), "i"(off) : "memory")
#define PV_D0(d0) do { s16x4 l0, l1, l2, l3, h0, h1, h2, h3; constexpr int b_ = VB * SHM_V + v_rd_off(d0, 0, 0); \
        TRRD(l0, b_); TRRD(h0, b_ + 2048); TRRD(l1, b_ + 4096); TRRD(h1, b_ + 6144); TRRD(l2, b_ + 8192); TRRD(h2, b_ + 10240); TRRD(l3, b_ + 12288); TRRD(h3, b_ + 14336); \
        asm volatile("s_waitcnt lgkmcnt(0)" ::: "memory"); SBAR();   \
        o[d0] = __builtin_amdgcn_mfma_f32_32x32x16_bf16(pa0, (bf16x8){l0[0], l0[1], l0[2], l0[3], h0[0], h0[1], h0[2], h0[3]}, o[d0], 0, 0, 0);   \
        o[d0] = __builtin_amdgcn_mfma_f32_32x32x16_bf16(pa1, (bf16x8){l1[0], l1[1], l1[2], l1[3], h1[0], h1[1], h1[2], h1[3]}, o[d0], 0, 0, 0);   \
        o[d0] = __builtin_amdgcn_mfma_f32_32x32x16_bf16(pa2, (bf16x8){l2[0], l2[1], l2[2], l2[3], h2[0], h2[1], h2[2], h2[3]}, o[d0], 0, 0, 0);   \
        o[d0] = __builtin_amdgcn_mfma_f32_32x32x16_bf16(pa3, (bf16x8){l3[0], l3[1], l3[2], l3[3], h3[0], h3[1], h3[2], h3[3]}, o[d0], 0, 0, 0); } while (0)
    PV_D0(0); PV_D0(1); PV_D0(2); PV_D0(3);
#undef PV_D0
#undef TRRD
}
template <class TOut> struct BlockRef { const bf16_t* Q; const bf16_t* K; const bf16_t* V; TOut* O; const unsigned* MK; int P0; int orow, ocol; };
struct Seam { bf16x8 qr[8]; bf16x8 st_v0, st_v1, st_k0, st_k1; };
#define ROW(p, k0, rr) ((p) + (size_t)((k0) + (rr)) * LDP + sc)
#define VMW() asm volatile("s_waitcnt vmcnt(0)" ::: "memory")
#define VMWN(n) asm volatile("s_waitcnt vmcnt(%0)" :: "i"(n) : "memory")
#define SLOAD_H(Kp, Vp, k0) do { S.st_v0 = ld8(ROW(Vp, k0, sr)); S.st_v1 = ld8(ROW(Vp, k0, 32 + sr)); S.st_k0 = ld8(ROW(Kp, k0, sr)); S.st_k1 = ld8(ROW(Kp, k0, 32 + sr)); } while (0)
#define SWRITE_HK(bf) do { *(bf16x8*)(K_lds + (bf) * SHM_K + kws) = S.st_k0; *(bf16x8*)(K_lds + (bf) * SHM_K + kws + 32 * 256) = S.st_k1; } while (0)
#define SWRITE_HV(bf) do { *(bf16x8*)(V_lds + (bf) * SHM_V + vst0) = S.st_v0; *(bf16x8*)(V_lds + (bf) * SHM_V + vst1) = S.st_v1; } while (0)
#define SWRITE_H(bf) do { SWRITE_HV(bf); SWRITE_HK(bf); } while (0)
template <class TOut>
__device__ __forceinline__ void attn_prime(const BlockRef<TOut>& cur, char* lds, Seam& S) {
    const int tid_ = my_tid();
    const int tid = tid_, wid = __builtin_amdgcn_readfirstlane(tid >> 6), lane = tid & 63, r32 = lane & 31, hi = lane >> 5;
    const int sr = tid >> 4, sc = (tid & 15) * 8, kws = KSWZ(sr, sc * 2); char* K_lds = lds + 2 * SHM_V;
#pragma unroll
    for (int d0 = 0; d0 < 8; ++d0) S.qr[d0] = ld8(cur.Q + (size_t)(wid * QBLK + r32) * LDP + d0 * 16 + hi * 8);
    SLOAD_H(cur.K, cur.V, 0); VMW(); SWRITE_HK(0);
    __syncthreads();
}
template <class TOut, bool BM, int OS>
__device__ __forceinline__ void attn_block(const BlockRef<TOut>& cur, const BlockRef<TOut>& nxt, char* lds, Seam& S) {
    const int tid_ = my_tid();
    const int tid = tid_, wid = __builtin_amdgcn_readfirstlane(tid >> 6), lane = tid & 63, r32 = lane & 31, hi = lane >> 5;
    const int NT = (cur.P0 + QB - 1) / KVBLK + 1;
    const int qlo = cur.P0 + wid * QBLK;
    const int klim = (qlo & ~63) + 64;
    char* V_lds = lds; char* K_lds = lds + 2 * SHM_V;
    float* wsl = (float*)(lds + 2 * SHM_V + 2 * SHM_K) + wid * 64; float* li_l = wsl, * al_l = wsl + 32;
    float m_reg = -1e30f, l_reg = 0; f32x16 o[4] = {};
    const int sr = tid >> 4, sc = (tid & 15) * 8, vst0 = v_st(sr, sc), vst1 = v_st(32 + sr, sc), kws = KSWZ(sr, sc * 2);
    const int vb0 = (int)(uintptr_t)V_lds + v_rd_base(lane);
    const bf16_t* Kh = cur.K; const bf16_t* Vh = cur.V;
    const unsigned moff = (unsigned)(qlo + r32) * 4u;
    unsigned mw0 = 0, mw1 = 0;
#define RESC(a) do { if (__any((a) < 1.f)) { if (hi == 0) al_l[r32] = (a); asm volatile("s_waitcnt lgkmcnt(0)" ::: "memory");              \
                     _Pragma("unroll") for (int d_ = 0; d_ < 4; ++d_) _Pragma("unroll") for (int r = 0; r < 16; ++r) o[d_][r] *= al_l[crow(r, hi)]; } } while (0)
#define KBASE(t) ((t) * KVBLK)
#define MLOAD(t) do { if (BM) { const char* mb_ = (const char*)cur.MK + (size_t)(2 * (t)) * (T * 4); mw0 = *(const unsigned*)(mb_ + (size_t)moff); mw1 = *(const unsigned*)(mb_ + (size_t)(T * 4) + (size_t)moff); } } while (0)
#define MASKT(P0_, P1_, t) do { const float NEGI = -__builtin_inff(); \
        if (KBASE(t) >= klim) { _Pragma("unroll") for (int r = 0; r < 16; ++r) { P0_[r] = NEGI; P1_[r] = NEGI; } } \
        else if (BM) { const unsigned a_ = mw0 >> (4 * hi), b_ = mw1 >> (4 * hi); \
            _Pragma("unroll") for (int r = 0; r < 16; ++r) { const int cb = (r & 3) + 8 * (r >> 2); \
                const unsigned ma_ = (unsigned)__builtin_amdgcn_sbfe((int)a_, cb, 1), mb_ = (unsigned)__builtin_amdgcn_sbfe((int)b_, cb, 1);     \
                P0_[r] = __uint_as_float((__float_as_uint(P0_[r]) & ma_) | (0xFF800000u & ~ma_)); P1_[r] = __uint_as_float((__float_as_uint(P1_[r]) & mb_) | (0xFF800000u & ~mb_)); } } } while (0)
#define SEAM_K0() do { VMWN(8); SWRITE_HK(0); SBAR(); } while (0)
    f32x16 pA0, pA1, pB0, pB1; float mnA, mnB, alA, alB; bf16x8 pa0, pa1, pa2, pa3;
    SWRITE_HV(0); SBAR();
    MLOAD(0);
    if (NT > 1) { SLOAD_H(Kh, Vh, KBASE(1)); }
    SBAR(); qkt<0>(pA0, pA1, K_lds, r32, hi, S.qr);
    if (BM) VMW();
    MASKT(pA0, pA1, 0); partialSM(pA0, pA1, m_reg, mnA, alA);
    if (NT > 1) { VMW(); SWRITE_H(1); }
    __syncthreads();
#define HALF_STEP(PX0, PX1, mnX, alX, PY0, PY1, alY, t, KB, VB, SB) do {                                                      \
        MLOAD(t);                                                                                                             \
        SBAR(); qkt<KB>(PX0, PX1, K_lds, r32, hi, S.qr);                                                                      \
        finishSM(PY0, PY1, alY, l_reg, pa0, pa1, pa2, pa3); SBAR();                                                           \
        if ((t) + 1 < NT) { SLOAD_H(Kh, Vh, KBASE((t) + 1)); SBAR(); }                                                        \
        pv_tile<VB>(o, vb0, pa0, pa1, pa2, pa3);                                                                              \
        if (BM) { if ((t) + 1 < NT) VMWN(4); else VMW(); }                                                                    \
        MASKT(PX0, PX1, (t)); partialSM(PX0, PX1, m_reg, mnX, alX);                                                           \
        __syncthreads();                                                                                                      \
        if ((t) + 1 < NT) { VMW(); SWRITE_H(SB); }                                                                            \
        RESC(alX); __syncthreads(); } while (0)
    for (int t = 1; t + 1 < NT; t += 2) {
        HALF_STEP(pB0, pB1, mnB, alB, pA0, pA1, alA, t, 1, 0, 0);
        HALF_STEP(pA0, pA1, mnA, alA, pB0, pB1, alB, t + 1, 0, 1, 1);
    }
    const bool even = (NT & 1) == 0;
    if (even) { MLOAD(NT - 1); SBAR(); qkt<1>(pB0, pB1, K_lds, r32, hi, S.qr); SBAR(); }
    SLOAD_H(nxt.K, nxt.V, 0); SBAR();
#pragma unroll
    for (int d0 = 0; d0 < 8; ++d0) S.qr[d0] = ld8(nxt.Q + (size_t)(wid * QBLK + r32) * LDP + d0 * 16 + hi * 8);
    SBAR();
    finishSM(pA0, pA1, alA, l_reg, pa0, pa1, pa2, pa3); SBAR();
    pv_tile<0>(o, vb0, pa0, pa1, pa2, pa3);
    if (even) { if (BM) VMWN(12); MASKT(pB0, pB1, NT - 1); partialSM(pB0, pB1, m_reg, mnB, alB); __syncthreads(); RESC(alB);
        finishSM(pB0, pB1, alB, l_reg, pa0, pa1, pa2, pa3); SBAR(); pv_tile<1>(o, vb0, pa0, pa1, pa2, pa3); }
    SBAR(); SEAM_K0();
    if (hi == 0) li_l[r32] = l_reg; asm volatile("s_waitcnt lgkmcnt(0)" ::: "memory");
    float rli[16];
#pragma unroll
    for (int r = 0; r < 16; ++r) rli[r] = __builtin_amdgcn_rcpf(li_l[crow(r, hi)]);
    TOut* obase_ = cur.O; asm volatile("" : "+s"(obase_));
    TOut* Ow = obase_ + (size_t)(wid * QBLK) * OS;
#pragma unroll
    for (int r = 0; r < 16; ++r) { const int orow = crow(r, hi);
#pragma unroll
        for (int d0 = 0; d0 < 4; ++d0) { const float v = o[d0][r] * rli[r];
            if constexpr (sizeof(TOut) == 4) { Ow[(size_t)orow * OS + d0 * 32 + r32] = v; }
            else { const float vn = sx(v, 1, lane);
                   if ((r32 & 1) == 0) *(unsigned*)(obase_ + tiled_off((size_t)(cur.orow + wid * QBLK + orow), cur.ocol + d0 * 32 + r32, OS)) = cvt_pk_bf16(v, vn); } } }
    __syncthreads();
#undef RESC
#undef KBASE
#undef MLOAD
#undef MASKT
#undef SEAM_K0
#undef HALF_STEP
}
#undef ROW
#undef VMW
#undef VMWN
#undef SLOAD_H
#undef SWRITE_HK
#undef SWRITE_HV
#undef SWRITE_H
}

#define XB_TMO      128
#define XB_XCNT(j)  (256  + 64 * (j))
#define XB_XSUB(j)  (1280 + 64 * (j))
#define XB_XGEN(j)  (2304 + 64 * (j))
#define XB_TOP      3328
#define XB_TOPGEN   3392
#define XCD_BAR_WORDS 3456
#define XB_SPIN_CAP (1u << 22)
__device__ __forceinline__ unsigned xb_ld(unsigned* p)              { return __hip_atomic_load(p, __ATOMIC_RELAXED, __HIP_MEMORY_SCOPE_AGENT); }
__device__ __forceinline__ unsigned xb_add(unsigned* p, unsigned v) { return __hip_atomic_fetch_add(p, v, __ATOMIC_RELAXED, __HIP_MEMORY_SCOPE_AGENT); }
__device__ __forceinline__ unsigned xb_xcc_id() { return (unsigned)__builtin_amdgcn_s_getreg((3 << 11) | 20) & 0xFu; }
#define XB_SPIN(cond, bar) do { unsigned _sp = 0; while (cond) { __builtin_amdgcn_s_sleep(1); \
    if ((++_sp & 255u) == 0u) { if (xb_ld(&(bar)[XB_TMO])) break; if (_sp > XB_SPIN_CAP) { atomicAdd(&(bar)[XB_TMO], 1u); break; } } } } while (0)
struct XcdBarrier { unsigned* bar; unsigned x; volatile LAS unsigned* st; };
__device__ __forceinline__ XcdBarrier xcd_barrier_post(unsigned* bar, volatile LAS unsigned* st) {
    XcdBarrier b; b.bar = bar; b.x = xb_xcc_id(); b.st = st;
    if (my_tid() == 0) (void)xb_add(&bar[XB_XCNT(b.x)], 1u);
    return b;
}
__device__ __forceinline__ void xcd_barrier_complete(unsigned* bar, unsigned x, unsigned& nloc, unsigned& nx) {
    const unsigned G = gridDim.x * gridDim.y * gridDim.z;
    unsigned sum, cnt, mine, sp = 0u;
    for (;;) {
        sum = 0u; cnt = 0u; mine = 0u;
#pragma unroll
        for (unsigned j = 0; j < 16; ++j) { const unsigned c = xb_ld(&bar[XB_XCNT(j)]); sum += c; cnt += (c > 0u) ? 1u : 0u; mine = (j == x) ? c : mine; }
        if (sum == G) break;
        __builtin_amdgcn_s_sleep(1);
        if ((++sp & 255u) == 0u) { if (xb_ld(&bar[XB_TMO])) break; if (sp > XB_SPIN_CAP) { atomicAdd(&bar[XB_TMO], 1u); break; } }
    }
    nloc = mine > 0u ? mine : 1u; nx = cnt > 0u ? cnt : 1u;
}
__device__ __forceinline__ void xcd_barrier(const XcdBarrier& b) {
    asm volatile("s_waitcnt vmcnt(0)" ::: "memory");
    __syncthreads();
    if (my_tid() == 0) {
        unsigned* bar = b.bar;
        __builtin_amdgcn_s_waitcnt(0);
        unsigned nloc = b.st[0], nx = b.st[1];
        if (nloc == 0u) { xcd_barrier_complete(bar, b.x, nloc, nx); b.st[0] = nloc; b.st[1] = nx; }
        const unsigned old = xb_add(&bar[XB_XSUB(b.x)], 1u);
        const unsigned gen = old / nloc;
        if (old + 1u == (gen + 1u) * nloc) {
            __builtin_amdgcn_fence(__ATOMIC_RELEASE, "agent");
            asm volatile("s_waitcnt vmcnt(0)" ::: "memory");
            const unsigned og = xb_add(&bar[XB_TOP], 1u);
            const unsigned tg = og / nx;
            if (og + 1u == (tg + 1u) * nx) xb_add(&bar[XB_TOPGEN], 1u);
            else XB_SPIN(xb_ld(&bar[XB_TOPGEN]) == tg, bar);
            __builtin_amdgcn_fence(__ATOMIC_ACQUIRE, "agent");
            xb_add(&bar[XB_XGEN(b.x)], 1u);
            asm volatile("s_waitcnt vmcnt(0)" ::: "memory");
        } else {
            XB_SPIN(xb_ld(&bar[XB_XGEN(b.x)]) == gen, bar);
            __builtin_amdgcn_fence(__ATOMIC_ACQUIRE, "agent");
            asm volatile("s_waitcnt vmcnt(0)" ::: "memory");
        }
    }
    __syncthreads();
}

struct Args {
    const float* in[17]; float* out; unsigned char* ws; int ph_lo, ph_hi;
};
typedef const __attribute__((address_space(4))) Args KA;
#define PH_ARGS() ({ KA* p_ = (KA*)__builtin_amdgcn_kernarg_segment_ptr(); asm volatile("" : "+s"(p_)); p_; })
struct Frame {
    LAS unsigned char* lds; int tid, lane, wave, G, vcu;
};
__device__ __forceinline__ Frame make_frame(LAS unsigned char* lds) {
    Frame F; F.lds = lds; const int t = my_tid();
    F.tid = t; F.lane = t & 63; F.wave = __builtin_amdgcn_readfirstlane(t >> 6);
    F.G = gridDim.x; { const int bx = blockIdx.x; F.vcu = (F.G % 8 == 0) ? (bx % 8) * (F.G / 8) + bx / 8 : bx; }
    return F;
}
__device__ __forceinline__ float wave_sum(float v, int lane) {
    v = sum16(v); v += sx(v, 16, lane); v += sx(v, 32, lane);
    return v;
}
#define LDS_WAIT() asm volatile("s_waitcnt lgkmcnt(0)" ::: "memory")

__device__ __forceinline__ void p0_transpose_item(const float* W, int K, int N, bf16_t* WT, const float* gain, bool remap, LAS float* scr, int item, int lane) {
    const int nblk = N / 32, kb = item / nblk, nb = item % nblk, k0 = 128 * kb, n0 = 32 * nb;
    const int r = lane >> 3, c = lane & 7;
    f32x4 v[16];
#pragma unroll
    for (int i = 0; i < 16; ++i) v[i] = *(const f32x4*)(W + (size_t)(k0 + 8 * i + r) * N + n0 + 4 * c);
    if (gain) {
#pragma unroll
        for (int i = 0; i < 16; ++i) v[i] = v[i] * gain[k0 + 8 * i + r]; }
#pragma unroll
    for (int i = 0; i < 16; ++i) { const int k = 8 * i + r;
        scr[(4 * c + 0) * 132 + k] = v[i].x; scr[(4 * c + 1) * 132 + k] = v[i].y; scr[(4 * c + 2) * 132 + k] = v[i].z; scr[(4 * c + 3) * 132 + k] = v[i].w; }
    LDS_WAIT(); asm volatile("" ::: "memory");
    const int nl = lane >> 4, ck = lane & 15;
#pragma unroll
    for (int j = 0; j < 8; ++j) { const int n = 4 * j + nl; const f32x4 a = *(const LAS f32x4*)(scr + n * 132 + 8 * ck), b = *(const LAS f32x4*)(scr + n * 132 + 8 * ck + 4);
        u32x4 o; o.x = cvt_pk_bf16(a.x, a.y); o.y = cvt_pk_bf16(a.z, a.w); o.z = cvt_pk_bf16(b.x, b.y); o.w = cvt_pk_bf16(b.z, b.w);
        int nd = n0 + n;
        if (remap) { if (nd >= 7168) nd = (nd < 7184) ? nd + 7248 : nd - 16; }
        *(u32x4*)(WT + tiled_off((size_t)nd, k0 + 8 * ck, K)) = o; }
    LDS_WAIT(); asm volatile("" ::: "memory");
}
__device__ __forceinline__ void rownorm_row(const float* xrow, bf16_t* xb, float* SSQP, int m, int lane) {
    const f32x4* xr = (const f32x4*)xrow + lane;
    f32x4 v[16]; float s = 0.f;
#pragma unroll
    for (int j = 0; j < 16; ++j) { v[j] = xr[64 * j]; s += (v[j].x * v[j].x + v[j].y * v[j].y) + (v[j].z * v[j].z + v[j].w * v[j].w); }
    const float st = wave_sum(s, lane);
    SSQP[(size_t)lane * M + m] = lane == 0 ? st : 0.f;
#pragma unroll
    for (int j = 0; j < 16; ++j) { u32x2 o; o.x = cvt_pk_bf16(v[j].x, v[j].y); o.y = cvt_pk_bf16(v[j].z, v[j].w); *(u32x2*)(xb + tiled_off((size_t)m, 256 * j + 4 * lane, DM)) = o; }
}
__device__ __forceinline__ void rownorm_phase(const Frame& F, const float* x, bf16_t* xb, float* SSQP) {
    const int gw = F.vcu * 8 + F.wave, NGW = F.G * 8;
    for (int m = gw; m < M; m += NGW) rownorm_row(x + (size_t)m * DM, xb, SSQP, m, F.lane);
}
__device__ __forceinline__ void rs_reduce_phase(const Frame& F, const float* SSQP, float* RS) {
    const int gt = (F.vcu * 8 + F.wave) * 64 + F.lane, NGT = F.G * 512;
    for (int m = gt; m < M; m += NGT) { float s = 0.f;
#pragma unroll 8
        for (int j = 0; j < 64; ++j) s += SSQP[(size_t)j * M + m];
        RS[m] = 1.f / sqrtf(s * (1.f / DM) + EPS); }
}

constexpr int CONV_I_IN = (DM / 128) * (NIN / 32), CONV_I_O = (DM / 128) * (DM / 32), CONV_I_1 = (DM / 128) * (FF / 32), CONV_I_2 = (FF / 128) * (DM / 32);
constexpr int CONV_PER_L = CONV_I_IN + CONV_I_O + CONV_I_1 + CONV_I_2;
__device__ __forceinline__ void conv_item(KA* ap, int l, int r, LAS float* scr, int lane) {
    unsigned char* ws = ap->ws;
    if (r < CONV_I_IN) { p0_transpose_item(ap->in[2] + (size_t)l * DM * NIN, DM, NIN, (bf16_t*)(ws + WS_WIN + l * SZ_WIN), ap->in[1] + l * DM, true, scr, r, lane); return; } r -= CONV_I_IN;
    if (r < CONV_I_O) { p0_transpose_item(ap->in[13] + (size_t)l * DM * DM, DM, DM, (bf16_t*)(ws + WS_WOUT + l * SZ_WOUT), nullptr, false, scr, r, lane); return; } r -= CONV_I_O;
    if (r < CONV_I_1) { p0_transpose_item(ap->in[15] + (size_t)l * DM * FF, DM, FF, (bf16_t*)(ws + WS_W1 + l * SZ_W1), ap->in[14] + l * DM, false, scr, r, lane); return; } r -= CONV_I_1;
    p0_transpose_item(ap->in[16] + (size_t)l * FF * DM, FF, DM, (bf16_t*)(ws + WS_W2 + l * SZ_W2), nullptr, false, scr, r, lane);
}
__device__ __forceinline__ void bg_convert(const Frame& F, KA* ap, unsigned* arrive, bool drain) {
    unsigned* ctl = (unsigned*)(ap->ws + WS_CTL); unsigned* head = ctl + CW_BGQ;
    volatile LAS unsigned* slot = (volatile LAS unsigned*)(F.lds + LDS_MISC) + 24;
    LAS float* scr = (LAS float*)(F.lds + F.wave * 16896);
    if (!drain && F.tid == 0) (void)__hip_atomic_fetch_add(arrive, 1u, __ATOMIC_RELAXED, __HIP_MEMORY_SCOPE_AGENT);
    const unsigned step = drain ? 4u : 1u;
    for (;;) {
        __syncthreads();
        if (F.tid == 0) { unsigned done = 0u; if (!drain) done = (__hip_atomic_load(arrive, __ATOMIC_RELAXED, __HIP_MEMORY_SCOPE_AGENT) >= (unsigned)F.G) ? 1u : 0u;
            unsigned ch = 0xFFFFFFFFu; if (!done) ch = __hip_atomic_fetch_add(head, step, __ATOMIC_RELAXED, __HIP_MEMORY_SCOPE_AGENT);
            slot[0] = ch; }
        __syncthreads();
        const unsigned ch = (unsigned)__builtin_amdgcn_readfirstlane((int)slot[0]);
        if (ch == 0xFFFFFFFFu || ch * 8u >= (unsigned)CONV_PER_L) break;
        for (unsigned s = 0; s < step; ++s) { const int it = (int)(ch + s) * 8 + F.wave;
            if (it < CONV_PER_L) conv_item(ap, 1, it, scr, F.lane); }
    }
    __syncthreads();
}
constexpr int NCVW = 32;
__device__ __forceinline__ void conv_side(const Frame& F, KA* ap) {
    LAS float* scr = (LAS float*)(F.lds + F.wave * 16896);
    const int ncv = F.G < NCVW ? F.G : NCVW;
    for (int it = CONV_I_IN + (int)blockIdx.x * 8 + F.wave; it < CONV_PER_L; it += ncv * 8) conv_item(ap, 0, it, scr, F.lane);
    __syncthreads();
}
__device__ __forceinline__ void p0_prologue(const Frame& F, KA* ap) {
    unsigned char* ws = ap->ws;
    LAS float* scr = (LAS float*)(F.lds + F.wave * 16896);
    const int gw = F.vcu * 8 + F.wave, NGW = F.G * 8;
    for (int it = gw; it < CONV_I_IN; it += NGW) conv_item(ap, 0, it, scr, F.lane);
    { const int gt = (F.vcu * 8 + F.wave) * 64 + F.lane, NGT = F.G * 512; constexpr int PADV = (NINP - NIN) * DM / 8;
      for (int i = gt; i < DEPTH * PADV; i += NGT) { const int l = i / PADV, r = i % PADV; const int n = NIN + r / (DM / 8), k = (r % (DM / 8)) * 8;
          *(u32x4*)((bf16_t*)(ws + WS_WIN + l * SZ_WIN) + tiled_off((size_t)n, k, DM)) = zero4(); } }
    { const int gt = (F.vcu * 8 + F.wave) * 64 + F.lane; float* lb = (float*)(ws + WS_LB);
      if (gt < 1024) { const float g0 = ap->in[3][gt], g1 = ap->in[3][1024 + gt]; lb[gt] = 0.f; lb[1024 + gt] = 1.f / (1.f + expf(g0 - g1)); } }
    rownorm_phase(F, ap->in[0], (bf16_t*)(ws + WS_XB), (float*)(ws + WS_SSQP));
}


__device__ __forceinline__ int q_next(unsigned* ctr, volatile LAS unsigned* slot) {
    __syncthreads();
    if (my_tid() == 0) *slot = atomicAdd(ctr, 1u);
    __syncthreads();
    return __builtin_amdgcn_readfirstlane((int)*slot);
}

template <bool DRY>
__device__ __forceinline__ void norm128_inplace(bf16_t* p, const float (&g)[16], int lane) {
    u32x4 a = *(const u32x4*)(p + lane * 16), b = *(const u32x4*)(p + lane * 16 + 8);
    float v[16];
    v[0] = bf_lo(a.x); v[1] = bf_hi(a.x); v[2] = bf_lo(a.y); v[3] = bf_hi(a.y); v[4] = bf_lo(a.z); v[5] = bf_hi(a.z); v[6] = bf_lo(a.w); v[7] = bf_hi(a.w);
    v[8] = bf_lo(b.x); v[9] = bf_hi(b.x); v[10] = bf_lo(b.y); v[11] = bf_hi(b.y); v[12] = bf_lo(b.z); v[13] = bf_hi(b.z); v[14] = bf_lo(b.w); v[15] = bf_hi(b.w);
    float ss = 0.f;
#pragma unroll
    for (int i = 0; i < 16; ++i) ss += v[i] * v[i];
    ss = sum8(ss);
    const float rs = 1.f / sqrtf(ss * (1.f / 128.f) + EPS);
#pragma unroll
    for (int i = 0; i < 16; ++i) v[i] = v[i] * rs * g[i];
    a.x = cvt_pk_bf16(v[0], v[1]); a.y = cvt_pk_bf16(v[2], v[3]); a.z = cvt_pk_bf16(v[4], v[5]); a.w = cvt_pk_bf16(v[6], v[7]);
    b.x = cvt_pk_bf16(v[8], v[9]); b.y = cvt_pk_bf16(v[10], v[11]); b.z = cvt_pk_bf16(v[12], v[13]); b.w = cvt_pk_bf16(v[14], v[15]);
    if (!DRY || rs == 1234.5f) { *(u32x4*)(p + lane * 16) = a; *(u32x4*)(p + lane * 16 + 8) = b; }
}
template <bool DRY>
__device__ __forceinline__ void fixup_phase(const Frame& F, KA* ap, int l) {
    unsigned char* ws = ap->ws;
    bf16_t* PROJ = (bf16_t*)(ws + WS_PROJ); float* ODDW = (float*)(ws + WS_ODD); const float* ODDP = (const float*)(ws + WS_Y); const float* RS = (const float*)(ws + WS_RS); const float* gbias = ap->in[6] + l * 16;
    bf16_t* BQK = (bf16_t*)(ws + WS_BQK); bf16_t* KI = (bf16_t*)(ws + WS_KI);
    const float* kin = ap->in[12] + l * 64; const float* cw = ap->in[5] + l * 4096;
    const int gw = F.vcu * 8 + F.wave, NGW = F.G * 8, lane = F.lane;
    float wcv[4][16];
#pragma unroll
    for (int j = 0; j < 4; ++j)
#pragma unroll
        for (int i = 0; i < 16; ++i) wcv[j][i] = cw[j * 1024 + lane * 16 + i];
    for (int m = gw; m < M; m += NGW) {
        {
          const float* op = ODDP + (size_t)m * 128; const float rs = RS[m];
          const float x = rs * ((op[lane] + op[(size_t)M * 128 + lane]) + (op[(size_t)2 * M * 128 + lane] + op[(size_t)3 * M * 128 + lane]));
          if (lane < 32) { const int c2 = 64 + lane; float v = rs * ((op[c2] + op[(size_t)M * 128 + c2]) + (op[(size_t)2 * M * 128 + c2] + op[(size_t)3 * M * 128 + c2]));
              if (c2 < 80) v *= 2.0f;   else { v += gbias[c2 - 80]; if (c2 >= 88) v = fminf(v, 0.f) - __logf(1.f + __expf(-fabsf(v))); }
              if (!DRY || v == 1234.5f) ODDW[(size_t)m * LDO + c2] = v; }
          const float ss = wave_sum(x * x, lane); const float y = x * (1.f / sqrtf(ss * (1.f / 64.f) + EPS)) * kin[lane];
          if (!DRY || y == 1234.5f) KI[(((size_t)(m >> 5) * 4 + (lane >> 4)) * 64 + ((lane >> 3) & 1) * 32 + (m & 31)) * 8 + (lane & 7)] = (bf16_t)(cvt_pk_bf16(y, y) & 0xffffu); }
        { const int tt = m & (T - 1); float acc[16];
#pragma unroll
          for (int i = 0; i < 16; ++i) acc[i] = 0.f;
#pragma unroll
          for (int j = 0; j < 4; ++j) { if (tt - 3 + j >= 0) { const bf16_t* rp = PROJ + (size_t)(m - 3 + j) * LDP + C_BQK + lane * 16;
                const u32x4 x0 = *(const u32x4*)rp, x1 = *(const u32x4*)(rp + 8); const float (&wj)[16] = wcv[j];
                acc[0] += bf_lo(x0.x) * wj[0]; acc[1] += bf_hi(x0.x) * wj[1]; acc[2] += bf_lo(x0.y) * wj[2]; acc[3] += bf_hi(x0.y) * wj[3];
                acc[4] += bf_lo(x0.z) * wj[4]; acc[5] += bf_hi(x0.z) * wj[5]; acc[6] += bf_lo(x0.w) * wj[6]; acc[7] += bf_hi(x0.w) * wj[7];
                acc[8] += bf_lo(x1.x) * wj[8]; acc[9] += bf_hi(x1.x) * wj[9]; acc[10] += bf_lo(x1.y) * wj[10]; acc[11] += bf_hi(x1.y) * wj[11];
                acc[12] += bf_lo(x1.z) * wj[12]; acc[13] += bf_hi(x1.z) * wj[13]; acc[14] += bf_lo(x1.w) * wj[14]; acc[15] += bf_hi(x1.w) * wj[15]; } }
          const float sc = (lane >= 32) ? 0.125f : 1.f;
#pragma unroll
          for (int i = 0; i < 16; ++i) acc[i] = fast_silu(acc[i]) * sc;
          u32x4 o0, o1; o0.x = cvt_pk_bf16(acc[0], acc[1]); o0.y = cvt_pk_bf16(acc[2], acc[3]); o0.z = cvt_pk_bf16(acc[4], acc[5]); o0.w = cvt_pk_bf16(acc[6], acc[7]);
          o1.x = cvt_pk_bf16(acc[8], acc[9]); o1.y = cvt_pk_bf16(acc[10], acc[11]); o1.z = cvt_pk_bf16(acc[12], acc[13]); o1.w = cvt_pk_bf16(acc[14], acc[15]);
          if (!DRY || acc[0] == 1234.5f) { *(u32x4*)(BQK + (size_t)m * 1024 + lane * 16) = o0; *(u32x4*)(BQK + (size_t)m * 1024 + lane * 16 + 8) = o1; } }
    }
}
__device__ __forceinline__ void ccombine_phase(const Frame& F, KA* ap, int l) {
    unsigned char* ws = ap->ws; const float* CATT = (const float*)(ws + WS_CATT); bf16_t* Y = (bf16_t*)(ws + WS_Y);
    const float* lam = ap->in[9] + l * 512; const float* sub = ap->in[10] + l * 256; const int lane = F.lane;
    const float linit = (l == 0) ? 0.2f : 0.35550906759f;
    const float s1 = wave_sum(lam[lane] * lam[128 + lane] + lam[64 + lane] * lam[192 + lane], lane);
    const float s2 = wave_sum(lam[256 + lane] * lam[384 + lane] + lam[320 + lane] * lam[448 + lane], lane);
    const float lamf = expf(s1) - expf(s2) + linit;
    const int gw = F.vcu * 8 + F.wave, NGW = F.G * 8;
    float g[16];
#pragma unroll
    for (int i = 0; i < 16; ++i) g[i] = sub[(lane & 15) * 16 + i] * (1.f - linit);
    for (int m = gw; m < M; m += NGW) {
        const float* r1 = CATT + (size_t)m * 2048 + lane * 16; const float* r2 = r1 + 1024;
        float v[16]; float ss = 0.f;
#pragma unroll
        for (int q = 0; q < 4; ++q) { const f32x4 x = *(const f32x4*)(r1 + 4 * q), y = *(const f32x4*)(r2 + 4 * q);
#pragma unroll
            for (int j = 0; j < 4; ++j) { const float d = x[j] - lamf * y[j]; v[4 * q + j] = d; ss += d * d; } }
        ss = sum16(ss);
        const float rs = 1.f / sqrtf(ss * (1.f / 256.f) + EPS);
        u32x4 o0, o1;
        o0.x = cvt_pk_bf16(v[0] * rs * g[0], v[1] * rs * g[1]); o0.y = cvt_pk_bf16(v[2] * rs * g[2], v[3] * rs * g[3]); o0.z = cvt_pk_bf16(v[4] * rs * g[4], v[5] * rs * g[5]); o0.w = cvt_pk_bf16(v[6] * rs * g[6], v[7] * rs * g[7]);
        o1.x = cvt_pk_bf16(v[8] * rs * g[8], v[9] * rs * g[9]); o1.y = cvt_pk_bf16(v[10] * rs * g[10], v[11] * rs * g[11]); o1.z = cvt_pk_bf16(v[12] * rs * g[12], v[13] * rs * g[13]); o1.w = cvt_pk_bf16(v[14] * rs * g[14], v[15] * rs * g[15]);
        bf16_t* yo = Y + tiled_off((size_t)m, 2048 + lane * 16, DM);
        *(u32x4*)yo = o0; *(u32x4*)(yo + 8) = o1;
    }
}

template <int KS>
__device__ __forceinline__ void mma_nt(f32x16& acc, const LAS unsigned char* A, int sa, const LAS unsigned char* B, int sb, int lane) {
    const LAS unsigned char* ap = A + (lane & 31) * sa + (lane >> 5) * 16;
    const LAS unsigned char* bp = B + (lane & 31) * sb + (lane >> 5) * 16;
#pragma unroll
    for (int ks = 0; ks < KS; ++ks) { const bf16x8 x = *(const LAS bf16x8*)(ap + ks * 32), y = *(const LAS bf16x8*)(bp + ks * 32);
        acc = __builtin_amdgcn_mfma_f32_32x32x16_bf16(x, y, acc, 0, 0, 0); }
}
__device__ __forceinline__ unsigned short bf1(float v) { return (unsigned short)(cvt_pk_bf16(v, v) & 0xffffu); }

__device__ __forceinline__ void hgrn_scan(const Frame& F, KA* ap, int l, int bh) {
    const int tid_ = my_tid();
    const int tid = tid_, lane = tid & 63, w = __builtin_amdgcn_readfirstlane(tid >> 6), hi = lane >> 5, c32 = lane & 31;
    unsigned char* ws = ap->ws; LAS unsigned char* lds = F.lds;
    const int b = bh >> 3, h = bh & 7; const size_t m0 = (size_t)b * T;
    const bf16_t* PROJ = (const bf16_t*)(ws + WS_PROJ); const float* GL = (const float*)(ws + WS_GLOG) + h * 128;
    bf16_t* Y = (bf16_t*)(ws + WS_Y); const float* gn = ap->in[4] + l * 128;
    constexpr int QT = 0, KT = 17408, QH = 34816, KHT = 52224, VT = 70656, ST = 89088, PP = 123904, TOT = 133120, DEC = 137216, OO = 0;
    constexpr int SQ = 272, SK = 144;
    { const u32x4 z4 = zero4(); for (int i = tid; i < 34816 / 16; i += 512) *(LAS u32x4*)(lds + ST + i * 16) = z4; }
    f32x16 sacc[2] = {};
    f32x2 gv[8]; unsigned qv[8], vv[8];
    const int k0 = 2 * lane;
#define HG_LOAD(c) do { _Pragma("unroll") for (int i = 0; i < 8; ++i) { const size_t row = m0 + (size_t)(c) * 64 + 8 * w + i; \
        gv[i] = *(const f32x2*)(GL + row * 1024 + k0); qv[i] = *(const unsigned*)(PROJ + row * LDP + C_AQ + h * 128 + k0); vv[i] = *(const unsigned*)(PROJ + row * LDP + C_AI + h * 128 + k0); } } while (0)
    float ggv[16];
#pragma unroll
    for (int i = 0; i < 16; ++i) ggv[i] = gn[(tid & 7) * 16 + i];
    HG_LOAD(0);
    for (int c = 0; c < T / 64; ++c) {
        const bf16_t* gp_ = PROJ + (m0 + (size_t)c * 64 + (tid >> 3)) * LDP + C_AG + h * 128 + (tid & 7) * 16; const u32x4 g0 = *(const u32x4*)gp_, g1 = *(const u32x4*)(gp_ + 8);
        f32x2 cs[8]; { f32x2 run = {0.f, 0.f};
#pragma unroll
            for (int i = 0; i < 8; ++i) { run += gv[i]; cs[i] = run; }
            *(LAS f32x2*)(lds + TOT + (w * 128 + k0) * 4) = run; }
        __syncthreads();
        { f32x2 off = {0.f, 0.f}, b31 = {0.f, 0.f}, b63 = {0.f, 0.f};
#pragma unroll
          for (int j = 0; j < 8; ++j) { const f32x2 tj = *(const LAS f32x2*)(lds + TOT + (j * 128 + k0) * 4); if (j < w) off += tj; if (j < 4) b31 += tj; b63 += tj; }
          float kh0[8], kh1[8];
#pragma unroll
          for (int i = 0; i < 8; ++i) { const int t = 8 * w + i; const f32x2 bt = off + cs[i];
              const float q0 = bf_lo(qv[i]), q1 = bf_hi(qv[i]);
              const float ki0 = 1.f - __expf(gv[i].x), ki1 = 1.f - __expf(gv[i].y);
              *(LAS unsigned*)(lds + QT + t * SQ + k0 * 2) = cvt_pk_bf16(q0 * __expf(fminf(bt.x - b31.x, 80.f)), q1 * __expf(fminf(bt.y - b31.y, 80.f)));
              *(LAS unsigned*)(lds + KT + t * SQ + k0 * 2) = cvt_pk_bf16(ki0 * __expf(fminf(b31.x - bt.x, 80.f)), ki1 * __expf(fminf(b31.y - bt.y, 80.f)));
              *(LAS unsigned*)(lds + QH + t * SQ + k0 * 2) = cvt_pk_bf16(q0 * __expf(bt.x), q1 * __expf(bt.y));
              kh0[i] = ki0 * __expf(b63.x - bt.x); kh1[i] = ki1 * __expf(b63.y - bt.y); }
          u32x4 o; o.x = cvt_pk_bf16(kh0[0], kh0[1]); o.y = cvt_pk_bf16(kh0[2], kh0[3]); o.z = cvt_pk_bf16(kh0[4], kh0[5]); o.w = cvt_pk_bf16(kh0[6], kh0[7]);
          *(LAS u32x4*)(lds + KHT + k0 * SK + w * 16) = o;
          o.x = cvt_pk_bf16(kh1[0], kh1[1]); o.y = cvt_pk_bf16(kh1[2], kh1[3]); o.z = cvt_pk_bf16(kh1[4], kh1[5]); o.w = cvt_pk_bf16(kh1[6], kh1[7]);
          *(LAS u32x4*)(lds + KHT + (k0 + 1) * SK + w * 16) = o;
          o.x = (vv[0] & 0xffffu) | (vv[1] << 16); o.y = (vv[2] & 0xffffu) | (vv[3] << 16); o.z = (vv[4] & 0xffffu) | (vv[5] << 16); o.w = (vv[6] & 0xffffu) | (vv[7] << 16);
          *(LAS u32x4*)(lds + VT + k0 * SK + w * 16) = o;
          o.x = (vv[0] >> 16) | (vv[1] & 0xffff0000u); o.y = (vv[2] >> 16) | (vv[3] & 0xffff0000u); o.z = (vv[4] >> 16) | (vv[5] & 0xffff0000u); o.w = (vv[6] >> 16) | (vv[7] & 0xffff0000u);
          *(LAS u32x4*)(lds + VT + (k0 + 1) * SK + w * 16) = o;
          if (w == 7) { f32x2 d; d.x = __expf(b63.x); d.y = __expf(b63.y); *(LAS f32x2*)(lds + DEC + k0 * 4) = d; } }
        if (c + 1 < T / 64) HG_LOAD(c + 1);
        __syncthreads();
        f32x16 pacc = {}, oacc = {};
        const int ti = w >> 1, sj = w & 1;
        if (w < 4 && !(ti == 0 && sj == 1)) mma_nt<8>(pacc, lds + QT + ti * 32 * SQ, SQ, lds + KT + sj * 32 * SQ, SQ, lane);
        mma_nt<8>(oacc, lds + QH + (w & 1) * 32 * SQ, SQ, lds + ST + (w >> 1) * 32 * SQ, SQ, lane);
#pragma unroll
        for (int j = 0; j < 2; ++j) { const int kj = 2 * (w & 1) + j; const float dec = *(const LAS float*)(lds + DEC + (32 * kj + c32) * 4);
#pragma unroll
            for (int r = 0; r < 16; ++r) sacc[j][r] *= dec;
            mma_nt<4>(sacc[j], lds + VT + (w >> 1) * 32 * SK, SK, lds + KHT + kj * 32 * SK, SK, lane); }
        __syncthreads();
        if (w < 4) {
#pragma unroll
            for (int r = 0; r < 16; ++r) { const int t = 32 * ti + att::crow(r, hi), s_ = 32 * sj + c32; const float v = (s_ <= t) ? pacc[r] : 0.f;
                *(LAS unsigned short*)(lds + PP + t * SK + s_ * 2) = bf1(v); } }
#pragma unroll
        for (int j = 0; j < 2; ++j) { const int kj = 2 * (w & 1) + j;
#pragma unroll
            for (int r = 0; r < 16; ++r) { const int v_ = 32 * (w >> 1) + att::crow(r, hi), k_ = 32 * kj + c32;
                *(LAS unsigned short*)(lds + ST + v_ * SQ + k_ * 2) = bf1(sacc[j][r]); } }
        __syncthreads();
        mma_nt<4>(oacc, lds + PP + (w & 1) * 32 * SK, SK, lds + VT + (w >> 1) * 32 * SK, SK, lane);
#pragma unroll
        for (int r = 0; r < 16; ++r) { const int t = 32 * (w & 1) + att::crow(r, hi), v_ = 32 * (w >> 1) + c32; *(LAS float*)(lds + OO + (t * 132 + v_) * 4) = oacc[r]; }
        __syncthreads();
        { const int t = tid >> 3, sg = tid & 7; const size_t row = m0 + (size_t)c * 64 + t;
          float v[16]; float ss = 0.f;
#pragma unroll
          for (int q = 0; q < 4; ++q) { const f32x4 x = *(const LAS f32x4*)(lds + OO + (t * 132 + sg * 16 + 4 * q) * 4);
#pragma unroll
              for (int j = 0; j < 4; ++j) { v[4 * q + j] = x[j]; ss += x[j] * x[j]; } }
          ss = sum8(ss);
          const float rs = 1.f / sqrtf(ss * (1.f / 128.f) + EPS);
          const float (&gg)[16] = ggv;
          u32x4 o0, o1;
          o0.x = cvt_pk_bf16(v[0] * rs * gg[0] * bf_lo(g0.x), v[1] * rs * gg[1] * bf_hi(g0.x)); o0.y = cvt_pk_bf16(v[2] * rs * gg[2] * bf_lo(g0.y), v[3] * rs * gg[3] * bf_hi(g0.y));
          o0.z = cvt_pk_bf16(v[4] * rs * gg[4] * bf_lo(g0.z), v[5] * rs * gg[5] * bf_hi(g0.z)); o0.w = cvt_pk_bf16(v[6] * rs * gg[6] * bf_lo(g0.w), v[7] * rs * gg[7] * bf_hi(g0.w));
          o1.x = cvt_pk_bf16(v[8] * rs * gg[8] * bf_lo(g1.x), v[9] * rs * gg[9] * bf_hi(g1.x)); o1.y = cvt_pk_bf16(v[10] * rs * gg[10] * bf_lo(g1.y), v[11] * rs * gg[11] * bf_hi(g1.y));
          o1.z = cvt_pk_bf16(v[12] * rs * gg[12] * bf_lo(g1.z), v[13] * rs * gg[13] * bf_hi(g1.z)); o1.w = cvt_pk_bf16(v[14] * rs * gg[14] * bf_lo(g1.w), v[15] * rs * gg[15] * bf_hi(g1.w));
          bf16_t* yo = Y + tiled_off(row, h * 128 + sg * 16, DM); *(u32x4*)yo = o0; *(u32x4*)(yo + 8) = o1; }
    }
#undef HG_LOAD
    __syncthreads();
}

__device__ __forceinline__ void mlstm_scan(const Frame& F, KA* ap, int l, int bh) {
    const int tid_ = my_tid();
    const int tid = tid_, lane = tid & 63, w = __builtin_amdgcn_readfirstlane(tid >> 6), hi = lane >> 5, c32 = lane & 31;
    unsigned char* ws = ap->ws; LAS unsigned char* lds = F.lds;
    const int b = bh >> 3, h = bh & 7; const size_t m0 = (size_t)b * T;
    const bf16_t* PROJ = (const bf16_t*)(ws + WS_PROJ); const bf16_t* BQK = (const bf16_t*)(ws + WS_BQK); const float* ODD = (const float*)(ws + WS_ODD);
    bf16_t* Y = (bf16_t*)(ws + WS_Y); const float* hn = ap->in[7] + l * 128;
    constexpr int QA = 0, QI = 9216, KB = 18432, KHT = 27648, VT = 36864, CT = 59904, PP = 82944, SCAL = 92160, NUM = 94208;
    constexpr int SK = 144, SN = 164;
    { const u32x4 z4 = zero4(); for (int i = tid; i < 23040 / 16; i += 512) *(LAS u32x4*)(lds + CT + i * 16) = z4; }
    for (int i = tid; i < 32 * SK / 16; i += 512) { const int off = i * 16; const unsigned vone = (off < SK) ? 0x3F803F80u : 0u;
        *(LAS u32x4*)(lds + VT + 128 * SK + off) = (u32x4){vone, vone, vone, vone}; }
    f32x16 cacc[2] = {};
    float m_prev = 0.f;
    const int te = tid >> 3, d0 = (tid & 7) * 8, k0 = 2 * lane;
    bf16x8 qreg, kreg; unsigned vv[8]; float igr = 0.f, lfr = 0.f;
#define ML_LOAD(c) do { const size_t rb = m0 + (size_t)(c) * 64; \
        qreg = *(const bf16x8*)(BQK + (rb + te) * 1024 + h * 64 + d0); kreg = *(const bf16x8*)(BQK + (rb + te) * 1024 + 512 + h * 64 + d0); \
        _Pragma("unroll") for (int i = 0; i < 8; ++i) vv[i] = *(const unsigned*)(PROJ + (rb + 8 * w + i) * LDP + C_BV + h * 128 + k0); \
        if (w == 0) { igr = ODD[(rb + lane) * LDO + 80 + h]; lfr = ODD[(rb + lane) * LDO + 88 + h]; } } while (0)
    float ggv[16];
#pragma unroll
    for (int i = 0; i < 16; ++i) ggv[i] = hn[(tid & 7) * 16 + i];
    ML_LOAD(0);
    for (int c = 0; c < T / 64; ++c) {
        const bf16_t* gp_ = PROJ + (m0 + (size_t)c * 64 + (tid >> 3)) * LDP + C_BO + h * 128 + (tid & 7) * 16; const u32x4 g0 = *(const u32x4*)gp_, g1 = *(const u32x4*)(gp_ + 8);
        if (w == 0) {
            float bc = lfr;
#pragma unroll
            for (int o = 1; o < 64; o <<= 1) { const float x = sidx(bc, lane - o); if (lane >= o) bc += x; }
            const float c1 = igr - bc; float pm = c1;
#pragma unroll
            for (int o = 1; o < 64; o <<= 1) { const float x = sidx(pm, lane - o); if (lane >= o) pm = fmaxf(pm, x); }
            const float mt = fmaxf(bc + pm, bc + m_prev);
            const float wi = __expf(bc + m_prev - mt);
            const float m_new = sidx(mt, 63), b63 = sidx(bc, 63);
            const float wst = __expf(b63 + c1 - m_new), decay = __expf(b63 + m_prev - m_new);
            LAS float* sc = (LAS float*)(lds + SCAL);
            sc[lane] = c1; sc[64 + lane] = bc - mt; sc[128 + lane] = wi; sc[192 + lane] = wst; sc[256 + lane] = __expf(-mt); if (lane == 0) sc[320] = decay;
            m_prev = m_new;
        }
        *(LAS bf16x8*)(lds + QA + te * SK + d0 * 2) = qreg; *(LAS bf16x8*)(lds + KB + te * SK + d0 * 2) = kreg;
        { u32x4 o; o.x = (vv[0] & 0xffffu) | (vv[1] << 16); o.y = (vv[2] & 0xffffu) | (vv[3] << 16); o.z = (vv[4] & 0xffffu) | (vv[5] << 16); o.w = (vv[6] & 0xffffu) | (vv[7] << 16);
          *(LAS u32x4*)(lds + VT + k0 * SK + w * 16) = o;
          o.x = (vv[0] >> 16) | (vv[1] & 0xffff0000u); o.y = (vv[2] >> 16) | (vv[3] & 0xffff0000u); o.z = (vv[4] >> 16) | (vv[5] & 0xffff0000u); o.w = (vv[6] >> 16) | (vv[7] & 0xffff0000u);
          *(LAS u32x4*)(lds + VT + (k0 + 1) * SK + w * 16) = o; }
        __syncthreads();
        { const LAS float* sc = (const LAS float*)(lds + SCAL); const float wi = sc[128 + te], wst = sc[192 + te];
          float qf[8], kf[8];
#pragma unroll
          for (int i = 0; i < 8; ++i) { qf[i] = bf2f((bf16_t)qreg[i]) * wi; kf[i] = bf2f((bf16_t)kreg[i]) * wst; }
          u32x4 o; o.x = cvt_pk_bf16(qf[0], qf[1]); o.y = cvt_pk_bf16(qf[2], qf[3]); o.z = cvt_pk_bf16(qf[4], qf[5]); o.w = cvt_pk_bf16(qf[6], qf[7]);
          *(LAS u32x4*)(lds + QI + te * SK + d0 * 2) = o;
#pragma unroll
          for (int i = 0; i < 8; ++i) *(LAS unsigned short*)(lds + KHT + (d0 + i) * SK + te * 2) = bf1(kf[i]); }
        if (c + 1 < T / 64) ML_LOAD(c + 1);
        __syncthreads();
        f32x16 pacc = {}, nacc0 = {}, nacc1 = {};
        const int ti = w >> 1, sj = w & 1;
        const float decay = ((const LAS float*)(lds + SCAL))[320];
        if (w < 4 && !(ti == 0 && sj == 1)) mma_nt<4>(pacc, lds + QA + ti * 32 * SK, SK, lds + KB + sj * 32 * SK, SK, lane);
        mma_nt<4>(nacc0, lds + QI + (w & 1) * 32 * SK, SK, lds + CT + (w >> 1) * 32 * SK, SK, lane);
        if (w < 2) mma_nt<4>(nacc1, lds + QI + w * 32 * SK, SK, lds + CT + 4 * 32 * SK, SK, lane);
#pragma unroll
        for (int r = 0; r < 16; ++r) cacc[0][r] *= decay;
        mma_nt<4>(cacc[0], lds + VT + (w >> 1) * 32 * SK, SK, lds + KHT + (w & 1) * 32 * SK, SK, lane);
        if (w < 2) {
#pragma unroll
            for (int r = 0; r < 16; ++r) cacc[1][r] *= decay;
            mma_nt<4>(cacc[1], lds + VT + 4 * 32 * SK, SK, lds + KHT + w * 32 * SK, SK, lane); }
        __syncthreads();
        if (w < 4) { const LAS float* sc = (const LAS float*)(lds + SCAL); const int s_ = 32 * sj + c32; const float c1s = sc[s_];
#pragma unroll
            for (int r = 0; r < 16; ++r) { const int t = 32 * ti + att::crow(r, hi); const float v = (s_ <= t) ? pacc[r] * __expf(c1s + sc[64 + t]) : 0.f;
                *(LAS unsigned short*)(lds + PP + t * SK + s_ * 2) = bf1(v); } }
#pragma unroll
        for (int r = 0; r < 16; ++r) { const int v_ = 32 * (w >> 1) + att::crow(r, hi), d_ = 32 * (w & 1) + c32; *(LAS unsigned short*)(lds + CT + v_ * SK + d_ * 2) = bf1(cacc[0][r]); }
        if (w < 2) {
#pragma unroll
            for (int r = 0; r < 16; ++r) { const int v_ = 128 + att::crow(r, hi), d_ = 32 * w + c32; *(LAS unsigned short*)(lds + CT + v_ * SK + d_ * 2) = bf1(cacc[1][r]); } }
        __syncthreads();
        mma_nt<4>(nacc0, lds + PP + (w & 1) * 32 * SK, SK, lds + VT + (w >> 1) * 32 * SK, SK, lane);
        if (w < 2) mma_nt<4>(nacc1, lds + PP + w * 32 * SK, SK, lds + VT + 4 * 32 * SK, SK, lane);
#pragma unroll
        for (int r = 0; r < 16; ++r) { const int t = 32 * (w & 1) + att::crow(r, hi), v_ = 32 * (w >> 1) + c32; *(LAS float*)(lds + NUM + (t * SN + v_) * 4) = nacc0[r]; }
        if (w < 2) {
#pragma unroll
            for (int r = 0; r < 16; ++r) { const int t = 32 * w + att::crow(r, hi), v_ = 128 + c32; *(LAS float*)(lds + NUM + (t * SN + v_) * 4) = nacc1[r]; } }
        __syncthreads();
        { const int t = tid >> 3, sg = tid & 7; const size_t row = m0 + (size_t)c * 64 + t;
          const float den = *(const LAS float*)(lds + NUM + (t * SN + 128) * 4); const float emt = ((const LAS float*)(lds + SCAL))[256 + t];
          const float inv = 1.f / fmaxf(fabsf(den), emt);
          float v[16]; float ss = 0.f;
#pragma unroll
          for (int q = 0; q < 4; ++q) { const f32x4 x = *(const LAS f32x4*)(lds + NUM + (t * SN + sg * 16 + 4 * q) * 4);
#pragma unroll
              for (int j = 0; j < 4; ++j) { const float y = x[j] * inv; v[4 * q + j] = y; ss += y * y; } }
          ss = sum8(ss);
          const float rs = 1.f / sqrtf(ss * (1.f / 128.f) + EPS);
          const float (&gg)[16] = ggv;
          u32x4 o0, o1;
          o0.x = cvt_pk_bf16(v[0] * rs * gg[0] * bf_lo(g0.x), v[1] * rs * gg[1] * bf_hi(g0.x)); o0.y = cvt_pk_bf16(v[2] * rs * gg[2] * bf_lo(g0.y), v[3] * rs * gg[3] * bf_hi(g0.y));
          o0.z = cvt_pk_bf16(v[4] * rs * gg[4] * bf_lo(g0.z), v[5] * rs * gg[5] * bf_hi(g0.z)); o0.w = cvt_pk_bf16(v[6] * rs * gg[6] * bf_lo(g0.w), v[7] * rs * gg[7] * bf_hi(g0.w));
          o1.x = cvt_pk_bf16(v[8] * rs * gg[8] * bf_lo(g1.x), v[9] * rs * gg[9] * bf_hi(g1.x)); o1.y = cvt_pk_bf16(v[10] * rs * gg[10] * bf_lo(g1.y), v[11] * rs * gg[11] * bf_hi(g1.y));
          o1.z = cvt_pk_bf16(v[12] * rs * gg[12] * bf_lo(g1.z), v[13] * rs * gg[13] * bf_hi(g1.z)); o1.w = cvt_pk_bf16(v[14] * rs * gg[14] * bf_lo(g1.w), v[15] * rs * gg[15] * bf_hi(g1.w));
          bf16_t* yo = Y + tiled_off(row, 1024 + h * 128 + sg * 16, DM); *(u32x4*)yo = o0; *(u32x4*)(yo + 8) = o1; }
    }
#undef ML_LOAD
    __syncthreads();
}

template <int STG2>
__device__ __forceinline__ void dsa_index_item2(const Frame& F, KA* ap, int item) {
    const int tid_ = my_tid();
    const int tid = tid_, lane = tid & 63, w = __builtin_amdgcn_readfirstlane(tid >> 6), hi = lane >> 5, c32 = lane & 31;
    unsigned char* ws = ap->ws; LAS unsigned char* lds = F.lds;
    const int b = item % NB, tb = (T / 32 - 1) - item / NB;
    const int t0 = tb * 32 + 4 * w; const size_t m0 = (size_t)b * T;
    const int n = 64 * (t0 / 64 + 1), nkb = n / 32, nj = n / 64;
    unsigned* MK = (unsigned*)(ws + WS_MASK) + (size_t)b * 256 * T;
    if (n <= 256) { for (int i = lane; i < nkb * 4; i += 64) MK[(size_t)(i >> 2) * T + t0 + (i & 3)] = 0xFFFFFFFFu; return; }
    const bf16_t* PROJ = (const bf16_t*)(ws + WS_PROJ); const bf16_t* KI = (const bf16_t*)(ws + WS_KI) + m0 * 64; const float* ODD = (const float*)(ws + WS_ODD);
    unsigned* SCB = (unsigned*)(ws + WS_SCB) + ((size_t)blockIdx.x * 8 + w) * 4 * T;
    LAS unsigned* hist = (LAS unsigned*)(lds + w * 8192);
    LAS unsigned* wb = hist + 1024;
    {
        bf16x8 af[2][4]; float wv[2][16];
#pragma unroll
        for (int rt = 0; rt < 2; ++rt) {
#pragma unroll
            for (int ks = 0; ks < 4; ++ks) af[rt][ks] = *(const bf16x8*)(PROJ + (m0 + t0 + 2 * rt + (c32 >> 4)) * LDP + C_DQI + (c32 & 15) * 64 + ks * 16 + hi * 8);
#pragma unroll
            for (int r = 0; r < 16; ++r) { const int tok = 2 * rt + (r >> 3), head = (r & 3) + 8 * ((r >> 2) & 1) + 4 * hi; wv[rt][r] = ODD[(m0 + t0 + tok) * LDO + 64 + head]; } }
        f32x2 wv2[2][8]; const f32x2 one2 = {1.f, 1.f};
#pragma unroll
        for (int rt = 0; rt < 2; ++rt)
#pragma unroll
            for (int i = 0; i < 8; ++i) wv2[rt][i] = (f32x2){wv[rt][2 * i], wv[rt][2 * i + 1]};
        LAS unsigned char* kbuf = lds + 65536;
#define IDX_LOADB(dst, base_, t_) do { _Pragma("unroll") for (int ks = 0; ks < 4; ++ks) dst[ks] = *(const LAS bf16x8*)((base_) + (((t_) * 4 + ks) * 64 + lane) * 16); } while (0)
#define IDX_MMA(src, A0, A1) do { A0 = f32x16{}; A1 = f32x16{}; _Pragma("unroll") for (int ks = 0; ks < 4; ++ks) { \
            A0 = __builtin_amdgcn_mfma_f32_32x32x16_bf16(af[0][ks], src[ks], A0, 0, 0, 0); A1 = __builtin_amdgcn_mfma_f32_32x32x16_bf16(af[1][ks], src[ks], A1, 0, 0, 0); } } while (0)
#define IDX_PKACC(SP, ACC, i_, W2) do { f32x2 x2_ = {ACC[2 * (i_)], ACC[2 * (i_) + 1]}, r2_; \
            asm("v_pk_mul_f32 %0, %1, %2 clamp" : "=v"(r2_) : "v"(x2_), "v"(one2));     \
            asm("v_pk_fma_f32 %0, %1, %2, %0" : "+v"(SP) : "v"(r2_), "v"(W2)); } while (0)
#define IDX_RED1(ACC, rt, kb_) do { f32x2 sp0 = {0.f, 0.f}, sp1 = {0.f, 0.f}; \
            _Pragma("unroll") for (int i = 0; i < 4; ++i) { IDX_PKACC(sp0, ACC, i, wv2[rt][i]); IDX_PKACC(sp1, ACC, 4 + i, wv2[rt][4 + i]); } \
            const float s0 = sp0.x + sp0.y, s1 = sp1.x + sp1.y; \
            const auto pr_ = __builtin_amdgcn_permlane32_swap(__float_as_uint(s0), __float_as_uint(s1), false, false); \
            const float sv = fminf(fmaxf(__uint_as_float(pr_[0]) + __uint_as_float(pr_[1]), -15.99f), 15.99f); \
            const unsigned key_ = ((unsigned)(int)(sv * 134217728.f) + 0x80000000u) >> 8; SCB[(size_t)(2 * rt + hi) * T + 32 * (kb_) + c32] = key_; \
            { const unsigned bin_ = key_ >> 15; __hip_atomic_fetch_add(&hist[(2 * rt + hi) * 256 + (bin_ >> 1)], 1u << (16 * (bin_ & 1u)), __ATOMIC_RELAXED, __HIP_MEMORY_SCOPE_WORKGROUP); } } while (0)
#define IDX_RED(A0, A1, kb_) do { IDX_RED1(A0, 0, kb_); IDX_RED1(A1, 1, kb_); } while (0)
        const int ngrp = (nkb + 7) >> 3;
        u32x4 stg[4];
#pragma unroll
        for (int i = 0; i < 16; ++i) hist[64 * i + lane] = 0u;
        asm volatile("s_waitcnt lgkmcnt(0)" ::: "memory");
#pragma unroll
        for (int i = 0; i < 4; ++i) { const int ch = tid + 512 * i; if ((ch >> 8) < nkb) stg[i] = *(const u32x4*)((const char*)KI + (size_t)ch * 16); }
#pragma unroll
        for (int i = 0; i < 4; ++i) { const int ch = tid + 512 * i; if ((ch >> 8) < nkb) *(LAS u32x4*)(kbuf + ch * 16) = stg[i]; }
        __syncthreads();
        for (int g = 0; g < ngrp; ++g) {
            const int kb0 = 8 * g, nt_ = (nkb - kb0) < 8 ? (nkb - kb0) : 8;
            if (g + 1 < ngrp) {
#pragma unroll
                for (int i = 0; i < 4; ++i) { const int ch = tid + 512 * i; if (kb0 + 8 + (ch >> 8) < nkb) stg[i] = *(const u32x4*)((const char*)KI + ((size_t)(kb0 + 8) * 256 + ch) * 16); } }
            const LAS unsigned char* cb = kbuf + (g & 1) * 32768;
            bf16x8 ra[4], rb[4]; f32x16 P0, P1, Q0, Q1;
            IDX_LOADB(ra, cb, 0); IDX_MMA(ra, P0, P1);
            for (int t = 0; t < nt_; t += 2) {
                IDX_LOADB(rb, cb, t + 1); IDX_MMA(rb, Q0, Q1);
                IDX_RED(P0, P1, kb0 + t);
                if (t + 2 < nt_) { IDX_LOADB(ra, cb, t + 2); IDX_MMA(ra, P0, P1); }
                IDX_RED(Q0, Q1, kb0 + t + 1);
            }
            if (g + 1 < ngrp) {
#pragma unroll
                for (int i = 0; i < 4; ++i) { const int ch = tid + 512 * i; if (kb0 + 8 + (ch >> 8) < nkb) *(LAS u32x4*)(kbuf + ((g + 1) & 1) * 32768 + ch * 16) = stg[i]; } }
            __syncthreads();
        }
#undef IDX_MMA
#undef IDX_PKACC
#undef IDX_RED1
#undef IDX_RED
#undef IDX_LOADB
    }
    asm volatile("s_waitcnt vmcnt(0)" ::: "memory");
    if (STG2 == 1) return;
#define WSYNC() asm volatile("s_waitcnt lgkmcnt(0)" ::: "memory")
    for (int row = 0; row < 4; ++row) {
        const unsigned* sc = SCB + (size_t)row * T;
        unsigned kv[128];
#pragma unroll
        for (int j = 0; j < 128; ++j) kv[j] = 0u;
        { int njl = nj; asm volatile("" : "+s"(njl));
#pragma unroll
        for (int j = 0; j < 128; ++j) { if (j < njl) kv[j] = sc[64 * j + lane]; } }
        unsigned prefix, kth = 256u;
        LAS unsigned* hrow = hist + row * 256;
        {   unsigned hw[4]; unsigned tot = 0u;
#pragma unroll
            for (int i = 0; i < 4; ++i) { hw[i] = hrow[4 * lane + i]; tot += (hw[i] & 0xffffu) + (hw[i] >> 16); }
            unsigned suf = tot;
#pragma unroll
            for (int o = 1; o < 64; o <<= 1) { const unsigned x = sidxu(suf, lane + o); if (lane + o < 64) suf += x; }
            const unsigned above = suf - tot;
            unsigned selv = 0u, selk = 0u; const bool mine = (suf >= kth && above < kth);
            if (mine) { unsigned cnt = above; int bin = 0; bool found = false;
#pragma unroll
                for (int i = 7; i >= 0; --i) { const unsigned c = (i & 1) ? (hw[i >> 1] >> 16) : (hw[i >> 1] & 0xffffu);
                    if (!found) { if (cnt + c >= kth) { bin = i; found = true; } else cnt += c; } }
                selv = (unsigned)(8 * lane + bin); selk = kth - cnt; }
            const unsigned long long bm = __ballot(mine); const int src = (int)__builtin_ctzll(bm ? bm : 1ull);
            prefix = sidxu(selv, src); kth = sidxu(selk, src);
            WSYNC();
        }
#pragma unroll
        for (int pass = 1; pass < 3; ++pass) {
            const int shift = (pass == 1) ? 7 : 0, hshift = (pass == 1) ? 15 : 7; const unsigned dmask = (pass == 1) ? 255u : 127u;
#pragma unroll
            for (int i = 0; i < 4; ++i) hrow[64 * i + lane] = 0u;
            WSYNC();
            { int njl = nj; asm volatile("" : "+s"(njl));
#pragma unroll
            for (int j = 0; j < 128; ++j) { if (j < njl) { const unsigned key = kv[j];
                if ((key >> hshift) == prefix) __hip_atomic_fetch_add(&hrow[(key >> shift) & dmask], 1u, __ATOMIC_RELAXED, __HIP_MEMORY_SCOPE_WORKGROUP); } } }
            WSYNC();
            const unsigned h0 = hrow[4 * lane], h1 = hrow[4 * lane + 1], h2 = hrow[4 * lane + 2], h3 = hrow[4 * lane + 3];
            unsigned suf = h0 + h1 + h2 + h3;
#pragma unroll
            for (int o = 1; o < 64; o <<= 1) { const unsigned x = sidxu(suf, lane + o); if (lane + o < 64) suf += x; }
            const unsigned above = suf - (h0 + h1 + h2 + h3);
            unsigned selv = 0u, selk = 0u; const bool mine = (suf >= kth && above < kth);
            if (mine) { unsigned cnt = above; int bin;
                if (cnt + h3 >= kth) { bin = 3; } else { cnt += h3; if (cnt + h2 >= kth) { bin = 2; } else { cnt += h2; if (cnt + h1 >= kth) { bin = 1; } else { cnt += h1; bin = 0; } } }
                selv = (unsigned)(4 * lane + bin); selk = kth - cnt; }
            const unsigned long long bm = __ballot(mine); const int src = (int)__builtin_ctzll(bm ? bm : 1ull);
            prefix = (prefix << ((pass == 1) ? 8 : 7)) | sidxu(selv, src); kth = sidxu(selk, src);
            WSYNC();
        }
        if (STG2 == 2) { if (prefix == 0xdeadbeefu) MK[0] = kth; continue; }
        { int njl = nj; asm volatile("" : "+s"(njl));
#pragma unroll
        for (int j = 0; j < 128; ++j) { if (j < njl) { const unsigned long long bal = __ballot(kv[j] >= prefix);
            if (lane == 0) { wb[(2 * j) * 4 + row] = (unsigned)bal; wb[(2 * j + 1) * 4 + row] = (unsigned)(bal >> 32); } } } }
    }
    WSYNC();
    for (int kb = lane; kb < nkb; kb += 64) { const u32x4 v = *(const LAS u32x4*)(wb + kb * 4); *(u32x4*)(MK + (size_t)kb * T + t0) = v; }
    WSYNC();
#undef WSYNC
}

__device__ __forceinline__ int qn(unsigned* ctr, volatile LAS unsigned* slot, int lo, int hi) { const int v = q_next(ctr, slot) + lo; return v < hi ? v : 0x7fffffff; }
constexpr int IT_A = 16, IT_B = 32, IT_C = 32 + 1024, IT_D = IT_C + NB * (T / 32);
template <int ISTG>
__device__ __forceinline__ void mixer_a_phase(const Frame& F, KA* ap, int l, unsigned* qctr, int it_lo, int it_hi) {
    volatile LAS unsigned* slot = (volatile LAS unsigned*)(F.lds + LDS_MISC) + 16;
    unsigned char* ws = ap->ws;
    int it = qn(qctr, slot, it_lo, it_hi);
#ifndef NO_A
    while (it < IT_A) { hgrn_scan(F, ap, l, it); it = qn(qctr, slot, it_lo, it_hi); }
#endif
#ifndef NO_B
    while (it < IT_B) { mlstm_scan(F, ap, l, it - IT_A); it = qn(qctr, slot, it_lo, it_hi); }
#endif
    {
        const bf16_t* PROJ = (const bf16_t*)(ws + WS_PROJ); float* CATT = (float*)(ws + WS_CATT);
        att::Seam S;
        while (it < IT_C) {
            const int i = it - IT_B, y = 31 - (i >> 5), r = i & 31, b = r >> 4, vh = r & 15, h = vh >> 2, mm = (vh >> 1) & 1, vhalf = vh & 1;
            const bf16_t* base = PROJ + (size_t)b * T * LDP;
            att::BlockRef<float> r0;
            r0.Q = base + (size_t)(y * 256) * LDP + C_CQ + (h * 2 + mm) * 128; r0.K = base + C_CK + (h * 2 + mm) * 128; r0.V = base + C_CV + h * 256 + vhalf * 128;
            r0.O = CATT + ((size_t)b * T + y * 256) * 2048 + mm * 1024 + h * 256 + vhalf * 128; r0.MK = nullptr; r0.P0 = y * 256; r0.orow = 0; r0.ocol = 0;
#ifndef NO_C
            att::attn_prime<float>(r0, (char*)F.lds, S);
            att::attn_block<float, false, 2048>(r0, r0, (char*)F.lds, S);
#endif
            it = qn(qctr, slot, it_lo, it_hi);
        }
    }
#ifndef NO_D
    while (it < IT_D) { dsa_index_item2<4>(F, ap, it - IT_C); it = qn(qctr, slot, it_lo, it_hi); }
#endif
}
__device__ __forceinline__ void mixer_b_phase(const Frame& F, KA* ap, int l, unsigned* qctr) {
    volatile LAS unsigned* slot = (volatile LAS unsigned*)(F.lds + LDS_MISC) + 16;
    unsigned char* ws = ap->ws;
    const bf16_t* PROJ = (const bf16_t*)(ws + WS_PROJ); bf16_t* Y = (bf16_t*)(ws + WS_Y); const unsigned* MASK = (const unsigned*)(ws + WS_MASK);
    att::Seam S;
    int it = q_next(qctr, slot);
    while (it < 512) {
        const int y = 31 - (it >> 4), r = it & 15, b = r >> 3, h = r & 7;
        const bf16_t* base = PROJ + (size_t)b * T * LDP;
        att::BlockRef<bf16_t> r0;
        r0.Q = base + (size_t)(y * 256) * LDP + C_DQ + h * 128; r0.K = base + C_DK + h * 128; r0.V = base + C_DV + h * 128;
        r0.O = Y; r0.orow = b * T + y * 256; r0.ocol = 3072 + h * 128; r0.MK = MASK + (size_t)b * 256 * T; r0.P0 = y * 256;
#ifndef NO_E
        att::attn_prime<bf16_t>(r0, (char*)F.lds, S);
        att::attn_block<bf16_t, true, DM>(r0, r0, (char*)F.lds, S);
#endif
        it = q_next(qctr, slot);
    }
#ifndef NO_G
    { const Frame F2 = make_frame(F.lds); ccombine_phase(F2, ap, l); }
#endif
}

__global__ void __launch_bounds__(512, 2) mk_fwd(Args args) {
    extern __shared__ __attribute__((aligned(16))) unsigned char lds_raw[];
    LAS unsigned char* lds = (LAS unsigned char*)lds_raw;
    volatile LAS unsigned* MISC = (volatile LAS unsigned*)(lds + LDS_MISC);
    if (threadIdx.x < 64) MISC[threadIdx.x] = 0u;
    if ((threadIdx.x & 63) == 0) *(volatile LAS unsigned*)(lds + LDS_WTAB + ((unsigned)__builtin_amdgcn_s_getreg((5 << 11) | 4) & 63u) * 4) = threadIdx.x >> 6;
    __syncthreads();
    if (my_tid() != (int)threadIdx.x) __builtin_trap();
    const int lo = args.ph_lo, hi = args.ph_hi;
    XcdBarrier bar; bar.bar = (unsigned*)(args.ws + WS_CTL) + CW_BAR; bar.x = 0; bar.st = nullptr;
    if (hi - lo > 1) bar = xcd_barrier_post((unsigned*)(args.ws + WS_CTL) + CW_BAR, MISC + 8);
#define IN(k) (lo <= (k) && (k) < hi)
#define SEAM(k) do { if (IN(k) && IN((k) + 1)) { XcdBarrier b_; b_.bar = (unsigned*)(PH_ARGS()->ws + WS_CTL) + CW_BAR; b_.x = xb_xcc_id(); b_.st = MISC + 8; xcd_barrier(b_); } } while (0)

#ifndef REP_P0
#define REP_P0 1
#endif
    if (IN(0)) { for (int rep = 0; rep < REP_P0; ++rep) { KA* ap = PH_ARGS(); const Frame F = make_frame(lds); p0_prologue(F, ap); } SEAM(0); }

#pragma unroll
    for (int l = 0; l < DEPTH; ++l) {
        const int pb = 1 + 9 * l;
        if (IN(pb + 0)) {
            KA* ap = PH_ARGS(); unsigned char* ws = ap->ws;
            pg8::Gemm g{(const bf16_t*)(ws + WS_XB), (const bf16_t*)(ws + WS_WIN + l * SZ_WIN), M, LDP, DM, DM}; pg8::StaticOrder S; S.init(M, LDP, gridDim.x, (int)blockIdx.x);
            EpiInProj E{(bf16_t*)(ws + WS_PROJ), (float*)(ws + WS_GLOG), (float*)(ws + WS_ODD), (const float*)(ws + WS_LB) + l * 1024, ap->in[6] + l * 16, (const float*)(ws + WS_SSQP), ap->in[8] + l * 256, ap->in[11] + l * 256, (LAS float*)(lds + 131072), (LAS float*)(lds + 139264), (volatile LAS int*)(MISC + 28), (float*)(ws + WS_RS)};
            if (my_tid() == 0) MISC[28] = 0xFFFFFFFFu;
#ifndef REP_G1
#define REP_G1 1
#endif
            for (int rep = 0; rep < REP_G1; ++rep) pg8::gemm_phase<EpiInProj, pg8::StaticOrder>(lds, g, S, E);
            { pg8::Gemm g2{(const bf16_t*)(ws + WS_XB), (const bf16_t*)(ws + WS_WIN + l * SZ_WIN) + (size_t)56 * 256 * DM, M, 256, DM / 4, DM}; pg8::SplitKOrder S2; S2.init(M, 4, gridDim.x, (int)blockIdx.x);
              EpiOddPart E2{(float*)(ws + WS_Y)};
              pg8::gemm_phase<EpiOddPart, pg8::SplitKOrder>(lds, g2, S2, E2); }
            if (l == 0) { KA* apb = PH_ARGS(); const Frame Fb = make_frame(lds); bg_convert(Fb, apb, (unsigned*)(apb->ws + WS_CTL) + CW_BGQ + 64 * (1 + 0), false); }
            SEAM(pb + 0);
        }
#ifndef NO_F
        if (IN(pb + 1)) { { KA* ap = PH_ARGS(); const Frame F = make_frame(lds); fixup_phase<false>(F, ap, l); }
#ifdef REP_FX
            for (int rep = 0; rep < REP_FX; ++rep) { KA* ap = PH_ARGS(); const Frame F = make_frame(lds); fixup_phase<true>(F, ap, l); }
#endif
            if (l == 0) { KA* apb = PH_ARGS(); const Frame Fb = make_frame(lds); bg_convert(Fb, apb, (unsigned*)(apb->ws + WS_CTL) + CW_BGQ + 64 * (1 + 4), false); } SEAM(pb + 1); }
#endif
        if (IN(pb + 2)) {
#ifndef REP_A
#define REP_A 1
#endif
#ifdef PROBE_LO
            for (int rep = 0; rep < 2; ++rep)
            { KA* ap = PH_ARGS(); const Frame F = make_frame(lds); mixer_a_phase<4>(F, ap, l, (unsigned*)(ap->ws + WS_CTL) + CW_Q + 64 * (2 * l) + 16 * rep, rep ? PROBE_LO : 0, rep ? PROBE_HI : IT_D); }
#else
            if (l == 0 && blockIdx.x < NCVW) { KA* apc = PH_ARGS(); const Frame Fc = make_frame(lds); conv_side(Fc, apc); }
            { KA* ap = PH_ARGS(); const Frame F = make_frame(lds); mixer_a_phase<4>(F, ap, l, (unsigned*)(ap->ws + WS_CTL) + CW_Q + 64 * (2 * l), 0, IT_D); }
#endif
            if (l == 0) { KA* apb = PH_ARGS(); const Frame Fb = make_frame(lds); bg_convert(Fb, apb, (unsigned*)(apb->ws + WS_CTL) + CW_BGQ + 64 * (1 + 5), false); } SEAM(pb + 2); }
        if (IN(pb + 3)) {
#ifndef REP_B
#define REP_B 1
#endif
            for (int rep = 0; rep < REP_B; ++rep) { KA* ap = PH_ARGS(); const Frame F = make_frame(lds); mixer_b_phase(F, ap, l, (unsigned*)(ap->ws + WS_CTL) + CW_Q + 64 * (2 * l + 1) + 16 * rep); }
            if (l == 0) { KA* apb = PH_ARGS(); const Frame Fb = make_frame(lds); bg_convert(Fb, apb, (unsigned*)(apb->ws + WS_CTL) + CW_BGQ + 64 * (1 + 6), false); } SEAM(pb + 3); }
        if (IN(pb + 4)) {
            KA* ap = PH_ARGS(); unsigned char* ws = ap->ws;
            pg8::Gemm g{(const bf16_t*)(ws + WS_Y), (const bf16_t*)(ws + WS_WOUT + l * SZ_WOUT), M, DM, DM, DM}; pg8::StaticOrder S; S.init(M, DM, gridDim.x, (int)blockIdx.x);
            EpiResidBf E{(bf16_t*)(ws + WS_XB), (float*)(ws + WS_SSQP)};
            pg8::gemm_phase<EpiResidBf, pg8::StaticOrder>(lds, g, S, E);
            if (l == 0) { KA* apb = PH_ARGS(); const Frame Fb = make_frame(lds); bg_convert(Fb, apb, (unsigned*)(apb->ws + WS_CTL) + CW_BGQ + 64 * (1 + 1), false); }
            SEAM(pb + 4);
        }
#ifndef REP_RN
#define REP_RN 1
#endif
        if (IN(pb + 6)) {
            KA* ap = PH_ARGS(); unsigned char* ws = ap->ws;
            pg8::Gemm g{(const bf16_t*)(ws + WS_XB), (const bf16_t*)(ws + WS_W1 + l * SZ_W1), M, FF, DM, DM}; pg8::StaticOrder S; S.init(M, FF, gridDim.x, (int)blockIdx.x);
            EpiRelu2 E{(bf16_t*)(ws + WS_PROJ), (const float*)(ws + WS_SSQP), (LAS float*)(lds + 139264), (volatile LAS int*)(MISC + 28)};
            if (my_tid() == 0) MISC[28] = 0xFFFFFFFFu;
#ifndef REP_G3
#define REP_G3 1
#endif
            for (int rep = 0; rep < REP_G3; ++rep) pg8::gemm_phase<EpiRelu2, pg8::StaticOrder>(lds, g, S, E);
            if (l == 0) { KA* apb = PH_ARGS(); const Frame Fb = make_frame(lds); bg_convert(Fb, apb, (unsigned*)(apb->ws + WS_CTL) + CW_BGQ + 64 * (1 + 2), false); }
            SEAM(pb + 6);
        }
        if (IN(pb + 7)) {
            KA* ap = PH_ARGS(); unsigned char* ws = ap->ws;
            pg8::Gemm g{(const bf16_t*)(ws + WS_PROJ), (const bf16_t*)(ws + WS_W2 + l * SZ_W2), M, DM, FF, FF}; pg8::StaticOrder S; S.init(M, DM, gridDim.x, (int)blockIdx.x);
            if (l + 1 < DEPTH) { EpiResidBf E{(bf16_t*)(ws + WS_XB), (float*)(ws + WS_SSQP)}; pg8::gemm_phase<EpiResidBf, pg8::StaticOrder>(lds, g, S, E); }
            else { EpiFinal E{(const bf16_t*)(ws + WS_XB), ap->out}; pg8::gemm_phase<EpiFinal, pg8::StaticOrder>(lds, g, S, E); }
            if (l == 0) { KA* apb = PH_ARGS(); const Frame Fb = make_frame(lds); bg_convert(Fb, apb, nullptr, true); }
            SEAM(pb + 7);
        }
    }
#undef IN
#undef SEAM
}

extern "C" void kernel_launch(void* const* d_in, const int* in_sizes, int n_in, void* d_out, int out_size, void* d_ws, size_t ws_size, hipStream_t stream) {
    static int grid = 0;
    if (grid == 0) {
        if (n_in != 17 || in_sizes[0] != M * DM || out_size != M * DM || ws_size < WS_END) { fprintf(stderr, "kernel_launch: unexpected shapes (n_in %d in0 %d out %d ws %zu need %zu)\n", n_in, in_sizes[0], out_size, ws_size, (size_t)WS_END); grid = -1; return; }
        int dev = 0, cus = 0;
        if (hipGetDevice(&dev) != hipSuccess || hipDeviceGetAttribute(&cus, hipDeviceAttributeMultiprocessorCount, dev) != hipSuccess) { grid = -1; return; }
        if (hipFuncSetAttribute((const void*)mk_fwd, hipFuncAttributeMaxDynamicSharedMemorySize, LDS_BYTES) != hipSuccess) { fprintf(stderr, "kernel_launch: hipFuncSetAttribute failed\n"); grid = -1; return; }
        int per_cu = 0;
        if (hipOccupancyMaxActiveBlocksPerMultiprocessor(&per_cu, (const void*)mk_fwd, 512, LDS_BYTES) != hipSuccess || per_cu < 1) fprintf(stderr, "kernel_launch: occupancy query reports %d\n", per_cu);
        (void)hipGetLastError();
        grid = cus < 256 ? cus : 256;
    }
    if (grid < 0) return;
    if (hipMemsetAsync((char*)d_ws + WS_CTL, 0, CTL_BYTES, stream) != hipSuccess) return;
    Args a{};
    for (int i = 0; i < 17; ++i) a.in[i] = (const float*)d_in[i];
    a.out = (float*)d_out; a.ws = (unsigned char*)d_ws;
#if ONE_LAUNCH
    a.ph_lo = 0; a.ph_hi = NPHASE;
    hipLaunchKernelGGL(mk_fwd, dim3(grid), dim3(512), LDS_BYTES, stream, a);
#else
    for (int p = 0; p < NPHASE; ++p) { a.ph_lo = p; a.ph_hi = p + 1; hipLaunchKernelGGL(mk_fwd, dim3(grid), dim3(512), LDS_BYTES, stream, a); }
#endif
}
```
